# Optimizing an MI355X kernel written in HIP

```python
import math
import jax, jax.numpy as jnp
from jax import lax
import numpy as np

D_MODEL = 1024
BATCH = 8
SEQ = 4096
DEPTH = 2

HEAD_DIM = 64
GRID_W = 64
BLOCK_Q = 128
NORM_EPS = 1e-6
N_DIR = 2

A_HEADS = 4
A_WIDTH = A_HEADS * HEAD_DIM
A_DECAY_LORA = 64
A_ICL_LORA = 64
A_GATE_LORA = 128
A_GN_EPS = 64e-5
A_IN = 3 * A_WIDTH + A_DECAY_LORA + A_ICL_LORA + A_GATE_LORA

B_Q_HEADS = 4
B_KV_HEADS = 2
B_WIDTH = B_Q_HEADS * HEAD_DIM
B_IN = (B_Q_HEADS + 2 * B_KV_HEADS) * HEAD_DIM
ROPE_THETA = 10000.0
AXIS_DIM = HEAD_DIM // 2

C_HEADS = 4
C_WIDTH = C_HEADS * HEAD_DIM
C_CONV = 5
C_CHUNK = 64
C_IN = 4 * C_WIDTH + 2 * N_DIR * C_HEADS

D_BRANCHES = ((128, 1), (512, 4), (2048, 16))
D_HEADS_PER_BRANCH = 2
D_HEADS = D_HEADS_PER_BRANCH * len(D_BRANCHES)
D_WIDTH = D_HEADS * HEAD_DIM
D_IN = 3 * D_WIDTH
REL_BUCKETS = 32
REL_MAX_DIST = 1024

P_IN = A_IN + B_IN + C_IN + D_IN
MIX_WIDTH = A_WIDTH + B_WIDTH + C_WIDTH + D_WIDTH

N_EXPERTS = 16
EC_CAPACITY = 2
D_FF_EXPERT = D_MODEL

kernel_name = 'hybrid_parallel_heads_ec_moe_encoder'


def _heads(t):
    return t.reshape(t.shape[:-1] + (t.shape[-1] // HEAD_DIM, HEAD_DIM))


def rms_norm(x, g):
    xf = x.astype(jnp.float32)
    y = xf * lax.rsqrt(jnp.mean(xf * xf, axis=-1, keepdims=True) + NORM_EPS)
    return (y * g.astype(jnp.float32)).astype(x.dtype)


def _l2norm(x):
    return x * lax.rsqrt(jnp.sum(x * x, axis=-1, keepdims=True) + 1e-12)


def rwkv7_mixer(feat, mu_prev, mu_next, w0, w_up, a0, a_up, g_up, k_k, k_a, r_k, ln_w, ln_b):
    dtype = feat.dtype
    f = feat.astype(jnp.float32)
    prev = jnp.pad(f, ((0, 0), (1, 0), (0, 0)))[:, :-1]
    nxt = jnp.pad(f, ((0, 0), (0, 1), (0, 0)))[:, 1:]
    f = f + mu_prev * (prev - f) + mu_next * (nxt - f)
    r, k, v, wd, ad, gd = jnp.split(f, [A_WIDTH, 2 * A_WIDTH, 3 * A_WIDTH, 3 * A_WIDTH + A_DECAY_LORA, 3 * A_WIDTH + A_DECAY_LORA + A_ICL_LORA], axis=-1)
    w_log = -jax.nn.softplus(-(w0[:, None, None, :] + jnp.einsum('bsr,drc->dbsc', jnp.tanh(wd), w_up))) - 0.5
    decay = jnp.exp(-jnp.exp(w_log))
    a = jax.nn.sigmoid(a0[:, None, None, :] + jnp.einsum('bsr,drc->dbsc', ad, a_up))
    g = jnp.einsum('bsr,rc->bsc', jax.nn.sigmoid(gd), g_up)
    kk = _l2norm(_heads(k * k_k))
    k_eff = k[None] * (1.0 + (a - 1.0) * k_a)
    both = lambda t: jnp.stack([t, jnp.flip(t, 1)])
    per_dir = lambda t: jnp.stack([t[0], jnp.flip(t[1], 1)])
    to_time = lambda t: jnp.moveaxis(t, 2, 0)
    xs = (to_time(both(_heads(r))), to_time(per_dir(_heads(decay))), to_time(per_dir(_heads(k_eff))),
          to_time(both(_heads(v))), to_time(both(kk)), to_time(per_dir(_heads(a))))
    bsz, seq = f.shape[0], f.shape[1]
    state0 = jnp.zeros((N_DIR, bsz, A_HEADS, HEAD_DIM, HEAD_DIM), jnp.float32)

    def step(st, inp):
        r_t, w_t, k_t, v_t, kk_t, a_t = inp
        sa = jnp.einsum('dbhvk,dbhk->dbhv', st, -kk_t)
        st = st * w_t[..., None, :] + sa[..., :, None] * (kk_t * a_t)[..., None, :] + v_t[..., :, None] * k_t[..., None, :]
        return st, jnp.einsum('dbhvk,dbhk->dbhv', st, r_t)

    _, ys = lax.scan(step, state0, xs)
    ys = jnp.moveaxis(ys, 0, 2)
    y = ys[0] + jnp.flip(ys[1], 1)
    mean = jnp.mean(y, -1, keepdims=True)
    var = jnp.mean(jnp.square(y - mean), -1, keepdims=True)
    y = ((y - mean) * lax.rsqrt(var + A_GN_EPS)).reshape(bsz, seq, A_WIDTH) * ln_w + ln_b
    bonus = jnp.sum(_heads(r) * _heads(jnp.mean(k_eff, 0)) * r_k, -1, keepdims=True) * _heads(v)
    out = (y + bonus.reshape(bsz, seq, A_WIDTH)) * g
    return out.astype(dtype)


def axial_rope_angles(seq):
    rows = seq // GRID_W
    row_id = jnp.repeat(jnp.arange(rows), GRID_W).astype(jnp.float32)
    col_id = jnp.tile(jnp.arange(GRID_W), rows).astype(jnp.float32)
    inv = ROPE_THETA ** (-jnp.arange(0, AXIS_DIM, 2, dtype=jnp.float32) / AXIS_DIM)
    return row_id[:, None] * inv, col_id[:, None] * inv


def _rotate(x, ang):
    half = AXIS_DIM // 2
    x1, x2 = x[..., :half], x[..., half:]
    cos = jnp.cos(ang)[None, :, None, :].astype(x.dtype)
    sin = jnp.sin(ang)[None, :, None, :].astype(x.dtype)
    return jnp.concatenate([x1 * cos - x2 * sin, x2 * cos + x1 * sin], -1)


def axial_rope(x, ang_r, ang_c):
    return jnp.concatenate([_rotate(x[..., :AXIS_DIM], ang_r), _rotate(x[..., AXIS_DIM:], ang_c)], -1)


def gqa_axial_mixer(feat, q_norm_g, k_norm_g):
    bsz, seq, _ = feat.shape
    q, k, v = jnp.split(feat, [B_WIDTH, B_WIDTH + B_KV_HEADS * HEAD_DIM], axis=-1)
    q = rms_norm(_heads(q), q_norm_g)
    k = rms_norm(_heads(k), k_norm_g)
    v = _heads(v)
    ang_r, ang_c = axial_rope_angles(seq)
    q = axial_rope(q, ang_r, ang_c)
    k = axial_rope(k, ang_r, ang_c)
    rep = B_Q_HEADS // B_KV_HEADS
    nblk = seq // BLOCK_Q
    qb = jnp.moveaxis(q.reshape(bsz, nblk, BLOCK_Q, B_KV_HEADS, rep, HEAD_DIM), 1, 0)
    scale = HEAD_DIM ** -0.5

    def block(qi):
        s = jnp.einsum('bqgrd,bkgd->bgrqk', qi, k).astype(jnp.float32) * scale
        p = jax.nn.softmax(s, axis=-1).astype(v.dtype)
        return jnp.einsum('bgrqk,bkgd->bqgrd', p, v)

    o = lax.map(block, qb)
    return jnp.moveaxis(o, 0, 1).reshape(bsz, seq, B_WIDTH).astype(feat.dtype)


def short_conv(x, w):
    ch = x.shape[-1]
    return lax.conv_general_dilated(x, w[:, None, :].astype(x.dtype), window_strides=(1,),
                                    padding=[(C_CONV // 2, C_CONV // 2)],
                                    dimension_numbers=('NWC', 'WIO', 'NWC'), feature_group_count=ch)


def chunk_gated_delta(q, k, v, beta, g):
    lead = q.shape[:-2]
    seq = q.shape[-2]
    dk, dv = q.shape[-1], v.shape[-1]
    n = seq // C_CHUNK
    q, k, v = (t.astype(jnp.float32).reshape(lead + (n, C_CHUNK, t.shape[-1])) for t in (q, k, v))
    beta = beta.astype(jnp.float32).reshape(lead + (n, C_CHUNK))
    g = jnp.cumsum(g.astype(jnp.float32).reshape(lead + (n, C_CHUNK)), axis=-1)
    incl = jnp.tril(jnp.ones((C_CHUNK, C_CHUNK), bool))
    strict = jnp.tril(jnp.ones((C_CHUNK, C_CHUNK), bool), -1)
    decay = jnp.exp(jnp.where(incl, g[..., :, None] - g[..., None, :], -jnp.inf))
    kb = k * beta[..., None]
    lower = jnp.where(strict, jnp.einsum('...id,...jd->...ij', kb, k) * decay, 0.0)
    eye = jnp.eye(C_CHUNK, dtype=jnp.float32)
    rhs = jnp.concatenate([v * beta[..., None], kb * jnp.exp(g)[..., None]], -1)
    sol = lax.linalg.triangular_solve(lower + eye, rhs, left_side=True, lower=True)
    u, w = sol[..., :dv], sol[..., dv:]
    a_intra = jnp.einsum('...id,...jd->...ij', q, k) * decay
    ax = len(lead)
    mv = lambda t: jnp.moveaxis(t, ax, 0)
    state0 = jnp.zeros(lead + (dk, dv), jnp.float32)

    def step(st, inp):
        qc, kc, uc, wc, gc, ac = inp
        v_new = uc - jnp.einsum('...cd,...dv->...cv', wc, st)
        o = jnp.einsum('...cd,...dv->...cv', qc * jnp.exp(gc)[..., None], st) + jnp.einsum('...ij,...jv->...iv', ac, v_new)
        gl = gc[..., -1:]
        st = st * jnp.exp(gl)[..., None] + jnp.einsum('...cd,...cv->...dv', kc * jnp.exp(gl - gc)[..., None], v_new)
        return st, o

    _, o = lax.scan(step, state0, (mv(q), mv(k), mv(u), mv(w), mv(g), mv(a_intra)))
    return jnp.moveaxis(o, 0, ax).reshape(lead + (seq, dv))


def gated_deltanet_mixer(feat, conv_w, a_log, dt_bias, norm_g):
    bsz, seq, _ = feat.shape
    qkv, z, b, al = jnp.split(feat, [3 * C_WIDTH, 4 * C_WIDTH, 4 * C_WIDTH + N_DIR * C_HEADS], axis=-1)
    qkv = jax.nn.silu(short_conv(qkv, conv_w))
    q, k, v = jnp.split(qkv, [C_WIDTH, 2 * C_WIDTH], axis=-1)
    q = _l2norm(_heads(q).astype(jnp.float32)) * (HEAD_DIM ** -0.5)
    k = _l2norm(_heads(k).astype(jnp.float32))
    v = _heads(v).astype(jnp.float32)
    beta = jax.nn.sigmoid(b.reshape(bsz, seq, N_DIR, C_HEADS).astype(jnp.float32))
    gdec = -jnp.exp(a_log.astype(jnp.float32)) * jax.nn.softplus(al.reshape(bsz, seq, N_DIR, C_HEADS).astype(jnp.float32) + dt_bias)
    both = lambda t: jnp.stack([jnp.swapaxes(t, 1, 2), jnp.flip(jnp.swapaxes(t, 1, 2), 2)])
    per_dir = lambda t: jnp.stack([jnp.transpose(t, (2, 0, 3, 1))[0], jnp.flip(jnp.transpose(t, (2, 0, 3, 1))[1], -1)])
    o = chunk_gated_delta(both(q), both(k), both(v), per_dir(beta), per_dir(gdec))
    o = jnp.swapaxes(o[0] + jnp.flip(o[1], 2), 1, 2)
    o = rms_norm(o, norm_g) * jax.nn.silu(_heads(z).astype(jnp.float32))
    return o.reshape(bsz, seq, C_WIDTH).astype(feat.dtype)


def t5_bucket(rel):
    nb = REL_BUCKETS // 2
    max_exact = nb // 2
    n = jnp.abs(rel)
    large = max_exact + (jnp.log(jnp.maximum(n, 1).astype(jnp.float32) / max_exact)
                         / math.log(REL_MAX_DIST / max_exact) * (nb - max_exact)).astype(jnp.int32)
    large = jnp.minimum(large, nb - 1)
    return jnp.where(rel > 0, nb, 0) + jnp.where(n < max_exact, n, large)


def dilated_window_mixer(feat, rel_bias):
    bsz, seq, _ = feat.shape
    q, k, v = [_heads(t) for t in jnp.split(feat, [D_WIDTH, 2 * D_WIDTH], axis=-1)]
    nblk = seq // BLOCK_Q
    qb = jnp.swapaxes(q.reshape(bsz, nblk, BLOCK_Q, D_HEADS, HEAD_DIM), 0, 1)
    starts = jnp.arange(nblk, dtype=jnp.int32) * BLOCK_Q
    branches = []
    for br, (window, dil) in enumerate(D_BRANCHES):
        half = window // (2 * dil)
        offs = jnp.arange(-half, half + 1, dtype=jnp.int32) * dil
        hs = slice(br * D_HEADS_PER_BRANCH, (br + 1) * D_HEADS_PER_BRANCH)
        bias = rel_bias[t5_bucket(offs)][:, hs].T.astype(jnp.float32)
        branches.append((offs, hs, k[:, :, hs], v[:, :, hs], bias))
    scale = HEAD_DIM ** -0.5

    def block(args):
        qi, start = args
        pos = start + jnp.arange(BLOCK_Q, dtype=jnp.int32)
        ms, ls, outs = [], [], []
        for offs, hs, kbr, vbr, bias in branches:
            idx = pos[:, None] + offs[None, :]
            valid = (idx >= 0) & (idx < seq)
            idx = jnp.clip(idx, 0, seq - 1)
            kg = kbr[:, idx]
            vg = vbr[:, idx]
            s = jnp.einsum('bqhd,bqkhd->bqhk', qi[:, :, hs], kg).astype(jnp.float32) * scale + bias
            s = jnp.where(valid[None, :, None, :], s, -jnp.inf)
            m = jnp.max(s, -1, keepdims=True)
            p = jnp.exp(s - m)
            l = jnp.sum(p, -1, keepdims=True)
            outs.append(jnp.einsum('bqhk,bqkhd->bqhd', (p / l).astype(vg.dtype), vg).astype(jnp.float32))
            ms.append(m)
            ls.append(l)
        m_all = jnp.stack(ms)
        den = jnp.stack(ls) * jnp.exp(m_all - jnp.max(m_all, 0))
        o = jnp.stack(outs) * (den / jnp.sum(den, 0))
        return jnp.moveaxis(o, 0, 2).reshape(bsz, BLOCK_Q, D_HEADS, HEAD_DIM)

    o = lax.map(block, (qb, starts))
    return jnp.swapaxes(o, 0, 1).reshape(bsz, seq, D_WIDTH).astype(feat.dtype)


def expert_choice_ffn(h, router_w, router_b, w_gate, w_up, w_down):
    bsz, seq, _ = h.shape
    cap = EC_CAPACITY * seq // N_EXPERTS
    aff = jax.nn.softmax(jnp.einsum('bsd,de->bse', h, router_w).astype(jnp.float32) + router_b.astype(jnp.float32), axis=-1)
    gate, idx = lax.top_k(jnp.swapaxes(aff, 1, 2), cap)
    bidx = jnp.arange(bsz)[:, None, None]
    xs = h[bidx, idx]
    hid = jax.nn.silu(jnp.einsum('becd,edf->becf', xs, w_gate)) * jnp.einsum('becd,edf->becf', xs, w_up)
    ys = jnp.einsum('becf,efd->becd', hid, w_down) * gate[..., None].astype(h.dtype)
    return jnp.zeros_like(h).at[bidx, idx].add(ys.astype(h.dtype))


def setup_inputs(seed: int = 0) -> dict:
    key = jax.random.key(seed)
    ks = iter(jax.random.split(key, 40))

    def nrm(shape, scale):
        return scale * jax.random.normal(next(ks), shape, jnp.float32)

    def uni(shape, lo, hi):
        return jax.random.uniform(next(ks), shape, jnp.float32, lo, hi)

    L = DEPTH
    dt = jnp.exp(uni((L, N_DIR, C_HEADS), math.log(1e-3), math.log(1e-1)))
    return {
        'x': nrm((BATCH, SEQ, D_MODEL), 1.0),
        'norm_mix_g': 1.0 + nrm((L, D_MODEL), 0.1),
        'norm_ffn_g': 1.0 + nrm((L, D_MODEL), 0.1),
        'norm_final_g': 1.0 + nrm((D_MODEL,), 0.1),
        'w_in': nrm((L, D_MODEL, P_IN), D_MODEL ** -0.5),
        'w_out': nrm((L, MIX_WIDTH, D_MODEL), MIX_WIDTH ** -0.5),
        'rwkv_mu_prev': uni((L, A_IN), 0.0, 0.5),
        'rwkv_mu_next': uni((L, A_IN), 0.0, 0.5),
        'rwkv_w0': nrm((L, N_DIR, A_WIDTH), 0.5) - 0.5,
        'rwkv_w_up': nrm((L, N_DIR, A_DECAY_LORA, A_WIDTH), 0.1),
        'rwkv_a0': nrm((L, N_DIR, A_WIDTH), 0.5),
        'rwkv_a_up': nrm((L, N_DIR, A_ICL_LORA, A_WIDTH), 0.1),
        'rwkv_g_up': nrm((L, A_GATE_LORA, A_WIDTH), A_GATE_LORA ** -0.5),
        'rwkv_k_k': 0.85 + nrm((L, A_WIDTH), 0.05),
        'rwkv_k_a': 1.0 + nrm((L, A_WIDTH), 0.05),
        'rwkv_r_k': nrm((L, A_HEADS, HEAD_DIM), 0.1),
        'rwkv_ln_w': 1.0 + nrm((L, A_WIDTH), 0.1),
        'rwkv_ln_b': nrm((L, A_WIDTH), 0.02),
        'attn_q_norm': 1.0 + nrm((L, HEAD_DIM), 0.1),
        'attn_k_norm': 1.0 + nrm((L, HEAD_DIM), 0.1),
        'gdn_conv': nrm((L, C_CONV, 3 * C_WIDTH), C_CONV ** -0.5),
        'gdn_a_log': jnp.log(uni((L, N_DIR, C_HEADS), 1.0, 16.0)),
        'gdn_dt_bias': dt + jnp.log(-jnp.expm1(-dt)),
        'gdn_norm_g': 1.0 + nrm((L, HEAD_DIM), 0.1),
        'rel_bias': nrm((REL_BUCKETS, D_HEADS), 0.5),
        'router_w': nrm((L, D_MODEL, N_EXPERTS), D_MODEL ** -0.5),
        'router_b': nrm((L, N_EXPERTS), 0.01),
        'expert_w_gate': nrm((L, N_EXPERTS, D_MODEL, D_FF_EXPERT), D_MODEL ** -0.5),
        'expert_w_up': nrm((L, N_EXPERTS, D_MODEL, D_FF_EXPERT), D_MODEL ** -0.5),
        'expert_w_down': nrm((L, N_EXPERTS, D_FF_EXPERT, D_MODEL), D_FF_EXPERT ** -0.5),
    }


def reference(x, norm_mix_g, norm_ffn_g, norm_final_g, w_in, w_out,
              rwkv_mu_prev, rwkv_mu_next, rwkv_w0, rwkv_w_up, rwkv_a0, rwkv_a_up, rwkv_g_up,
              rwkv_k_k, rwkv_k_a, rwkv_r_k, rwkv_ln_w, rwkv_ln_b,
              attn_q_norm, attn_k_norm,
              gdn_conv, gdn_a_log, gdn_dt_bias, gdn_norm_g,
              rel_bias,
              router_w, router_b, expert_w_gate, expert_w_up, expert_w_down):
    for l in range(DEPTH):
        h = rms_norm(x, norm_mix_g[l])
        p = jnp.einsum('bsd,dp->bsp', h, w_in[l])
        fa, fb, fc, fd = jnp.split(p, [A_IN, A_IN + B_IN, A_IN + B_IN + C_IN], axis=-1)
        ya = rwkv7_mixer(fa, rwkv_mu_prev[l], rwkv_mu_next[l], rwkv_w0[l], rwkv_w_up[l], rwkv_a0[l],
                         rwkv_a_up[l], rwkv_g_up[l], rwkv_k_k[l], rwkv_k_a[l], rwkv_r_k[l],
                         rwkv_ln_w[l], rwkv_ln_b[l])
        yb = gqa_axial_mixer(fb, attn_q_norm[l], attn_k_norm[l])
        yc = gated_deltanet_mixer(fc, gdn_conv[l], gdn_a_log[l], gdn_dt_bias[l], gdn_norm_g[l])
        yd = dilated_window_mixer(fd, rel_bias)
        mixed = jnp.concatenate([ya, yb, yc, yd], axis=-1)
        x = x + jnp.einsum('bsm,md->bsd', mixed, w_out[l])
        x = x + expert_choice_ffn(rms_norm(x, norm_ffn_g[l]), router_w[l], router_b[l],
                                  expert_w_gate[l], expert_w_up[l], expert_w_down[l])
    return rms_norm(x, norm_final_g)
```

```cpp
#ifdef CPU_EMU
#include <cmath>
#include <cstdint>
#include <cstring>
#include <cstdio>
#include <cstdlib>
#define DEVFN static inline
#define GRID_SYNC() _Pragma("omp barrier")
#else
#include <hip/hip_runtime.h>
#include <hip/hip_cooperative_groups.h>
#include <cstdio>
#include <cstdint>
#include <cstring>
namespace cg = cooperative_groups;
#define DEVFN __device__ __forceinline__
#define GRID_SYNC() cg::this_grid().sync()
#endif

#ifndef NB
#define NB 8
#endif
#ifndef NS
#define NS 4096
#endif
#define MROWS (NB * NS)
#define DM 1024
#define PIN 3728
#define MIXW 1152
#define NEXP 16
#define CAP (2 * NS / NEXP)
#define NPAIR (NB * NEXP * CAP)

typedef unsigned short bf16_t;

DEVFN float bf2f(bf16_t v) { unsigned u = ((unsigned)v) << 16; float f; memcpy(&f, &u, 4); return f; }
DEVFN bf16_t f2bf(float f) { unsigned u; memcpy(&u, &f, 4); u = (u + 0x7fffu + ((u >> 16) & 1u)) >> 16; return (bf16_t)u; }
DEVFN float sigmoidf_(float x) { return 1.0f / (1.0f + expf(-x)); }
DEVFN float softplusf_(float x) { return (x > 0.f ? x : 0.f) + log1pf(expf(-fabsf(x))); }
DEVFN float siluf_(float x) { return x * sigmoidf_(x); }
DEVFN float bfpair(unsigned w, int odd) { unsigned u = odd ? (w & 0xffff0000u) : (w << 16); float f; memcpy(&f, &u, 4); return f; }
#define MEMBAR() asm volatile("" ::: "memory")
#ifdef CPU_EMU
#define OPAQUE(x) asm volatile("" : "+r"(x))
#else
#define OPAQUE(x) asm volatile("" : "+v"(x))
#endif
#ifdef CPU_EMU
DEVFN float fsin_(float x) { return sinf(x); }
DEVFN float fcos_(float x) { return cosf(x); }
#else
DEVFN float fsin_(float x) { return __sinf(x); }
DEVFN float fcos_(float x) { return __cosf(x); }
#endif

struct Params {
    const float *x, *norm_mix_g, *norm_ffn_g, *norm_final_g, *w_in, *w_out, *mu_prev, *mu_next, *w0, *w_up, *a0, *a_up, *g_up,
        *k_k, *k_a, *r_k, *ln_w, *ln_b, *q_norm, *k_norm, *conv, *a_log, *dt_bias, *gdn_norm_g, *rel_bias, *router_w, *router_b,
        *w_gate, *w_upx, *w_down;
    float* out;
    bf16_t *XN, *PA, *PB, *PC, *PD, *AP, *LT, *GA, *CP, *YA, *OC, *MIX, *HID, *YS;
    float *RN, *BON, *CBG, *ML, *RS, *AFF, *GATE;
    int *SLOT, *IDX;
    int pad0, pad1;
};

#define WS_ROW_BYTES 16932

DEVFN void ph_rowrs(const float* x, float* rs, long gid, long gs) {
    for (long r = gid; r < MROWS; r += gs) {
        const float* xr = x + r * DM; float s = 0.f;
        for (int c = 0; c < DM; ++c) s += xr[c] * xr[c];
        rs[r] = 1.0f / sqrtf(s * (1.0f / DM) + 1e-6f);
    }
}
DEVFN void ph_norm_bf16(const float* x, const float* rs, const float* g, bf16_t* o, long gid, long gs) {
    for (long i = gid; i < (long)MROWS * DM; i += gs) { long r = i / DM; int c = (int)(i % DM); o[i] = f2bf(x[i] * rs[r] * g[c]); }
}
DEVFN void ph_gemm_in(const Params& P, int l, long gid, long gs) {
    const float* W = P.w_in + (size_t)l * DM * PIN;
    for (long it = gid; it < (long)(MROWS / 8) * PIN; it += gs) {
        const long rg = it / PIN; const int c = (int)(it % PIN);
        float acc[8];
#pragma unroll
        for (int j = 0; j < 8; ++j) acc[j] = 0.f;
        const bf16_t* a = P.XN + rg * 8 * DM;
        for (int k = 0; k < DM; ++k) {
            const float w = W[(size_t)k * PIN + c];
#pragma unroll
            for (int j = 0; j < 8; ++j) acc[j] += bf2f(a[j * DM + k]) * w;
        }
        bf16_t* dst; int pitch, cc;
        if (c < 1024) { dst = P.PA; pitch = 1024; cc = c; }
        else if (c < 1536) { dst = P.PB; pitch = 512; cc = c - 1024; }
        else if (c < 2560) { dst = P.PC; pitch = 1024; cc = c - 1536; }
        else if (c < 2576) { dst = P.PD; pitch = 1280; cc = 1152 + (c - 2560); }
        else { dst = P.PD; pitch = 1280; cc = c - 2576; }
#pragma unroll
        for (int j = 0; j < 8; ++j) dst[(rg * 8 + j) * pitch + cc] = f2bf(acc[j]);
    }
}
DEVFN void ph_prepA_shift(const Params& P, int l, long gid, long gs) {
    const float* mp = P.mu_prev + l * 1024; const float* mn = P.mu_next + l * 1024;
    for (long i = gid; i < (long)MROWS * 1024; i += gs) {
        const long t = i / 1024; const int c = (int)(i % 1024); const int s = (int)(t % NS);
        const float f = bf2f(P.PA[i]);
        const float pv = s > 0 ? bf2f(P.PA[i - 1024]) : 0.f;
        const float nx = s < NS - 1 ? bf2f(P.PA[i + 1024]) : 0.f;
        const float o = f + mp[c] * (pv - f) + mn[c] * (nx - f);
        if (c < 768) P.AP[t * 1792 + c] = f2bf(o); else P.LT[t * 256 + (c - 768)] = f2bf(o);
    }
}
DEVFN void ph_prepA_lora(const Params& P, int l, long gid, long gs) {
    const float* w0 = P.w0 + l * 512; const float* a0 = P.a0 + l * 512;
    const float* wu = P.w_up + (size_t)l * 2 * 64 * 256; const float* au = P.a_up + (size_t)l * 2 * 64 * 256; const float* gu = P.g_up + (size_t)l * 128 * 256;
    for (long i = gid; i < (long)MROWS * 256; i += gs) {
        const long t = i / 256; const int c = (int)(i % 256);
        const bf16_t* lt = P.LT + t * 256;
        float aw0 = 0.f, aw1 = 0.f, aa0 = 0.f, aa1 = 0.f, ag = 0.f;
        for (int r = 0; r < 64; ++r) {
            const float tw = tanhf(bf2f(lt[r])); const float ad = bf2f(lt[64 + r]);
            aw0 += tw * wu[r * 256 + c]; aw1 += tw * wu[(64 + r) * 256 + c];
            aa0 += ad * au[r * 256 + c]; aa1 += ad * au[(64 + r) * 256 + c];
        }
        for (int r = 0; r < 128; ++r) ag += sigmoidf_(bf2f(lt[128 + r])) * gu[r * 256 + c];
        bf16_t* ap = P.AP + t * 1792;
        ap[768 + c] = f2bf(0.6065306597f * sigmoidf_(w0[c] + aw0));
        ap[1024 + c] = f2bf(0.6065306597f * sigmoidf_(w0[256 + c] + aw1));
        ap[1280 + c] = f2bf(sigmoidf_(a0[c] + aa0));
        ap[1536 + c] = f2bf(sigmoidf_(a0[256 + c] + aa1));
        P.GA[i] = f2bf(ag);
    }
}
DEVFN void ph_prepA_rn(const Params& P, int l, long gid, long gs) {
    const float* kk = P.k_k + l * 256; const float* ka = P.k_a + l * 256; const float* rk = P.r_k + l * 256;
    for (long i = gid; i < (long)MROWS * 4; i += gs) {
        const long t = i / 4; const int h = (int)(i % 4); const bf16_t* ap = P.AP + t * 1792;
        float s = 0.f, bo = 0.f;
        for (int j = 0; j < 64; ++j) {
            const int c = h * 64 + j; const float k = bf2f(ap[256 + c]); const float kx = k * kk[c]; s += kx * kx;
            const float am = 0.5f * (bf2f(ap[1280 + c]) + bf2f(ap[1536 + c]));
            bo += bf2f(ap[c]) * (k * (1.0f + (am - 1.0f) * ka[c])) * rk[c];
        }
        P.RN[i] = 1.0f / sqrtf(s + 1e-12f); P.BON[i] = bo;
    }
}
DEVFN void ph_prepB(const Params& P, int l, long gid, long gs) {
    for (long i = gid; i < (long)MROWS * 6; i += gs) {
        const long t = i / 6; const int hh = (int)(i % 6); const int s = (int)(t % NS);
        bf16_t* p = P.PB + t * 512 + hh * 64; const float* g = (hh < 4 ? P.q_norm : P.k_norm) + l * 64;
        float v[64]; float ss = 0.f;
#pragma unroll
        for (int j = 0; j < 64; ++j) { v[j] = bf2f(p[j]); ss += v[j] * v[j]; }
        const float rs = 1.0f / sqrtf(ss * (1.0f / 64) + 1e-6f);
#pragma unroll
        for (int j = 0; j < 64; ++j) v[j] = v[j] * rs * g[j];
        const float sc = hh < 4 ? 0.125f * 1.4426950408889634f : 1.0f;
        const float rowid = (float)(s / 64), colid = (float)(s % 64);
#pragma unroll
        for (int j = 0; j < 16; ++j) {
            const float inv = exp2f(-(float)j * 0.8304820237218406f);
            const float ar = rowid * inv, ac = colid * inv; const float cr = fcos_(ar), sr = fsin_(ar), cc = fcos_(ac), sc2 = fsin_(ac);
            const float x1 = v[j], x2 = v[16 + j]; p[j] = f2bf((x1 * cr - x2 * sr) * sc); p[16 + j] = f2bf((x2 * cr + x1 * sr) * sc);
            const float y1 = v[32 + j], y2 = v[48 + j]; p[32 + j] = f2bf((y1 * cc - y2 * sc2) * sc); p[48 + j] = f2bf((y2 * cc + y1 * sc2) * sc);
        }
    }
}
DEVFN void ph_prepC_conv(const Params& P, int l, long gid, long gs) {
    const float* cw = P.conv + (size_t)l * 5 * 768;
    for (long i = gid; i < (long)MROWS * 12; i += gs) {
        const long t = i / 12; const int g = (int)(i % 12); const int s = (int)(t % NS);
        float v[64]; float ss = 0.f;
#pragma unroll
        for (int j = 0; j < 64; ++j) {
            const int c = g * 64 + j; float a = 0.f;
#pragma unroll
            for (int q = 0; q < 5; ++q) { const int sq = s + q - 2; if (sq >= 0 && sq < NS) a += bf2f(P.PC[(t + q - 2) * 1024 + c]) * cw[q * 768 + c]; }
            a = siluf_(a); v[j] = a; ss += a * a;
        }
        float sc = 1.0f;
        if (g < 8) sc = 1.0f / sqrtf(ss + 1e-12f);
        if (g < 4) sc *= 0.125f;
#pragma unroll
        for (int j = 0; j < 64; ++j) P.CP[t * 768 + g * 64 + j] = f2bf(v[j] * sc);
    }
}
DEVFN void ph_prepC_bg(const Params& P, int l, long gid, long gs) {
    for (long i = gid; i < (long)MROWS * 8; i += gs) {
        const long t = i / 8; const int dh = (int)(i % 8);
        const float b = bf2f(P.PD[t * 1280 + 1152 + dh]), al = bf2f(P.PD[t * 1280 + 1160 + dh]);
        P.CBG[t * 16 + dh] = sigmoidf_(b);
        P.CBG[t * 16 + 8 + dh] = -expf(P.a_log[l * 8 + dh]) * softplusf_(al + P.dt_bias[l * 8 + dh]);
    }
}
DEVFN void ph_scanA(const Params& P, int l, long gid, long gs) {
    const float* kkp = P.k_k + l * 256; const float* kap = P.k_a + l * 256;
    for (long it = gid; it < (long)2 * NB * 4 * 64; it += gs) {
        const int v = (int)(it % 64), h = (int)((it / 64) % 4), b = (int)((it / 256) % NB), d = (int)(it / (256 * NB));
        float S[64];
#pragma unroll
        for (int j = 0; j < 64; ++j) S[j] = 0.f;
        for (int s = 0; s < NS; ++s) {
            MEMBAR();
            const long t = (long)b * NS + (d == 0 ? s : NS - 1 - s);
            const bf16_t* ap = P.AP + t * 1792 + h * 64; const float rn = P.RN[t * 4 + h];
            const float vv = bf2f(ap[512 + v]);
            float sa = 0.f;
#pragma unroll
            for (int j0 = 0; j0 < 64; j0 += 16) {
#pragma unroll
                for (int j = j0; j < j0 + 16; ++j) sa += S[j] * (bf2f(ap[256 + j]) * kkp[h * 64 + j] * rn);
                MEMBAR();
            }
            sa = -sa; float y = 0.f;
#pragma unroll
            for (int j0 = 0; j0 < 64; j0 += 8) {
#pragma unroll
                for (int j = j0; j < j0 + 8; ++j) {
                    const float k = bf2f(ap[256 + j]); const float kkv = k * kkp[h * 64 + j] * rn;
                    const float a = bf2f(ap[1280 + d * 256 + j]); const float w = expf(-bf2f(ap[768 + d * 256 + j]));
                    const float kx = k * (1.0f + (a - 1.0f) * kap[h * 64 + j]);
                    S[j] = S[j] * w + sa * (kkv * a) + vv * kx;
                    y += S[j] * bf2f(ap[j]);
                }
                MEMBAR();
            }
            P.YA[((size_t)d * MROWS + t) * 256 + h * 64 + v] = f2bf(y);
        }
    }
}
DEVFN void ph_scanC(const Params& P, int l, long gid, long gs) {
    for (long it = gid; it < (long)2 * NB * 4 * 64; it += gs) {
        const int v = (int)(it % 64), h = (int)((it / 64) % 4), b = (int)((it / 256) % NB), d = (int)(it / (256 * NB));
        float S[64];
#pragma unroll
        for (int j = 0; j < 64; ++j) S[j] = 0.f;
        for (int s = 0; s < NS; ++s) {
            MEMBAR();
            const long t = (long)b * NS + (d == 0 ? s : NS - 1 - s);
            const bf16_t* cp = P.CP + t * 768 + h * 64;
            const float beta = P.CBG[t * 16 + d * 4 + h], eg = expf(P.CBG[t * 16 + 8 + d * 4 + h]);
            float pred = 0.f;
#pragma unroll
            for (int j0 = 0; j0 < 64; j0 += 16) {
#pragma unroll
                for (int j = j0; j < j0 + 16; ++j) pred += S[j] * bf2f(cp[256 + j]);
                MEMBAR(); }
            const float dd = beta * (bf2f(cp[512 + v]) - eg * pred); float o = 0.f;
#pragma unroll
            for (int j0 = 0; j0 < 64; j0 += 16) {
#pragma unroll
                for (int j = j0; j < j0 + 16; ++j) { S[j] = S[j] * eg + dd * bf2f(cp[256 + j]); o += S[j] * bf2f(cp[j]); }
                MEMBAR(); }
            P.OC[((size_t)d * MROWS + t) * 256 + h * 64 + v] = f2bf(o);
        }
    }
}
DEVFN void ph_attnB(const Params& P, long gid, long gs) {
    for (long it = gid; it < (long)NB * 4 * NS; it += gs) {
        const int s = (int)(it % NS), h = (int)((it / NS) % 4), b = (int)(it / (4 * NS)); const int g = h / 2;
        const long t = (long)b * NS + s;
        unsigned q2[32]; float acc[64];
#pragma unroll
        for (int j = 0; j < 32; ++j) { memcpy(&q2[j], P.PB + t * 512 + h * 64 + 2 * j, 4); acc[2 * j] = 0.f; acc[2 * j + 1] = 0.f; }
        float m = -1e30f, lsum = 0.f;
        for (int kx = 0; kx < NS; ++kx) {
            const bf16_t* kp = P.PB + ((long)b * NS + kx) * 512 + 256 + g * 64; const bf16_t* vp = kp + 128;
            float sc = 0.f;
#pragma unroll
            for (int j = 0; j < 32; ++j) OPAQUE(q2[j]);
#pragma unroll
            for (int j0 = 0; j0 < 64; j0 += 16) {
#pragma unroll
                for (int j = j0; j < j0 + 16; ++j) sc += bfpair(q2[j >> 1], j & 1) * bf2f(kp[j]);
                MEMBAR(); }
            if (sc > m) { const float f = exp2f(m - sc); lsum *= f;
#pragma unroll
                for (int j = 0; j < 64; ++j) acc[j] *= f;
                m = sc; }
            const float p = exp2f(sc - m); lsum += p;
#pragma unroll
            for (int j0 = 0; j0 < 64; j0 += 16) {
#pragma unroll
                for (int j = j0; j < j0 + 16; ++j) acc[j] += p * bf2f(vp[j]);
                MEMBAR(); }
        }
        const float il = 1.0f / lsum;
#pragma unroll
        for (int j = 0; j < 64; ++j) P.MIX[t * MIXW + 256 + h * 64 + j] = f2bf(acc[j] * il);
    }
}
DEVFN int t5_bucket(int rel) {
    const int n = rel < 0 ? -rel : rel; int v;
    if (n < 8) v = n; else { int lg = 8 + (int)(logf((float)n / 8.0f) / 4.852030263919617f * 8.0f); v = lg < 15 ? lg : 15; }
    return (rel > 0 ? 16 : 0) + v;
}
DEVFN void ph_attnD(const Params& P, long gid, long gs) {
    for (long it = gid; it < (long)NB * 6 * NS; it += gs) {
        const int s = (int)(it % NS), hd = (int)((it / NS) % 6), b = (int)(it / (6 * NS)); const int br = hd / 2; const int dil = br == 0 ? 1 : (br == 1 ? 4 : 16);
        const long t = (long)b * NS + s;
        unsigned q2[32]; float acc[64];
#pragma unroll
        for (int j = 0; j < 32; ++j) { memcpy(&q2[j], P.PD + t * 1280 + hd * 64 + 2 * j, 4); acc[2 * j] = 0.f; acc[2 * j + 1] = 0.f; }
        float m = -1e30f, lsum = 0.f;
        for (int jj = -64; jj <= 64; ++jj) {
            const int sk = s + jj * dil; if (sk < 0 || sk >= NS) continue;
            const bf16_t* kp = P.PD + ((long)b * NS + sk) * 1280 + 384 + hd * 64; const bf16_t* vp = kp + 384;
            float sc = 0.f;
#pragma unroll
            for (int j = 0; j < 32; ++j) OPAQUE(q2[j]);
#pragma unroll
            for (int j0 = 0; j0 < 64; j0 += 16) {
#pragma unroll
                for (int j = j0; j < j0 + 16; ++j) sc += bfpair(q2[j >> 1], j & 1) * bf2f(kp[j]);
                MEMBAR(); }
            sc = sc * 0.125f + P.rel_bias[t5_bucket(jj * dil) * 6 + hd];
            if (sc > m) { const float f = expf(m - sc); lsum *= f;
#pragma unroll
                for (int j = 0; j < 64; ++j) acc[j] *= f;
                m = sc; }
            const float p = expf(sc - m); lsum += p;
#pragma unroll
            for (int j0 = 0; j0 < 64; j0 += 16) {
#pragma unroll
                for (int j = j0; j < j0 + 16; ++j) acc[j] += p * bf2f(vp[j]);
                MEMBAR(); }
        }
        const float il = 1.0f / lsum;
#pragma unroll
        for (int j = 0; j < 64; ++j) P.MIX[t * MIXW + 768 + hd * 64 + j] = f2bf(acc[j] * il);
        P.ML[t * 12 + hd * 2] = m; P.ML[t * 12 + hd * 2 + 1] = lsum;
    }
}
DEVFN void ph_fixA(const Params& P, int l, long gid, long gs) {
    const float* lw = P.ln_w + l * 256; const float* lb = P.ln_b + l * 256;
    for (long i = gid; i < (long)MROWS * 4; i += gs) {
        const long t = i / 4; const int h = (int)(i % 4);
        float y[64]; float mean = 0.f;
#pragma unroll
        for (int j = 0; j < 64; ++j) { y[j] = bf2f(P.YA[t * 256 + h * 64 + j]) + bf2f(P.YA[((size_t)MROWS + t) * 256 + h * 64 + j]); mean += y[j]; }
        mean *= (1.0f / 64); float var = 0.f;
#pragma unroll
        for (int j = 0; j < 64; ++j) { const float d = y[j] - mean; var += d * d; }
        const float rstd = 1.0f / sqrtf(var * (1.0f / 64) + 64e-5f); const float bo = P.BON[i];
#pragma unroll
        for (int j = 0; j < 64; ++j) { const int c = h * 64 + j;
            const float o = ((y[j] - mean) * rstd * lw[c] + lb[c] + bo * bf2f(P.AP[t * 1792 + 512 + c])) * bf2f(P.GA[t * 256 + c]);
            P.MIX[t * MIXW + c] = f2bf(o); }
    }
}
DEVFN void ph_fixC(const Params& P, int l, long gid, long gs) {
    const float* ng = P.gdn_norm_g + l * 64;
    for (long i = gid; i < (long)MROWS * 4; i += gs) {
        const long t = i / 4; const int h = (int)(i % 4);
        float o[64]; float ss = 0.f;
#pragma unroll
        for (int j = 0; j < 64; ++j) { o[j] = bf2f(P.OC[t * 256 + h * 64 + j]) + bf2f(P.OC[((size_t)MROWS + t) * 256 + h * 64 + j]); ss += o[j] * o[j]; }
        const float rs = 1.0f / sqrtf(ss * (1.0f / 64) + 1e-6f);
#pragma unroll
        for (int j = 0; j < 64; ++j) P.MIX[t * MIXW + 512 + h * 64 + j] = f2bf(o[j] * rs * ng[j] * siluf_(bf2f(P.PC[t * 1024 + 768 + h * 64 + j])));
    }
}
DEVFN void ph_fixD(const Params& P, long gid, long gs) {
    for (long i = gid; i < (long)MROWS * 2; i += gs) {
        const long t = i / 2; const int jh = (int)(i % 2);
        float m[3], lv[3]; float mx = -1e30f;
#pragma unroll
        for (int br = 0; br < 3; ++br) { m[br] = P.ML[t * 12 + (br * 2 + jh) * 2]; lv[br] = P.ML[t * 12 + (br * 2 + jh) * 2 + 1]; mx = m[br] > mx ? m[br] : mx; }
        float den[3], sum = 0.f;
#pragma unroll
        for (int br = 0; br < 3; ++br) { den[br] = lv[br] * expf(m[br] - mx); sum += den[br]; }
#pragma unroll
        for (int br = 0; br < 3; ++br) { const float w = den[br] / sum; bf16_t* p = P.MIX + t * MIXW + 768 + (br * 2 + jh) * 64;
            for (int j = 0; j < 64; ++j) p[j] = f2bf(bf2f(p[j]) * w); }
    }
}
DEVFN void ph_gemm_out(const Params& P, int l, const float* xsrc, long gid, long gs) {
    const float* W = P.w_out + (size_t)l * MIXW * DM;
    for (long it = gid; it < (long)(MROWS / 8) * DM; it += gs) {
        const long rg = it / DM; const int c = (int)(it % DM);
        float acc[8];
#pragma unroll
        for (int j = 0; j < 8; ++j) acc[j] = 0.f;
        const bf16_t* a = P.MIX + rg * 8 * MIXW;
        for (int k = 0; k < MIXW; ++k) { const float w = W[(size_t)k * DM + c];
#pragma unroll
            for (int j = 0; j < 8; ++j) acc[j] += bf2f(a[j * MIXW + k]) * w; }
#pragma unroll
        for (int j = 0; j < 8; ++j) { const size_t o = (size_t)(rg * 8 + j) * DM + c; P.out[o] = xsrc[o] + acc[j]; }
    }
}
DEVFN void ph_router(const Params& P, int l, long gid, long gs) {
    const float* g = P.norm_ffn_g + l * DM; const float* rw = P.router_w + (size_t)l * DM * NEXP; const float* rb = P.router_b + l * NEXP;
    for (long r = gid; r < MROWS; r += gs) {
        const float* xr = P.out + r * DM; float ss = 0.f; float lg[NEXP];
#pragma unroll
        for (int e = 0; e < NEXP; ++e) lg[e] = 0.f;
        for (int c = 0; c < DM; ++c) { const float xv = xr[c]; ss += xv * xv; const float xg = xv * g[c];
#pragma unroll
            for (int e = 0; e < NEXP; ++e) lg[e] += xg * rw[c * NEXP + e]; }
        const float rs = 1.0f / sqrtf(ss * (1.0f / DM) + 1e-6f); P.RS[r] = rs;
        float mx = -1e30f;
#pragma unroll
        for (int e = 0; e < NEXP; ++e) { lg[e] = lg[e] * rs + rb[e]; mx = lg[e] > mx ? lg[e] : mx; }
        float sum = 0.f;
#pragma unroll
        for (int e = 0; e < NEXP; ++e) { lg[e] = expf(lg[e] - mx); sum += lg[e]; }
#pragma unroll
        for (int e = 0; e < NEXP; ++e) P.AFF[r * NEXP + e] = lg[e] / sum;
    }
}
DEVFN void ph_topk(const Params& P, long gid, long gs) {
    for (long it = gid; it < (long)NB * NEXP * NS; it += gs) {
        const int s = (int)(it % NS), e = (int)((it / NS) % NEXP), b = (int)(it / ((long)NS * NEXP));
        const float* af = P.AFF + (size_t)b * NS * NEXP + e; const float v = af[(size_t)s * NEXP];
        int rank = 0;
        for (int s2 = 0; s2 < NS; ++s2) { const float o = af[(size_t)s2 * NEXP]; rank += (o > v || (o == v && s2 < s)) ? 1 : 0; }
        const long t = (long)b * NS + s;
        if (rank < CAP) { const long p = ((long)b * NEXP + e) * CAP + rank; P.IDX[p] = (int)t; P.GATE[p] = v; P.SLOT[t * NEXP + e] = rank; }
        else P.SLOT[t * NEXP + e] = -1;
    }
}
DEVFN void ph_gemm_gu(const Params& P, int l, long gid, long gs) {
    for (long it = gid; it < (long)(NPAIR / 8) * DM; it += gs) {
        const long pg = it / DM; const int f = (int)(it % DM); const int e = (int)((pg * 8 / CAP) % NEXP);
        const float* Wg = P.w_gate + ((size_t)l * NEXP + e) * DM * DM; const float* Wu = P.w_upx + ((size_t)l * NEXP + e) * DM * DM;
        float ag[8], au[8]; const bf16_t* a[8];
#pragma unroll
        for (int j = 0; j < 8; ++j) { ag[j] = 0.f; au[j] = 0.f; a[j] = P.XN + (size_t)P.IDX[pg * 8 + j] * DM; }
        for (int k = 0; k < DM; ++k) { const float wg = Wg[(size_t)k * DM + f], wu = Wu[(size_t)k * DM + f];
#pragma unroll
            for (int j = 0; j < 8; ++j) { const float xv = bf2f(a[j][k]); ag[j] += xv * wg; au[j] += xv * wu; } }
#pragma unroll
        for (int j = 0; j < 8; ++j) P.HID[(size_t)(pg * 8 + j) * DM + f] = f2bf(siluf_(ag[j]) * au[j]);
    }
}
DEVFN void ph_gemm_down(const Params& P, int l, long gid, long gs) {
    for (long it = gid; it < (long)(NPAIR / 8) * DM; it += gs) {
        const long pg = it / DM; const int c = (int)(it % DM); const int e = (int)((pg * 8 / CAP) % NEXP);
        const float* Wd = P.w_down + ((size_t)l * NEXP + e) * DM * DM;
        float acc[8];
#pragma unroll
        for (int j = 0; j < 8; ++j) acc[j] = 0.f;
        const bf16_t* a = P.HID + (size_t)pg * 8 * DM;
        for (int k = 0; k < DM; ++k) { const float w = Wd[(size_t)k * DM + c];
#pragma unroll
            for (int j = 0; j < 8; ++j) acc[j] += bf2f(a[j * DM + k]) * w; }
#pragma unroll
        for (int j = 0; j < 8; ++j) P.YS[(size_t)(pg * 8 + j) * DM + c] = f2bf(acc[j] * P.GATE[pg * 8 + j]);
    }
}
DEVFN void ph_combine(const Params& P, long gid, long gs) {
    for (long i = gid; i < (long)MROWS * DM; i += gs) {
        const long t = i / DM; const int c = (int)(i % DM); const int b = (int)(t / NS);
        float acc = P.out[i];
        for (int e = 0; e < NEXP; ++e) { const int sl = P.SLOT[t * NEXP + e]; if (sl >= 0) acc += bf2f(P.YS[(((size_t)b * NEXP + e) * CAP + sl) * DM + c]); }
        P.out[i] = acc;
    }
}
DEVFN void ph_final(const Params& P, long gid, long gs) {
    for (long i = gid; i < (long)MROWS * DM; i += gs) { const long r = i / DM; const int c = (int)(i % DM); P.out[i] = P.out[i] * P.RS[r] * P.norm_final_g[c]; }
}

DEVFN void forward(const Params& P, long gid, long gs) {
    for (int l = 0; l < 2; ++l) {
        const float* xsrc = l == 0 ? P.x : P.out;
        ph_rowrs(xsrc, P.RS, gid, gs); GRID_SYNC();
        ph_norm_bf16(xsrc, P.RS, P.norm_mix_g + l * DM, P.XN, gid, gs); GRID_SYNC();
        ph_gemm_in(P, l, gid, gs); GRID_SYNC();
        ph_prepA_shift(P, l, gid, gs); ph_prepB(P, l, gid, gs); ph_prepC_conv(P, l, gid, gs); ph_prepC_bg(P, l, gid, gs); GRID_SYNC();
        ph_prepA_lora(P, l, gid, gs); GRID_SYNC();
        ph_prepA_rn(P, l, gid, gs); GRID_SYNC();
        ph_scanA(P, l, gid, gs); ph_scanC(P, l, (gid + gs / 2) % gs, gs); GRID_SYNC();
        ph_attnB(P, gid, gs); ph_attnD(P, gid, gs); GRID_SYNC();
        ph_fixA(P, l, gid, gs); ph_fixC(P, l, gid, gs); ph_fixD(P, gid, gs); GRID_SYNC();
        ph_gemm_out(P, l, xsrc, gid, gs); GRID_SYNC();
        ph_router(P, l, gid, gs); GRID_SYNC();
        ph_norm_bf16(P.out, P.RS, P.norm_ffn_g + l * DM, P.XN, gid, gs); ph_topk(P, gid, gs); GRID_SYNC();
        ph_gemm_gu(P, l, gid, gs); GRID_SYNC();
        ph_gemm_down(P, l, gid, gs); GRID_SYNC();
        ph_combine(P, gid, gs); GRID_SYNC();
    }
    ph_rowrs(P.out, P.RS, gid, gs); GRID_SYNC();
    ph_final(P, gid, gs);
}

static void carve(Params& p, unsigned char* ws) {
    const size_t M = MROWS; size_t o = 0;
    auto take = [&](size_t bytes_per_row) { unsigned char* r = ws + o; o += bytes_per_row * M; return r; };
    p.XN = (bf16_t*)take(2048); p.CP = p.XN;
    unsigned char* big = ws + o;
    p.PA = (bf16_t*)take(2048); p.YA = p.PA; p.OC = p.PA + (size_t)2 * M * 256;
    p.PB = (bf16_t*)take(1024); p.PC = (bf16_t*)take(2048); p.PD = (bf16_t*)take(2560); p.AP = (bf16_t*)take(3584);
    p.HID = (bf16_t*)big; p.YS = (bf16_t*)(big + (size_t)4096 * M);
    p.LT = (bf16_t*)take(512); p.GA = (bf16_t*)take(512); p.RN = (float*)take(16); p.BON = (float*)take(16); p.CBG = (float*)take(64);
    p.ML = (float*)take(48); p.MIX = (bf16_t*)take(2304); p.RS = (float*)take(4); p.AFF = (float*)take(64); p.SLOT = (int*)take(64);
    p.IDX = (int*)take(8); p.GATE = (float*)take(8);
}
static void fill_inputs(Params& p, void* const* d_in) {
    const float** f = (const float**)&p.x;
    for (int i = 0; i < 30; ++i) f[i] = (const float*)d_in[i];
}

#ifndef CPU_EMU
__global__ void __launch_bounds__(512) mega_fwd(Params P) {
    const long gid = (long)blockIdx.x * blockDim.x + threadIdx.x, gs = (long)gridDim.x * blockDim.x;
    forward(P, gid, gs);
}

extern "C" void kernel_launch(void* const* d_in, const int* in_sizes, int n_in, void* d_out, int out_size, void* d_ws, size_t ws_size,
                              hipStream_t stream) {
    static int grid = 0;
    if (grid == 0) {
        int dev = 0, cus = 0, per_cu = 0;
        (void)hipGetDevice(&dev);
        (void)hipDeviceGetAttribute(&cus, hipDeviceAttributeMultiprocessorCount, dev);
        (void)hipOccupancyMaxActiveBlocksPerMultiprocessor(&per_cu, (const void*)mega_fwd, 512, 0);
        if (per_cu < 1) per_cu = 1;
        if (per_cu > 2) per_cu = 2;
        grid = cus * per_cu;
        if ((size_t)WS_ROW_BYTES * MROWS > ws_size) { fprintf(stderr, "workspace too small: need %zu have %zu\n", (size_t)WS_ROW_BYTES * MROWS, ws_size); }
    }
    Params p; memset(&p, 0, sizeof(p));
    fill_inputs(p, d_in);
    p.out = (float*)d_out;
    carve(p, (unsigned char*)d_ws);
    void* args[] = {&p};
    hipError_t e = hipLaunchCooperativeKernel((const void*)mega_fwd, dim3(grid), dim3(512), args, 0, stream);
    if (e != hipSuccess) fprintf(stderr, "cooperative launch failed: %s (grid %d)\n", hipGetErrorString(e), grid);
}
#endif
```

```cpp
#ifdef CPU_EMU
#include <cmath>
#include <cstdint>
#include <cstring>
#include <cstdio>
#include <cstdlib>
#define DEVFN static inline
#define GRID_SYNC() _Pragma("omp barrier")
struct Ctx { long gid, gs; };
#else
#include <hip/hip_runtime.h>
#include <hip/hip_cooperative_groups.h>
#include <cstdio>
#include <cstdint>
#include <cstring>
namespace cg = cooperative_groups;
#define DEVFN __device__ __forceinline__
#define GRID_SYNC() do { xcd_barrier(C.bar); if (KNOB_DUP & 2048) xcd_barrier(C.bar); } while (0)
#endif

#ifndef KNOB_CONVERT
#define KNOB_CONVERT 1
#endif
#ifndef KNOB_SCAN
#define KNOB_SCAN 3
#endif
#ifndef KNOB_ATTNB
#define KNOB_ATTNB 1
#endif
#ifndef KNOB_DUP
#define KNOB_DUP 0
#endif
#ifndef KNOB_SDUP
#define KNOB_SDUP 0
#endif
#ifndef KNOB_MFMA
#define KNOB_MFMA 15
#endif
#ifndef NB
#define NB 8
#endif
#ifndef NS
#define NS 4096
#endif
#define MROWS (NB * NS)
#define DM 1024
#define PIN 3728
#define MIXW 1152
#define NEXP 16
#define CAP (2 * NS / NEXP)
#define NPAIR (NB * NEXP * CAP)

typedef unsigned short bf16_t;
struct uint4v { unsigned x, y, z, w; };

DEVFN float bf2f(bf16_t v) { unsigned u = ((unsigned)v) << 16; float f; memcpy(&f, &u, 4); return f; }
DEVFN bf16_t f2bf(float f) { unsigned u; memcpy(&u, &f, 4); u = (u + 0x7fffu + ((u >> 16) & 1u)) >> 16; return (bf16_t)u; }
DEVFN float sigmoidf_(float x) { return 1.0f / (1.0f + expf(-x)); }
DEVFN float softplusf_(float x) { return (x > 0.f ? x : 0.f) + log1pf(expf(-fabsf(x))); }
DEVFN float siluf_(float x) { return x * sigmoidf_(x); }
DEVFN float bfpair(unsigned w, int odd) { unsigned u = odd ? (w & 0xffff0000u) : (w << 16); float f; memcpy(&f, &u, 4); return f; }
#define MEMBAR() asm volatile("" ::: "memory")
#ifdef CPU_EMU
#define OPAQUE(x) asm volatile("" : "+r"(x))
#else
#define OPAQUE(x) asm volatile("" : "+v"(x))
#endif
#ifdef CPU_EMU
DEVFN float fsin_(float x) { return sinf(x); }
DEVFN float fcos_(float x) { return cosf(x); }
#else
DEVFN float fsin_(float x) { return __sinf(x); }
DEVFN float fcos_(float x) { return __cosf(x); }
#endif

struct Params {
    const float *x, *norm_mix_g, *norm_ffn_g, *norm_final_g, *w_in, *w_out, *mu_prev, *mu_next, *w0, *w_up, *a0, *a_up, *g_up,
        *k_k, *k_a, *r_k, *ln_w, *ln_b, *q_norm, *k_norm, *conv, *a_log, *dt_bias, *gdn_norm_g, *rel_bias, *router_w, *router_b,
        *w_gate, *w_upx, *w_down;
    float* out;
    bf16_t *XN, *PA, *PB, *PC, *PD, *AP, *LT, *GA, *CP, *YA, *OC, *MIX, *HID, *YS, *XS, *WIN_T, *WOUT_T, *WGU_T, *WD_T, *WL_T, *ZMID, *XR;
    unsigned* CTL;
    float *RN, *BON, *CBG, *ML, *RS, *AFF, *GATE;
    int *SLOT, *IDX;
    int pad0, pad1;
};

#ifdef CPU_EMU
typedef const Params& PRef;
#else
typedef const __attribute__((address_space(3))) Params& PRef;
#endif
#define WS_ROW_BYTES 16932

DEVFN void ph_rowrs(const float* x, float* rs, long gid, long gs) {
    for (long r = gid; r < MROWS; r += gs) {
        const float* xr = x + r * DM; float s = 0.f;
        for (int c = 0; c < DM; ++c) s += xr[c] * xr[c];
        rs[r] = 1.0f / sqrtf(s * (1.0f / DM) + 1e-6f);
    }
}
DEVFN void ph_norm_bf16(const float* x, const float* rs, const float* g, bf16_t* o, long gid, long gs) {
    for (long i = gid; i < (long)MROWS * DM; i += gs) { long r = i / DM; int c = (int)(i % DM); o[i] = f2bf(x[i] * rs[r] * g[c]); }
}
DEVFN void ph_gemm_in(PRef P, int l, long gid, long gs) {
    const float* W = P.w_in + (size_t)l * DM * PIN;
    for (long it = gid; it < (long)(MROWS / 8) * PIN; it += gs) {
        const long rg = it / PIN; const int c = (int)(it % PIN);
        float acc[8];
#pragma unroll
        for (int j = 0; j < 8; ++j) acc[j] = 0.f;
        const bf16_t* a = P.XN + rg * 8 * DM;
        for (int k = 0; k < DM; ++k) {
            const float w = W[(size_t)k * PIN + c];
#pragma unroll
            for (int j = 0; j < 8; ++j) acc[j] += bf2f(a[j * DM + k]) * w;
        }
        bf16_t* dst; int pitch, cc;
        if (c < 1024) { dst = P.PA; pitch = 1024; cc = c; }
        else if (c < 1536) { dst = P.PB; pitch = 512; cc = c - 1024; }
        else if (c < 2560) { dst = P.PC; pitch = 1024; cc = c - 1536; }
        else if (c < 2576) { dst = P.PD; pitch = 1280; cc = 1152 + (c - 2560); }
        else { dst = P.PD; pitch = 1280; cc = c - 2576; }
#pragma unroll
        for (int j = 0; j < 8; ++j) dst[(rg * 8 + j) * pitch + cc] = f2bf(acc[j]);
    }
}
DEVFN void ph_prepA_shift(PRef P, int l, long gid, long gs) {
    const float* mp = P.mu_prev + l * 1024; const float* mn = P.mu_next + l * 1024;
    for (long i = gid; i < (long)MROWS * 1024; i += gs) {
        const long t = i / 1024; const int c = (int)(i % 1024); const int s = (int)(t % NS);
        const float f = bf2f(P.PA[i]);
        const float pv = s > 0 ? bf2f(P.PA[i - 1024]) : 0.f;
        const float nx = s < NS - 1 ? bf2f(P.PA[i + 1024]) : 0.f;
        const float o = f + mp[c] * (pv - f) + mn[c] * (nx - f);
        if (c < 768) P.AP[t * 1792 + c] = f2bf(o); else P.LT[t * 256 + (c - 768)] = f2bf(c < 832 ? tanhf(o) : (c < 896 ? o : sigmoidf_(o)));
    }
}
DEVFN void ph_prepA_lora(PRef P, int l, long gid, long gs) {
    const float* w0 = P.w0 + l * 512; const float* a0 = P.a0 + l * 512;
    const float* wu = P.w_up + (size_t)l * 2 * 64 * 256; const float* au = P.a_up + (size_t)l * 2 * 64 * 256; const float* gu = P.g_up + (size_t)l * 128 * 256;
    for (long i = gid; i < (long)MROWS * 256; i += gs) {
        const long t = i / 256; const int c = (int)(i % 256);
        const bf16_t* lt = P.LT + t * 256;
        float aw0 = 0.f, aw1 = 0.f, aa0 = 0.f, aa1 = 0.f, ag = 0.f;
        for (int r = 0; r < 64; ++r) {
            const float tw = bf2f(lt[r]); const float ad = bf2f(lt[64 + r]);
            aw0 += tw * wu[r * 256 + c]; aw1 += tw * wu[(64 + r) * 256 + c];
            aa0 += ad * au[r * 256 + c]; aa1 += ad * au[(64 + r) * 256 + c];
        }
        for (int r = 0; r < 128; ++r) ag += bf2f(lt[128 + r]) * gu[r * 256 + c];
        bf16_t* ap = P.AP + t * 1792;
        ap[768 + c] = f2bf(0.6065306597f * sigmoidf_(w0[c] + aw0));
        ap[1024 + c] = f2bf(0.6065306597f * sigmoidf_(w0[256 + c] + aw1));
        ap[1280 + c] = f2bf(sigmoidf_(a0[c] + aa0));
        ap[1536 + c] = f2bf(sigmoidf_(a0[256 + c] + aa1));
        P.GA[i] = f2bf(ag);
    }
}
DEVFN void ph_prepA_rn(PRef P, int l, long gid, long gs) {
    const float* kk = P.k_k + l * 256; const float* ka = P.k_a + l * 256; const float* rk = P.r_k + l * 256;
    for (long i = gid; i < (long)MROWS * 4; i += gs) {
        const long t = i / 4; const int h = (int)(i % 4); const bf16_t* ap = P.AP + t * 1792;
        float s = 0.f, bo = 0.f;
        for (int j = 0; j < 64; ++j) {
            const int c = h * 64 + j; const float k = bf2f(ap[256 + c]); const float kx = k * kk[c]; s += kx * kx;
            const float am = 0.5f * (bf2f(ap[1280 + c]) + bf2f(ap[1536 + c]));
            bo += bf2f(ap[c]) * (k * (1.0f + (am - 1.0f) * ka[c])) * rk[c];
        }
        P.RN[i] = 1.0f / sqrtf(s + 1e-12f); P.BON[i] = bo;
    }
}
DEVFN void ph_prepB(PRef P, int l, long gid, long gs) {
    for (long i = gid; i < (long)MROWS * 6; i += gs) {
        const long t = i / 6; const int hh = (int)(i % 6); const int s = (int)(t % NS);
        bf16_t* p = P.PB + t * 512 + hh * 64; const float* g = (hh < 4 ? P.q_norm : P.k_norm) + l * 64;
        float v[64]; float ss = 0.f;
#pragma unroll
        for (int j = 0; j < 64; ++j) { v[j] = bf2f(p[j]); ss += v[j] * v[j]; }
        const float rs = 1.0f / sqrtf(ss * (1.0f / 64) + 1e-6f);
#pragma unroll
        for (int j = 0; j < 64; ++j) v[j] = v[j] * rs * g[j];
        const float sc = hh < 4 ? 0.125f * 1.4426950408889634f : 1.0f;
        const float rowid = (float)(s / 64), colid = (float)(s % 64);
#pragma unroll
        for (int j = 0; j < 16; ++j) {
            const float inv = exp2f(-(float)j * 0.8304820237218406f);
            const float ar = rowid * inv, ac = colid * inv; const float cr = fcos_(ar), sr = fsin_(ar), cc = fcos_(ac), sc2 = fsin_(ac);
            const float x1 = v[j], x2 = v[16 + j]; p[j] = f2bf((x1 * cr - x2 * sr) * sc); p[16 + j] = f2bf((x2 * cr + x1 * sr) * sc);
            const float y1 = v[32 + j], y2 = v[48 + j]; p[32 + j] = f2bf((y1 * cc - y2 * sc2) * sc); p[48 + j] = f2bf((y2 * cc + y1 * sc2) * sc);
        }
    }
}
DEVFN void ph_prepC_conv(PRef P, int l, long gid, long gs) {
    const float* cw = P.conv + (size_t)l * 5 * 768;
    for (long i = gid; i < (long)MROWS * 12; i += gs) {
        const long t = i / 12; const int g = (int)(i % 12); const int s = (int)(t % NS);
        float v[64]; float ss = 0.f;
#pragma unroll
        for (int j = 0; j < 64; ++j) {
            const int c = g * 64 + j; float a = 0.f;
#pragma unroll
            for (int q = 0; q < 5; ++q) { const int sq = s + q - 2; if (sq >= 0 && sq < NS) a += bf2f(P.PC[(t + q - 2) * 1024 + c]) * cw[q * 768 + c]; }
            a = siluf_(a); v[j] = a; ss += a * a;
        }
        float sc = 1.0f;
        if (g < 8) sc = 1.0f / sqrtf(ss + 1e-12f);
        if (g < 4) sc *= 0.125f;
#pragma unroll
        for (int j = 0; j < 64; ++j) P.CP[t * 768 + g * 64 + j] = f2bf(v[j] * sc);
    }
}
DEVFN void ph_prepC_bg(PRef P, int l, long gid, long gs) {
    for (long i = gid; i < (long)MROWS * 8; i += gs) {
        const long t = i / 8; const int dh = (int)(i % 8);
        const float b = bf2f(P.PD[t * 1280 + 1152 + dh]), al = bf2f(P.PD[t * 1280 + 1160 + dh]);
        P.CBG[t * 16 + dh] = sigmoidf_(b);
        P.CBG[t * 16 + 8 + dh] = -expf(P.a_log[l * 8 + dh]) * softplusf_(al + P.dt_bias[l * 8 + dh]);
    }
}
DEVFN void ph_scanA(PRef P, int l, long gid, long gs) {
    const float* kkp = P.k_k + l * 256; const float* kap = P.k_a + l * 256;
    for (long it = gid; it < (long)2 * NB * 4 * 64; it += gs) {
        const int v = (int)(it % 64), h = (int)((it / 64) % 4), b = (int)((it / 256) % NB), d = (int)(it / (256 * NB));
        float S[64];
#pragma unroll
        for (int j = 0; j < 64; ++j) S[j] = 0.f;
        for (int s = 0; s < NS; ++s) {
            MEMBAR();
            const long t = (long)b * NS + (d == 0 ? s : NS - 1 - s);
            const bf16_t* ap = P.AP + t * 1792 + h * 64; const float rn = P.RN[t * 4 + h];
            const float vv = bf2f(ap[512 + v]);
            float sa = 0.f;
#pragma unroll
            for (int j0 = 0; j0 < 64; j0 += 16) {
#pragma unroll
                for (int j = j0; j < j0 + 16; ++j) sa += S[j] * (bf2f(ap[256 + j]) * kkp[h * 64 + j] * rn);
                MEMBAR();
            }
            sa = -sa; float y = 0.f;
#pragma unroll
            for (int j0 = 0; j0 < 64; j0 += 8) {
#pragma unroll
                for (int j = j0; j < j0 + 8; ++j) {
                    const float k = bf2f(ap[256 + j]); const float kkv = k * kkp[h * 64 + j] * rn;
                    const float a = bf2f(ap[1280 + d * 256 + j]); const float w = expf(-bf2f(ap[768 + d * 256 + j]));
                    const float kx = k * (1.0f + (a - 1.0f) * kap[h * 64 + j]);
                    S[j] = S[j] * w + sa * (kkv * a) + vv * kx;
                    y += S[j] * bf2f(ap[j]);
                }
                MEMBAR();
            }
            P.YA[((size_t)d * MROWS + t) * 256 + h * 64 + v] = f2bf(y);
        }
    }
}
DEVFN void ph_scanC(PRef P, int l, long gid, long gs) {
    for (long it = gid; it < (long)2 * NB * 4 * 64; it += gs) {
        const int v = (int)(it % 64), h = (int)((it / 64) % 4), b = (int)((it / 256) % NB), d = (int)(it / (256 * NB));
        float S[64];
#pragma unroll
        for (int j = 0; j < 64; ++j) S[j] = 0.f;
        for (int s = 0; s < NS; ++s) {
            MEMBAR();
            const long t = (long)b * NS + (d == 0 ? s : NS - 1 - s);
            const bf16_t* cp = P.CP + t * 768 + h * 64;
            const float beta = P.CBG[t * 16 + d * 4 + h], eg = expf(P.CBG[t * 16 + 8 + d * 4 + h]);
            float pred = 0.f;
#pragma unroll
            for (int j0 = 0; j0 < 64; j0 += 16) {
#pragma unroll
                for (int j = j0; j < j0 + 16; ++j) pred += S[j] * bf2f(cp[256 + j]);
                MEMBAR(); }
            const float dd = beta * (bf2f(cp[512 + v]) - eg * pred); float o = 0.f;
#pragma unroll
            for (int j0 = 0; j0 < 64; j0 += 16) {
#pragma unroll
                for (int j = j0; j < j0 + 16; ++j) { S[j] = S[j] * eg + dd * bf2f(cp[256 + j]); o += S[j] * bf2f(cp[j]); }
                MEMBAR(); }
            P.OC[((size_t)d * MROWS + t) * 256 + h * 64 + v] = f2bf(o);
        }
    }
}
DEVFN void ph_attnB(PRef P, long gid, long gs) {
    for (long it = gid; it < (long)NB * 4 * NS; it += gs) {
        const int s = (int)(it % NS), h = (int)((it / NS) % 4), b = (int)(it / (4 * NS)); const int g = h / 2;
        const long t = (long)b * NS + s;
        unsigned q2[32]; float acc[64];
#pragma unroll
        for (int j = 0; j < 32; ++j) { memcpy(&q2[j], P.PB + t * 512 + h * 64 + 2 * j, 4); acc[2 * j] = 0.f; acc[2 * j + 1] = 0.f; }
        float m = -1e30f, lsum = 0.f;
        for (int kx = 0; kx < NS; ++kx) {
            const bf16_t* kp = P.PB + ((long)b * NS + kx) * 512 + 256 + g * 64; const bf16_t* vp = kp + 128;
            float sc = 0.f;
#pragma unroll
            for (int j = 0; j < 32; ++j) OPAQUE(q2[j]);
#pragma unroll
            for (int j0 = 0; j0 < 64; j0 += 16) {
#pragma unroll
                for (int j = j0; j < j0 + 16; ++j) sc += bfpair(q2[j >> 1], j & 1) * bf2f(kp[j]);
                MEMBAR(); }
            if (sc > m) { const float f = exp2f(m - sc); lsum *= f;
#pragma unroll
                for (int j = 0; j < 64; ++j) acc[j] *= f;
                m = sc; }
            const float p = exp2f(sc - m); lsum += p;
#pragma unroll
            for (int j0 = 0; j0 < 64; j0 += 16) {
#pragma unroll
                for (int j = j0; j < j0 + 16; ++j) acc[j] += p * bf2f(vp[j]);
                MEMBAR(); }
        }
        const float il = 1.0f / lsum;
#pragma unroll
        for (int j = 0; j < 64; ++j) P.MIX[t * MIXW + 256 + h * 64 + j] = f2bf(acc[j] * il);
    }
}
DEVFN int t5_bucket(int rel) {
    const int n = rel < 0 ? -rel : rel; int v;
    if (n < 8) v = n; else { int lg = 8 + (int)(logf((float)n / 8.0f) / 4.852030263919617f * 8.0f); v = lg < 15 ? lg : 15; }
    return (rel > 0 ? 16 : 0) + v;
}
DEVFN void ph_attnD(PRef P, long gid, long gs) {
    for (long it = gid; it < (long)NB * 6 * NS; it += gs) {
        const int s = (int)(it % NS), hd = (int)((it / NS) % 6), b = (int)(it / (6 * NS)); const int br = hd / 2; const int dil = br == 0 ? 1 : (br == 1 ? 4 : 16);
        const long t = (long)b * NS + s;
        unsigned q2[32]; float acc[64];
#pragma unroll
        for (int j = 0; j < 32; ++j) { memcpy(&q2[j], P.PD + t * 1280 + hd * 64 + 2 * j, 4); acc[2 * j] = 0.f; acc[2 * j + 1] = 0.f; }
        float m = -1e30f, lsum = 0.f;
        for (int jj = -64; jj <= 64; ++jj) {
            const int sk = s + jj * dil; if (sk < 0 || sk >= NS) continue;
            const bf16_t* kp = P.PD + ((long)b * NS + sk) * 1280 + 384 + hd * 64; const bf16_t* vp = kp + 384;
            float sc = 0.f;
#pragma unroll
            for (int j = 0; j < 32; ++j) OPAQUE(q2[j]);
#pragma unroll
            for (int j0 = 0; j0 < 64; j0 += 16) {
#pragma unroll
                for (int j = j0; j < j0 + 16; ++j) sc += bfpair(q2[j >> 1], j & 1) * bf2f(kp[j]);
                MEMBAR(); }
            sc = sc * 0.125f + P.rel_bias[t5_bucket(jj * dil) * 6 + hd];
            if (sc > m) { const float f = expf(m - sc); lsum *= f;
#pragma unroll
                for (int j = 0; j < 64; ++j) acc[j] *= f;
                m = sc; }
            const float p = expf(sc - m); lsum += p;
#pragma unroll
            for (int j0 = 0; j0 < 64; j0 += 16) {
#pragma unroll
                for (int j = j0; j < j0 + 16; ++j) acc[j] += p * bf2f(vp[j]);
                MEMBAR(); }
        }
        const float il = 1.0f / lsum;
#pragma unroll
        for (int j = 0; j < 64; ++j) P.MIX[t * MIXW + 768 + hd * 64 + j] = f2bf(acc[j] * il);
        P.ML[t * 12 + hd * 2] = m; P.ML[t * 12 + hd * 2 + 1] = lsum;
    }
}
DEVFN void ph_fixA(PRef P, int l, long gid, long gs) {
    const float* lw = P.ln_w + l * 256; const float* lb = P.ln_b + l * 256;
    for (long i = gid; i < (long)MROWS * 4; i += gs) {
        const long t = i / 4; const int h = (int)(i % 4);
        float y[64]; float mean = 0.f;
#pragma unroll
        for (int j = 0; j < 64; ++j) { y[j] = bf2f(P.YA[t * 256 + h * 64 + j]) + bf2f(P.YA[((size_t)MROWS + t) * 256 + h * 64 + j]); mean += y[j]; }
        mean *= (1.0f / 64); float var = 0.f;
#pragma unroll
        for (int j = 0; j < 64; ++j) { const float d = y[j] - mean; var += d * d; }
        const float rstd = 1.0f / sqrtf(var * (1.0f / 64) + 64e-5f); const float bo = P.BON[i];
#pragma unroll
        for (int j = 0; j < 64; ++j) { const int c = h * 64 + j;
            const float o = ((y[j] - mean) * rstd * lw[c] + lb[c] + bo * bf2f(P.AP[t * 1792 + 512 + c])) * bf2f(P.GA[t * 256 + c]);
            P.MIX[t * MIXW + c] = f2bf(o); }
    }
}
DEVFN void ph_fixC(PRef P, int l, long gid, long gs) {
    const float* ng = P.gdn_norm_g + l * 64;
    for (long i = gid; i < (long)MROWS * 4; i += gs) {
        const long t = i / 4; const int h = (int)(i % 4);
        float o[64]; float ss = 0.f;
#pragma unroll
        for (int j = 0; j < 64; ++j) { o[j] = bf2f(P.OC[t * 256 + h * 64 + j]) + bf2f(P.OC[((size_t)MROWS + t) * 256 + h * 64 + j]); ss += o[j] * o[j]; }
        const float rs = 1.0f / sqrtf(ss * (1.0f / 64) + 1e-6f);
#pragma unroll
        for (int j = 0; j < 64; ++j) P.MIX[t * MIXW + 512 + h * 64 + j] = f2bf(o[j] * rs * ng[j] * siluf_(bf2f(P.PC[t * 1024 + 768 + h * 64 + j])));
    }
}
DEVFN void ph_fixD(PRef P, long gid, long gs) {
    for (long i = gid; i < (long)MROWS * 2; i += gs) {
        const long t = i / 2; const int jh = (int)(i % 2);
        float m[3], lv[3]; float mx = -1e30f;
#pragma unroll
        for (int br = 0; br < 3; ++br) { m[br] = P.ML[t * 12 + (br * 2 + jh) * 2]; lv[br] = P.ML[t * 12 + (br * 2 + jh) * 2 + 1]; mx = m[br] > mx ? m[br] : mx; }
        float den[3], sum = 0.f;
#pragma unroll
        for (int br = 0; br < 3; ++br) { den[br] = lv[br] * expf(m[br] - mx); sum += den[br]; }
#pragma unroll
        for (int br = 0; br < 3; ++br) { const float w = den[br] / sum; bf16_t* p = P.MIX + t * MIXW + 768 + (br * 2 + jh) * 64;
            for (int j = 0; j < 64; ++j) p[j] = f2bf(bf2f(p[j]) * w); }
    }
}
DEVFN void ph_gemm_out(PRef P, int l, const float* xsrc, long gid, long gs) {
    const float* W = P.w_out + (size_t)l * MIXW * DM;
    for (long it = gid; it < (long)(MROWS / 8) * DM; it += gs) {
        const long rg = it / DM; const int c = (int)(it % DM);
        float acc[8];
#pragma unroll
        for (int j = 0; j < 8; ++j) acc[j] = 0.f;
        const bf16_t* a = P.MIX + rg * 8 * MIXW;
        for (int k = 0; k < MIXW; ++k) { const float w = W[(size_t)k * DM + c];
#pragma unroll
            for (int j = 0; j < 8; ++j) acc[j] += bf2f(a[j * MIXW + k]) * w; }
#pragma unroll
        for (int j = 0; j < 8; ++j) { const size_t o = (size_t)(rg * 8 + j) * DM + c; P.out[o] = xsrc[o] + acc[j]; }
    }
}
DEVFN void ph_router(PRef P, int l, long gid, long gs) {
    const float* g = P.norm_ffn_g + l * DM; const float* rw = P.router_w + (size_t)l * DM * NEXP; const float* rb = P.router_b + l * NEXP;
    for (long r = gid; r < MROWS; r += gs) {
        const float* xr = P.out + r * DM; float ss = 0.f; float lg[NEXP];
#pragma unroll
        for (int e = 0; e < NEXP; ++e) lg[e] = 0.f;
        for (int c = 0; c < DM; ++c) { const float xv = xr[c]; ss += xv * xv; const float xg = xv * g[c];
#pragma unroll
            for (int e = 0; e < NEXP; ++e) lg[e] += xg * rw[c * NEXP + e]; }
        const float rs = 1.0f / sqrtf(ss * (1.0f / DM) + 1e-6f); P.RS[r] = rs;
        float mx = -1e30f;
#pragma unroll
        for (int e = 0; e < NEXP; ++e) { lg[e] = lg[e] * rs + rb[e]; mx = lg[e] > mx ? lg[e] : mx; }
        float sum = 0.f;
#pragma unroll
        for (int e = 0; e < NEXP; ++e) { lg[e] = expf(lg[e] - mx); sum += lg[e]; }
#pragma unroll
        for (int e = 0; e < NEXP; ++e) P.AFF[r * NEXP + e] = lg[e] / sum;
    }
}
DEVFN void ph_topk(PRef P, long gid, long gs) {
    for (long it = gid; it < (long)NB * NEXP * NS; it += gs) {
        const int s = (int)(it % NS), e = (int)((it / NS) % NEXP), b = (int)(it / ((long)NS * NEXP));
        const float* af = P.AFF + (size_t)b * NS * NEXP + e; const float v = af[(size_t)s * NEXP];
        int rank = 0;
        for (int s2 = 0; s2 < NS; ++s2) { const float o = af[(size_t)s2 * NEXP]; rank += (o > v || (o == v && s2 < s)) ? 1 : 0; }
        const long t = (long)b * NS + s;
        if (rank < CAP) { const long p = ((long)e * NB + b) * CAP + rank; P.IDX[p] = (int)t; P.GATE[p] = v; P.SLOT[t * NEXP + e] = rank; }
        else P.SLOT[t * NEXP + e] = -1;
    }
}
DEVFN void ph_gemm_gu(PRef P, int l, long gid, long gs) {
    for (long it = gid; it < (long)(NPAIR / 8) * DM; it += gs) {
        const long pg = it / DM; const int f = (int)(it % DM); const int e = (int)(pg * 8 / ((long)CAP * NB));
        const float* Wg = P.w_gate + ((size_t)l * NEXP + e) * DM * DM; const float* Wu = P.w_upx + ((size_t)l * NEXP + e) * DM * DM;
        float ag[8], au[8]; const bf16_t* a[8];
#pragma unroll
        for (int j = 0; j < 8; ++j) { ag[j] = 0.f; au[j] = 0.f; a[j] = P.XS + (size_t)(pg * 8 + j) * DM; }
        for (int k = 0; k < DM; ++k) { const float wg = Wg[(size_t)k * DM + f], wu = Wu[(size_t)k * DM + f];
#pragma unroll
            for (int j = 0; j < 8; ++j) { const float xv = bf2f(a[j][k]); ag[j] += xv * wg; au[j] += xv * wu; } }
#pragma unroll
        for (int j = 0; j < 8; ++j) P.HID[(size_t)(pg * 8 + j) * DM + f] = f2bf(siluf_(ag[j]) * au[j]);
    }
}
DEVFN void ph_gemm_down(PRef P, int l, long gid, long gs) {
    for (long it = gid; it < (long)(NPAIR / 8) * DM; it += gs) {
        const long pg = it / DM; const int c = (int)(it % DM); const int e = (int)(pg * 8 / ((long)CAP * NB));
        const float* Wd = P.w_down + ((size_t)l * NEXP + e) * DM * DM;
        float acc[8];
#pragma unroll
        for (int j = 0; j < 8; ++j) acc[j] = 0.f;
        const bf16_t* a = P.HID + (size_t)pg * 8 * DM;
        for (int k = 0; k < DM; ++k) { const float w = Wd[(size_t)k * DM + c];
#pragma unroll
            for (int j = 0; j < 8; ++j) acc[j] += bf2f(a[j * DM + k]) * w; }
#pragma unroll
        for (int j = 0; j < 8; ++j) P.YS[(size_t)(pg * 8 + j) * DM + c] = f2bf(acc[j] * P.GATE[pg * 8 + j]);
    }
}
DEVFN void ph_gather(PRef P, long gid, long gs) {
    for (long i = gid; i < (long)NPAIR * 128; i += gs) { const long p = i / 128; const int ch = (int)(i % 128);
        const uint4v* src = (const uint4v*)(P.XN + (size_t)P.IDX[p] * DM) + ch; ((uint4v*)(P.XS + (size_t)p * DM))[ch] = *src; }
}
DEVFN void ph_combine(PRef P, long gid, long gs) {
    for (long i = gid; i < (long)MROWS * DM; i += gs) {
        const long t = i / DM; const int c = (int)(i % DM); const int b = (int)(t / NS);
        float acc = P.out[i];
        for (int e = 0; e < NEXP; ++e) { const int sl = P.SLOT[t * NEXP + e]; if (sl >= 0) acc += bf2f(P.YS[(((size_t)e * NB + b) * CAP + sl) * DM + c]); }
        P.out[i] = acc;
    }
}
DEVFN void ph_final(PRef P, long gid, long gs) {
    for (long i = gid; i < (long)MROWS * DM; i += gs) { const long r = i / DM; const int c = (int)(i % DM); P.out[i] = P.out[i] * P.RS[r] * P.norm_final_g[c]; }
}


#ifndef CPU_EMU
__device__ __forceinline__ int fresh_tid() { int t = threadIdx.x; asm volatile("" : "+v"(t)); return t; }
namespace pg8 {
#define PG8_LAS __attribute__((address_space(3)))
typedef unsigned short bf16_t;
typedef short bf16x8 __attribute__((ext_vector_type(8)));
typedef float f32x4 __attribute__((ext_vector_type(4)));
typedef unsigned u32x4 __attribute__((ext_vector_type(4)));
constexpr int BM = 256, BK = 64, HALF = 128, HTB = HALF * BK * 2  , STAGE_BYTES = 8 * HTB, NXCD = 8, WGM = 8;

__host__ __device__ __forceinline__ int lds_byte(int r, int c) { const int st = (r >> 4) * 2 + (c >> 5), rr = r & 15, cc = c & 31, ob = rr * 64 + cc * 2; return st * 1024 + (ob ^ (((ob >> 9) & 1) << 5)); }
__host__ __device__ __forceinline__ void stage_rc(int b, int& R, int& C) { const int st = b / 1024, sb = b % 1024, swz = sb ^ (((sb >> 9) & 1) << 5); R = (st >> 1) * 16 + swz / 64; C = (st & 1) * 32 + (swz % 64) / 2; }
__host__ __device__ __forceinline__ int perm32(int rho) { const int n = rho >> 4, i = rho & 15; return 8 * (i >> 2) + 4 * n + (i & 3); }

struct Unit { int pm, pn; size_t boff; };
struct Gemm { const bf16_t* A; const bf16_t* Bt; int M, N, K; };

struct StaticOrder {
    int nM, nN, nwg, G, c, rows_per_group; size_t group_stride;
    __host__ __device__ void init(int M, int N, int G_, int c_) { nM = M / BM; nN = N / BM; nwg = nM * nN; G = G_; c = c_; rows_per_group = 1 << 30; group_stride = 0; }
    __host__ __device__ bool next(int i, Unit& u) const {
        const long L = (long)i * G + c; if (L >= nwg) return false;
        int wgid = (int)L; { const int q = nwg / NXCD, r = nwg % NXCD, xcd = wgid % NXCD, off = wgid / NXCD; wgid = (xcd < r ? xcd * (q + 1) : r * (q + 1) + (xcd - r) * q) + off; }
        const int nig = WGM * nN, gid = wgid / nig, fm = gid * WGM, gsz = (nM - fm) < WGM ? (nM - fm) : WGM;
        u.pm = fm + ((wgid % nig) % gsz); u.pn = (wgid % nig) / gsz; u.boff = (size_t)(u.pm / rows_per_group) * group_stride; return true;
    }
    __device__ __forceinline__ void a_ready(const Unit&) const {}
    __device__ __forceinline__ void done(const Unit&) const {}
};


__device__ __forceinline__ unsigned cvt_pk_bf16(float lo, float hi) { unsigned r; asm volatile("v_cvt_pk_bf16_f32 %0, %1, %2" : "=v"(r) : "v"(lo), "v"(hi)); return r; }
typedef float f32x2 __attribute__((ext_vector_type(2)));

typedef float f32x2 __attribute__((ext_vector_type(2)));
template <class Epi, class Sched, bool ALIGN_EPI = false, bool SP2 = false, bool GATHER = false>
__device__ __forceinline__ void gemm_phase(PG8_LAS unsigned char* lds, const Gemm g, const Sched& S, const Epi& E, const PG8_LAS unsigned* gtab = nullptr) {
    static_assert(!GATHER || SP2, "the gathered A operand is wired into the SP2 schedule only");
    const int tid = fresh_tid(), wid = __builtin_amdgcn_readfirstlane(tid >> 6), lane = tid & 63, wr = wid >> 2, wc = wid & 3, fr = lane & 15, fq = lane >> 4;
    const int K = g.K, nt = K / BK;
    unsigned voffA[2], voffB[2]; int rowA[2]; unsigned colA2[2];
#pragma unroll
    for (int i = 0; i < 2; ++i) { int R, C; stage_rc(tid * 16 + i * 8192, R, C); const int Rb = Epi::PERM ? ((R & ~31) + perm32(R & 31)) : R;
        voffA[i] = (unsigned)(R * K + C) * 2u; voffB[i] = (unsigned)(Rb * K + C) * 2u; rowA[i] = R; colA2[i] = (unsigned)C * 2u; }
    unsigned vC[2][2] = {{0u, 0u}, {0u, 0u}}, vN[2][2] = {{0u, 0u}, {0u, 0u}};
    auto gload = [&](int ui_, unsigned (&v)[2][2]) __attribute__((always_inline)) {
#pragma unroll
        for (int h = 0; h < 2; ++h)
#pragma unroll
            for (int i = 0; i < 2; ++i) v[h][i] = gtab[ui_ * 256 + h * HALF + rowA[i]] + colA2[i]; };
    const size_t kstep = (size_t)(BK * 2);
    const size_t hstep = (size_t)HALF * K * 2;
    const size_t tstep = 2 * hstep;
    const unsigned ldsw = (unsigned)wid * 1024u;
    const int aoff = lds_byte(wr * 64 + fr, fq * 8), boff = lds_byte(wc * 32 + fr, fq * 8);
#define PG8_SA(b, h) (((b) * 2 + (h)) * HTB)
#define PG8_SB(b, h) ((4 + (b) * 2 + (h)) * HTB)
#define PG8_STAGE(bufoff, gbase, voff) do { _Pragma("unroll") for (int _i = 0; _i < 2; ++_i) \
        __builtin_amdgcn_global_load_lds((const unsigned*)((const char*)(gbase) + (voff)[_i]), (PG8_LAS unsigned*)(lds + (bufoff) + ldsw + _i * 8192), 16, 0, 0); } while (0)
#define PG8_LDA(dst, b, h) do { _Pragma("unroll") for (int m = 0; m < 4; ++m) _Pragma("unroll") for (int k = 0; k < 2; ++k) dst[m][k] = *(const PG8_LAS bf16x8*)(lds + PG8_SA(b, h) + aoff + m * 2048 + k * 1024); } while (0)
#define PG8_LDB(dst, b, h) do { _Pragma("unroll") for (int n = 0; n < 2; ++n) _Pragma("unroll") for (int k = 0; k < 2; ++k) dst[n][k] = *(const PG8_LAS bf16x8*)(lds + PG8_SB(b, h) + boff + n * 2048 + k * 1024); } while (0)
#define PG8_MMA(ai, bj, At, Bt) do { __builtin_amdgcn_s_setprio(1); _Pragma("unroll") for (int m = 0; m < 4; ++m) _Pragma("unroll") for (int n = 0; n < 2; ++n) _Pragma("unroll") for (int k = 0; k < 2; ++k) \
        acc[ai][bj][m][n] = __builtin_amdgcn_mfma_f32_16x16x32_bf16(Bt[n][k], At[m][k], acc[ai][bj][m][n], 0, 0, 0); __builtin_amdgcn_s_setprio(0); } while (0)
#define PG8_WAIT_V(n) asm volatile("s_waitcnt vmcnt(" #n ")" ::: "memory")
#define PG8_WAIT_L(n) asm volatile("s_waitcnt lgkmcnt(" #n ")" ::: "memory")
#define PG8_BAR __builtin_amdgcn_s_barrier()
#define PG8_SCHED __builtin_amdgcn_sched_barrier(0)
    auto stageA = [&](int bufoff, const char* gbase, int h, bool nx) __attribute__((always_inline)) {
        if constexpr (GATHER) { unsigned v_[2] = {nx ? vN[h][0] : vC[h][0], nx ? vN[h][1] : vC[h][1]}; PG8_STAGE(bufoff, gbase, v_); }
        else { (void)nx; PG8_STAGE(bufoff, gbase + (h ? hstep : 0), voffA); } };
    Unit cur, nxt; int ui = 0;
    if (!S.next(0, cur)) return;
    f32x4 acc[2][2][4][2];
#pragma unroll
    for (int a = 0; a < 2; ++a)
#pragma unroll
        for (int b = 0; b < 2; ++b)
#pragma unroll
            for (int m = 0; m < 4; ++m)
#pragma unroll
                for (int n = 0; n < 2; ++n) acc[a][b][m][n] = (f32x4){0.f, 0.f, 0.f, 0.f};
    bf16x8 At[4][2], B0[2][2], B1[2][2];
    const char* cA = (const char*)g.A + (GATHER ? (size_t)0 : (size_t)cur.pm * tstep); const char* cB = (const char*)g.Bt + cur.boff + (size_t)cur.pn * tstep;
    S.a_ready(cur);
    if constexpr (GATHER) gload(0, vC);
    if constexpr (SP2) {
        PG8_STAGE(PG8_SB(0, 0), cB, voffB); PG8_STAGE(PG8_SB(0, 1), cB + hstep, voffB); stageA(PG8_SA(0, 0), cA, 0, false); stageA(PG8_SA(0, 1), cA, 1, false);
        if (wr == 1) PG8_BAR;
        PG8_WAIT_V(2); PG8_BAR;
        PG8_STAGE(PG8_SB(1, 0), cB + kstep, voffB); stageA(PG8_SA(1, 0), cA + kstep, 0, false); PG8_STAGE(PG8_SB(1, 1), cB + hstep + kstep, voffB);
        PG8_WAIT_V(6); PG8_BAR;
    } else {
        PG8_STAGE(PG8_SB(0, 0), cB, voffB); PG8_STAGE(PG8_SA(0, 0), cA, voffA); PG8_STAGE(PG8_SB(0, 1), cB + hstep, voffB); PG8_STAGE(PG8_SA(0, 1), cA + hstep, voffA);
        if (wr == 1) PG8_BAR;
        PG8_WAIT_V(4); PG8_BAR;
        PG8_STAGE(PG8_SB(1, 0), cB + kstep, voffB); PG8_STAGE(PG8_SA(1, 0), cA + kstep, voffA); PG8_STAGE(PG8_SB(1, 1), cB + hstep + kstep, voffB);
        PG8_WAIT_V(6); PG8_BAR;
    }
    for (;;) {
        const bool has_next = S.next(ui + 1, nxt);
        const char* nA = has_next ? (const char*)g.A + (GATHER ? (size_t)0 : (size_t)nxt.pm * tstep) : cA;
        if constexpr (GATHER) { if (has_next) gload(ui + 1, vN); else {
#pragma unroll
            for (int h = 0; h < 2; ++h) { vN[h][0] = vC[h][0]; vN[h][1] = vC[h][1]; } } } const char* nB = has_next ? (const char*)g.Bt + nxt.boff + (size_t)nxt.pn * tstep : cB;
        for (int t = 0; t < nt; t += 2) {
            const bool last = (t == nt - 2);
            const char* a1 = cA + (size_t)(t + 1) * kstep;
            const char* a2 = last ? nA : cA + (size_t)(t + 2) * kstep; const char* b2 = last ? nB : cB + (size_t)(t + 2) * kstep;
            const char* a3 = a2 + kstep; const char* b3 = b2 + kstep;
            if (last && has_next) S.a_ready(nxt);
            if constexpr (SP2) {
            PG8_LDB(B0, 0, 0); PG8_LDB(B1, 0, 1); PG8_SCHED; PG8_LDA(At, 0, 0); stageA(PG8_SA(1, 1), a1, 1, false);
            PG8_WAIT_V(8); PG8_WAIT_L(0); PG8_BAR; PG8_MMA(0, 0, At, B0); PG8_MMA(0, 1, At, B1); PG8_BAR; PG8_SCHED;
            PG8_LDA(At, 0, 1); PG8_STAGE(PG8_SB(0, 0), b2, voffB); PG8_STAGE(PG8_SB(0, 1), b2 + hstep, voffB); stageA(PG8_SA(0, 0), a2, 0, last);
            PG8_WAIT_V(8); PG8_WAIT_L(0); PG8_BAR; PG8_MMA(1, 0, At, B0); PG8_MMA(1, 1, At, B1); PG8_BAR; PG8_SCHED;
            PG8_LDB(B0, 1, 0); PG8_LDB(B1, 1, 1); PG8_SCHED; PG8_LDA(At, 1, 0); stageA(PG8_SA(0, 1), a2, 1, last);
            PG8_WAIT_V(8); PG8_WAIT_L(0); PG8_BAR; PG8_MMA(0, 0, At, B0); PG8_MMA(0, 1, At, B1); PG8_BAR; PG8_SCHED;
            PG8_LDA(At, 1, 1); PG8_STAGE(PG8_SB(1, 0), b3, voffB); PG8_STAGE(PG8_SB(1, 1), b3 + hstep, voffB); stageA(PG8_SA(1, 0), a3, 0, last);
            PG8_WAIT_V(8); PG8_WAIT_L(0); PG8_BAR; PG8_MMA(1, 0, At, B0); PG8_MMA(1, 1, At, B1); PG8_BAR; PG8_SCHED;
            } else {
            PG8_LDB(B0, 0, 0); PG8_SCHED; PG8_LDA(At, 0, 0); PG8_STAGE(PG8_SA(1, 1), a1 + hstep, voffA);
            PG8_WAIT_L(8); PG8_BAR; PG8_WAIT_L(0); PG8_MMA(0, 0, At, B0); PG8_BAR; PG8_SCHED;
            PG8_LDB(B1, 0, 1); PG8_STAGE(PG8_SB(0, 0), b2, voffB);
            PG8_BAR; PG8_WAIT_L(0); PG8_MMA(0, 1, At, B1); PG8_BAR;
            PG8_LDA(At, 0, 1); PG8_STAGE(PG8_SA(0, 0), a2, voffA);
            PG8_BAR; PG8_WAIT_L(0); PG8_MMA(1, 0, At, B0); PG8_BAR; PG8_SCHED;
            PG8_STAGE(PG8_SB(0, 1), b2 + hstep, voffB);
            PG8_WAIT_V(6); PG8_BAR; PG8_MMA(1, 1, At, B1); PG8_BAR;
            PG8_LDB(B0, 1, 0); PG8_SCHED; PG8_LDA(At, 1, 0); PG8_STAGE(PG8_SA(0, 1), a2 + hstep, voffA);
            PG8_WAIT_L(8); PG8_BAR; PG8_WAIT_L(0); PG8_MMA(0, 0, At, B0); PG8_BAR; PG8_SCHED;
            PG8_LDB(B1, 1, 1); PG8_STAGE(PG8_SB(1, 0), b3, voffB);
            PG8_BAR; PG8_WAIT_L(0); PG8_MMA(0, 1, At, B1); PG8_BAR;
            PG8_LDA(At, 1, 1); PG8_STAGE(PG8_SA(1, 0), a3, voffA);
            PG8_BAR; PG8_WAIT_L(0); PG8_MMA(1, 0, At, B0); PG8_BAR; PG8_SCHED;
            PG8_STAGE(PG8_SB(1, 1), b3 + hstep, voffB);
            PG8_WAIT_V(6); PG8_BAR; PG8_MMA(1, 1, At, B1); PG8_BAR;
            }
        }
        if constexpr (ALIGN_EPI) { if (wr == 0) PG8_BAR; }
        if constexpr (!Epi::AFTER_DRAIN) { E(acc, cur, wr, wc, fr, fq); S.done(cur); }
        if (!has_next) break;
#pragma unroll
        for (int a = 0; a < 2; ++a)
#pragma unroll
            for (int b = 0; b < 2; ++b)
#pragma unroll
                for (int m = 0; m < 4; ++m)
#pragma unroll
                    for (int n = 0; n < 2; ++n) acc[a][b][m][n] = (f32x4){0.f, 0.f, 0.f, 0.f};
        cur = nxt; cA = nA; cB = nB; ++ui;
        if constexpr (GATHER) {
#pragma unroll
            for (int h = 0; h < 2; ++h) { vC[h][0] = vN[h][0]; vC[h][1] = vN[h][1]; } }
        if constexpr (ALIGN_EPI) { if (wr == 1) PG8_BAR; }
    }
    PG8_WAIT_V(0);
    if constexpr (!ALIGN_EPI) { if (wr == 0) PG8_BAR; }
    PG8_BAR;
    if constexpr (Epi::AFTER_DRAIN) { E.fused(acc, cur, wr, wc, fr, fq, lds, wid, lane); S.done(cur); }
#undef PG8_SA
#undef PG8_SB
#undef PG8_STAGE
#undef PG8_LDA
#undef PG8_LDB
#undef PG8_MMA
#undef PG8_WAIT_V
#undef PG8_WAIT_L
#undef PG8_BAR
#undef PG8_SCHED
}
}

#define GAS __attribute__((address_space(1)))
#define LAS __attribute__((address_space(3)))
typedef unsigned v4u __attribute__((ext_vector_type(4)));
typedef float f32x4 __attribute__((ext_vector_type(4)));
typedef short bf16x8 __attribute__((ext_vector_type(8)));
typedef GAS unsigned gu32;
typedef GAS unsigned long long gu64;
#define RLX_AGENT __ATOMIC_RELAXED, __HIP_MEMORY_SCOPE_AGENT
#define LDS_WAIT() asm volatile("s_waitcnt lgkmcnt(0)" ::: "memory")
#define VM_WAIT() asm volatile("s_waitcnt vmcnt(0)" ::: "memory")
__device__ __forceinline__ unsigned long long rt() { return __builtin_amdgcn_s_memrealtime(); }
typedef float f32x2_pk __attribute__((ext_vector_type(2))); typedef __bf16 bf16x2_pk __attribute__((ext_vector_type(2)));
__device__ __forceinline__ unsigned pk2(float lo, float hi) { const f32x2_pk v = {lo, hi}; return __builtin_bit_cast(unsigned, __builtin_convertvector(v, bf16x2_pk)); }
__device__ __forceinline__ bf16_t f2bf_hw(float f) { return (bf16_t)(pk2(f, 0.f) & 0xffffu); }

#define XB_TMO      128
#define XB_XCNT(j)  (256  + 64 * (j))
#define XB_XSUB(j)  (1280 + 64 * (j))
#define XB_XGEN(j)  (2304 + 64 * (j))
#define XB_TOP      3328
#define XB_TOPGEN   3392
#define XCD_BAR_WORDS 3456
#define XB_SPIN_CAP (1u << 30)

__device__ __forceinline__ unsigned xb_ld(unsigned* p)              { return __hip_atomic_load(p, __ATOMIC_RELAXED, __HIP_MEMORY_SCOPE_AGENT); }
__device__ __forceinline__ unsigned xb_add(unsigned* p, unsigned v) { return __hip_atomic_fetch_add(p, v, __ATOMIC_RELAXED, __HIP_MEMORY_SCOPE_AGENT); }
__device__ __forceinline__ unsigned xb_xcc_id() { return (unsigned)__builtin_amdgcn_s_getreg((3 << 11) | 20) & 0xFu; }
#define XB_SPIN(cond, bar) do { unsigned _sp = 0; while (cond) { __builtin_amdgcn_s_sleep(1); \
    if ((++_sp & 255u) == 0u) { if (xb_ld(&(bar)[XB_TMO])) break; if (_sp > XB_SPIN_CAP) { atomicAdd(&(bar)[XB_TMO], 1u); break; } } } } while (0)

struct XcdBarrier {
    unsigned* bar; unsigned x;
    volatile LAS unsigned* st;
};

__device__ __forceinline__ XcdBarrier xcd_barrier_post(unsigned* bar, volatile LAS unsigned* st) {
    XcdBarrier b; b.bar = bar; b.x = xb_xcc_id(); b.st = st;
    if (threadIdx.x == 0) (void)xb_add(&bar[XB_XCNT(b.x)], 1u);
    return b;
}
__device__ __forceinline__ void xcd_barrier_complete(unsigned* bar, unsigned x, unsigned& nloc, unsigned& nx) {
    const unsigned G = gridDim.x * gridDim.y * gridDim.z;
    unsigned sum, cnt, mine, sp = 0u;
    for (;;) {
        sum = 0u; cnt = 0u; mine = 0u;
#pragma unroll
        for (unsigned j = 0; j < 16; ++j) { const unsigned c = xb_ld(&bar[XB_XCNT(j)]); sum += c; cnt += (c > 0u) ? 1u : 0u; mine = (j == x) ? c : mine; }
        if (sum == G) break;
        __builtin_amdgcn_s_sleep(1);
        if ((++sp & 255u) == 0u) { if (xb_ld(&bar[XB_TMO])) break; if (sp > XB_SPIN_CAP) { atomicAdd(&bar[XB_TMO], 1u); break; } }
    }
    nloc = mine > 0u ? mine : 1u; nx = cnt > 0u ? cnt : 1u;
}

__device__ __forceinline__ void xcd_barrier(const XcdBarrier& b) {
    asm volatile("s_waitcnt vmcnt(0)" ::: "memory");
    __syncthreads();
    if (threadIdx.x == 0) {
        unsigned* bar = b.bar;
        __builtin_amdgcn_s_waitcnt(0);
        unsigned nloc = b.st[0], nx = b.st[1];
        if (nloc == 0u) { xcd_barrier_complete(bar, b.x, nloc, nx); b.st[0] = nloc; b.st[1] = nx; }
        const unsigned old = xb_add(&bar[XB_XSUB(b.x)], 1u);
        const unsigned gen = old / nloc;
        if (old + 1u == (gen + 1u) * nloc) {
            __builtin_amdgcn_fence(__ATOMIC_RELEASE, "agent");
            asm volatile("s_waitcnt vmcnt(0)" ::: "memory");
            const unsigned og = xb_add(&bar[XB_TOP], 1u);
            const unsigned tg = og / nx;
            if (og + 1u == (tg + 1u) * nx) xb_add(&bar[XB_TOPGEN], 1u);
            else XB_SPIN(xb_ld(&bar[XB_TOPGEN]) == tg, bar);
            __builtin_amdgcn_fence(__ATOMIC_ACQUIRE, "agent");
            xb_add(&bar[XB_XGEN(b.x)], 1u);
            asm volatile("s_waitcnt vmcnt(0)" ::: "memory");
        } else {
            XB_SPIN(xb_ld(&bar[XB_XGEN(b.x)]) == gen, bar);
            __builtin_amdgcn_fence(__ATOMIC_ACQUIRE, "agent");
            asm volatile("s_waitcnt vmcnt(0)" ::: "memory");
        }
    }
    __syncthreads();
}

struct Ctx { LAS unsigned char* lds; char* lds_g; XcdBarrier bar; int wave, G; };
constexpr int RING_OFF = 0, RING_BYTES = 131072, LDS_BYTES = 163840, LDSCTL_OFF = LDS_BYTES - 2048, MISC_OFF = LDSCTL_OFF + 320, PARAMS_OFF = LDSCTL_OFF + 1024;
#define CW_BAR 4096

struct EpiIn {
    static constexpr bool PERM = true, AFTER_DRAIN = false;
    bf16_t *PA, *PB, *PC, *PD;
    __device__ __forceinline__ void operator()(const pg8::f32x4 (&acc)[2][2][4][2], const pg8::Unit& u, int wr, int wc, int fr, int fq) const {
        bf16_t* base; int ldc, colt;
        if (u.pn < 4) { base = PA; ldc = 1024; colt = u.pn * 256; } else if (u.pn < 6) { base = PB; ldc = 512; colt = (u.pn - 4) * 256; }
        else if (u.pn < 10) { base = PC; ldc = 1024; colt = (u.pn - 6) * 256; } else { base = PD; ldc = 1280; colt = (u.pn - 10) * 256; }
        const int row0 = u.pm * 256 + wr * 64 + fr, col0 = colt + wc * 32 + 8 * fq;
#pragma unroll
        for (int ai = 0; ai < 2; ++ai)
#pragma unroll
            for (int m = 0; m < 4; ++m) { bf16_t* rowp = base + (size_t)(row0 + ai * 128 + m * 16) * ldc + col0;
#pragma unroll
                for (int bj = 0; bj < 2; ++bj) { const pg8::f32x4 v0 = acc[ai][bj][m][0], v1 = acc[ai][bj][m][1]; pg8::u32x4 w;
                    w.x = pg8::cvt_pk_bf16(v0[0], v0[1]); w.y = pg8::cvt_pk_bf16(v0[2], v0[3]); w.z = pg8::cvt_pk_bf16(v1[0], v1[1]); w.w = pg8::cvt_pk_bf16(v1[2], v1[3]);
                    *(GAS pg8::u32x4*)(rowp + bj * 128) = w; } }
    }
};
template <bool SRC_BF16> struct EpiOut {
    static constexpr bool PERM = true, AFTER_DRAIN = false;
    const void* xsrc; bf16_t* XR;
    __device__ __forceinline__ void operator()(const pg8::f32x4 (&acc)[2][2][4][2], const pg8::Unit& u, int wr, int wc, int fr, int fq) const {
        const int col0 = u.pn * 256 + wc * 32 + 8 * fq;
#pragma unroll
        for (int ai = 0; ai < 2; ++ai)
#pragma unroll
            for (int m = 0; m < 4; ++m) { const size_t off = (size_t)(u.pm * 256 + ai * 128 + wr * 64 + m * 16 + fr) * DM + col0;
#pragma unroll
                for (int bj = 0; bj < 2; ++bj) { pg8::f32x4 b0, b1;
                    if (SRC_BF16) { const pg8::u32x4 w = __builtin_nontemporal_load((const GAS pg8::u32x4*)((const bf16_t*)xsrc + off + bj * 128));
                        b0 = (pg8::f32x4){__uint_as_float(w.x << 16), __uint_as_float(w.x & 0xffff0000u), __uint_as_float(w.y << 16), __uint_as_float(w.y & 0xffff0000u)};
                        b1 = (pg8::f32x4){__uint_as_float(w.z << 16), __uint_as_float(w.z & 0xffff0000u), __uint_as_float(w.w << 16), __uint_as_float(w.w & 0xffff0000u)}; }
                    else { b0 = __builtin_nontemporal_load((const GAS pg8::f32x4*)((const float*)xsrc + off + bj * 128)); b1 = __builtin_nontemporal_load((const GAS pg8::f32x4*)((const float*)xsrc + off + bj * 128 + 4)); }
                    const pg8::f32x4 v0 = b0 + acc[ai][bj][m][0], v1 = b1 + acc[ai][bj][m][1]; pg8::u32x4 o;
                    o.x = pg8::cvt_pk_bf16(v0[0], v0[1]); o.y = pg8::cvt_pk_bf16(v0[2], v0[3]); o.z = pg8::cvt_pk_bf16(v1[0], v1[1]); o.w = pg8::cvt_pk_bf16(v1[2], v1[3]);
                    *(GAS pg8::u32x4*)(XR + off + bj * 128) = o; } }
    }
};
struct EpiGU {
    static constexpr bool PERM = true, AFTER_DRAIN = false;
    bf16_t* HID;
    __device__ __forceinline__ void operator()(const pg8::f32x4 (&acc)[2][2][4][2], const pg8::Unit& u, int wr, int wc, int fr, int fq) const {
        const int row0 = u.pm * 256 + wr * 64 + fr, col0 = u.pn * 128 + wc * 32 + 8 * fq;
#pragma unroll
        for (int ai = 0; ai < 2; ++ai)
#pragma unroll
            for (int m = 0; m < 4; ++m) { float h[8];
#pragma unroll
                for (int n = 0; n < 2; ++n)
#pragma unroll
                    for (int i = 0; i < 4; ++i) { const float g = acc[ai][0][m][n][i], up = acc[ai][1][m][n][i]; h[n * 4 + i] = g * __builtin_amdgcn_rcpf(1.0f + __expf(-g)) * up; }
                pg8::u32x4 w; w.x = pg8::cvt_pk_bf16(h[0], h[1]); w.y = pg8::cvt_pk_bf16(h[2], h[3]); w.z = pg8::cvt_pk_bf16(h[4], h[5]); w.w = pg8::cvt_pk_bf16(h[6], h[7]);
                *(GAS pg8::u32x4*)(HID + (size_t)(row0 + ai * 128 + m * 16) * DM + col0) = w; }
    }
};
struct EpiDown {
    static constexpr bool PERM = true, AFTER_DRAIN = false;
    bf16_t* YS; const float* GATE;
    __device__ __forceinline__ void operator()(const pg8::f32x4 (&acc)[2][2][4][2], const pg8::Unit& u, int wr, int wc, int fr, int fq) const {
        const int row0 = u.pm * 256 + wr * 64 + fr, col0 = u.pn * 256 + wc * 32 + 8 * fq;
#pragma unroll
        for (int ai = 0; ai < 2; ++ai)
#pragma unroll
            for (int m = 0; m < 4; ++m) { const int row = row0 + ai * 128 + m * 16; const float gt = ((const GAS float*)GATE)[row]; bf16_t* rowp = YS + (size_t)row * DM + col0;
#pragma unroll
                for (int bj = 0; bj < 2; ++bj) { const pg8::f32x4 v0 = acc[ai][bj][m][0] * gt, v1 = acc[ai][bj][m][1] * gt; pg8::u32x4 w;
                    w.x = pg8::cvt_pk_bf16(v0[0], v0[1]); w.y = pg8::cvt_pk_bf16(v0[2], v0[3]); w.z = pg8::cvt_pk_bf16(v1[0], v1[1]); w.w = pg8::cvt_pk_bf16(v1[2], v1[3]);
                    *(GAS pg8::u32x4*)(rowp + bj * 128) = w; } }
    }
};
template <class T> __device__ __forceinline__ T* uni(T* p) { const unsigned long long v = (unsigned long long)p;
    const unsigned lo = __builtin_amdgcn_readfirstlane((unsigned)v), hi = __builtin_amdgcn_readfirstlane((unsigned)(v >> 32)); return (T*)(((unsigned long long)hi << 32) | lo); }
struct EpiLora {
    static constexpr bool PERM = true, AFTER_DRAIN = false;
    bf16_t* AP; bf16_t* GA; const float* w0; const float* a0;
    __device__ __forceinline__ void operator()(const pg8::f32x4 (&acc)[2][2][4][2], const pg8::Unit& u, int wr, int wc, int fr, int fq) const {
        const int row0 = u.pm * 256 + wr * 64 + fr, col0 = wc * 32 + 8 * fq; const int kind = u.pn < 2 ? 0 : (u.pn < 4 ? 1 : 2);
        bf16_t* base = kind == 0 ? AP + 768 + u.pn * 256 : (kind == 1 ? AP + 1280 + (u.pn - 2) * 256 : GA); const int ldd = kind == 2 ? 256 : 1792;
        const float* bias = kind == 0 ? w0 + u.pn * 256 : a0 + (u.pn - 2) * 256; const float sc = kind == 0 ? 0.6065306597f : 1.0f;
        pg8::f32x4 bv[2][2];
#pragma unroll
        for (int bj = 0; bj < 2; ++bj)
#pragma unroll
            for (int n = 0; n < 2; ++n) bv[bj][n] = kind == 2 ? (pg8::f32x4){0.f, 0.f, 0.f, 0.f} : *(const GAS pg8::f32x4*)(bias + col0 + bj * 128 + 4 * n);
#pragma unroll
        for (int ai = 0; ai < 2; ++ai)
#pragma unroll
            for (int m = 0; m < 4; ++m) { bf16_t* rowp = base + (size_t)(row0 + ai * 128 + m * 16) * ldd + col0;
#pragma unroll
                for (int bj = 0; bj < 2; ++bj) { pg8::f32x4 v0 = acc[ai][bj][m][0] + bv[bj][0], v1 = acc[ai][bj][m][1] + bv[bj][1];
                    if (kind != 2) {
#pragma unroll
                        for (int i = 0; i < 4; ++i) { v0[i] = sc * __builtin_amdgcn_rcpf(1.0f + __expf(-v0[i])); v1[i] = sc * __builtin_amdgcn_rcpf(1.0f + __expf(-v1[i])); } }
                    pg8::u32x4 w; w.x = pg8::cvt_pk_bf16(v0[0], v0[1]); w.y = pg8::cvt_pk_bf16(v0[2], v0[3]); w.z = pg8::cvt_pk_bf16(v1[0], v1[1]); w.w = pg8::cvt_pk_bf16(v1[2], v1[3]);
                    *(GAS pg8::u32x4*)(rowp + bj * 128) = w; __builtin_amdgcn_sched_barrier(0); } }
    }
};
__device__ __forceinline__ void gemm_lora_mfma(PRef P, int l, Ctx& C) {
    int G_ = C.G, bx_ = (int)blockIdx.x; asm volatile("" : "+s"(G_), "+s"(bx_));
    int K_ = 256; asm volatile("" : "+s"(K_));
    pg8::Gemm g{uni(P.LT), uni(P.WL_T), MROWS, 1280, K_}; pg8::StaticOrder S; S.init(MROWS, 1280, G_, bx_);
    EpiLora E{uni(P.AP), uni(P.GA), uni(P.w0) + l * 512, uni(P.a0) + l * 512};
    pg8::gemm_phase<EpiLora, pg8::StaticOrder, true, true>(C.lds + RING_OFF, g, S, E);
}
__device__ __forceinline__ void gemm_in_mfma(PRef P, Ctx& C) {
    int G_ = C.G, bx_ = (int)blockIdx.x; asm volatile("" : "+s"(G_), "+s"(bx_));
    pg8::Gemm g{uni(P.XN), uni(P.WIN_T), MROWS, 3840, DM}; pg8::StaticOrder S; S.init(MROWS, 3840, G_, bx_);
    EpiIn E{uni(P.PA), uni(P.PB), uni(P.PC), uni(P.PD)};
    pg8::gemm_phase<EpiIn, pg8::StaticOrder, true, true>(C.lds + RING_OFF, g, S, E);
}
template <bool SRC_BF16> __device__ __forceinline__ void gemm_out_mfma(PRef P, const void* xsrc, Ctx& C) {
    int G_ = C.G, bx_ = (int)blockIdx.x; asm volatile("" : "+s"(G_), "+s"(bx_));
    pg8::Gemm g{uni(P.MIX), uni(P.WOUT_T), MROWS, DM, MIXW}; pg8::StaticOrder S; S.init(MROWS, DM, G_, bx_);
    EpiOut<SRC_BF16> E{uni((const char*)xsrc), uni(P.XR)};
    pg8::gemm_phase<EpiOut<SRC_BF16>, pg8::StaticOrder, true, true>(C.lds + RING_OFF, g, S, E);
}
__device__ __forceinline__ void gemm_gu_mfma(PRef P, Ctx& C) {
    int G_ = C.G, bx_ = (int)blockIdx.x; asm volatile("" : "+s"(G_), "+s"(bx_));
    pg8::Gemm g{uni(P.XN), uni(P.WGU_T), NPAIR, 2048, DM}; pg8::StaticOrder S; S.init(NPAIR, 2048, G_, bx_);
    S.rows_per_group = NB * CAP / 256; S.group_stride = (size_t)2048 * 1024 * 2;
    LAS unsigned* gt = (LAS unsigned*)(C.lds + RING_OFF + RING_BYTES);
    { const int tid = fresh_tid(); const GAS int* IDX = (const GAS int*)uni(P.IDX); unsigned val[8];
#pragma unroll
      for (int ui = 0; ui < 8; ++ui) { pg8::Unit u; const bool ok = S.next(ui, u); val[ui] = (ok && tid < 256) ? (unsigned)IDX[(size_t)u.pm * 256 + tid] * (unsigned)(DM * 2) : 0u; }
      if (tid < 256) {
#pragma unroll
          for (int ui = 0; ui < 8; ++ui) gt[ui * 256 + tid] = val[ui]; }
      __syncthreads(); }
    EpiGU E{uni(P.HID)};
    pg8::gemm_phase<EpiGU, pg8::StaticOrder, true, true, true>(C.lds + RING_OFF, g, S, E, gt);
}
__device__ __forceinline__ void gemm_down_mfma(PRef P, Ctx& C) {
    int G_ = C.G, bx_ = (int)blockIdx.x; asm volatile("" : "+s"(G_), "+s"(bx_));
    pg8::Gemm g{uni(P.HID), uni(P.WD_T), NPAIR, DM, DM}; pg8::StaticOrder S; S.init(NPAIR, DM, G_, bx_);
    S.rows_per_group = NB * CAP / 256; S.group_stride = (size_t)1024 * 1024 * 2;
    EpiDown E{uni(P.YS), uni(P.GATE)};
    pg8::gemm_phase<EpiDown, pg8::StaticOrder, true, true>(C.lds + RING_OFF, g, S, E);
}
__device__ __forceinline__ void conv_item(const float* W, int ldw, int col0, int nvalid, int k0, bf16_t* WT, int K, int n0, LAS float* scr, int lane, int kd = -1) {
    if (kd < 0) kd = k0;
    const int c = lane & 31;
    { const GAS float* Wg = (const GAS float*)W + (size_t)k0 * ldw + col0 + (c < nvalid ? c : 0); float r[32];
#pragma unroll
      for (int i = 0; i < 32; ++i) r[i] = Wg[(size_t)(2 * i + (lane >> 5)) * ldw];
#pragma unroll
      for (int i = 0; i < 32; ++i) scr[(2 * i + (lane >> 5)) * 33 + c] = c < nvalid ? r[i] : 0.f; }
    LDS_WAIT(); asm volatile("" ::: "memory");
    const int c8 = lane & 7;
#pragma unroll
    for (int j = 0; j < 4; ++j) { const int n = (lane >> 3) + 8 * j; const LAS float* s = scr + (8 * c8) * 33 + n;
        v4u o; o.x = pk2(s[0 * 33], s[1 * 33]); o.y = pk2(s[2 * 33], s[3 * 33]); o.z = pk2(s[4 * 33], s[5 * 33]); o.w = pk2(s[6 * 33], s[7 * 33]);
        *(GAS v4u*)(WT + (size_t)(n0 + n) * K + kd + 8 * c8) = o; }
    LDS_WAIT(); asm volatile("" ::: "memory");
}
__device__ __forceinline__ void conv_item64(const float* __restrict__ W, int ldw, int col0, int k0, bf16_t* __restrict__ WT, int K, int n0, LAS float* scr, int lane) {
#pragma unroll
    for (int i = 0; i < 64; ++i) scr[i * 65 + lane] = ((const GAS float*)W)[(size_t)(k0 + i) * ldw + col0 + lane];
    LDS_WAIT(); asm volatile("" ::: "memory");
    const int c8 = lane & 7;
#pragma unroll
    for (int j = 0; j < 8; ++j) { const int n = (lane >> 3) + 8 * j; const LAS float* sp = scr + (8 * c8) * 65 + n;
        v4u o; o.x = pk2(sp[0 * 65], sp[1 * 65]); o.y = pk2(sp[2 * 65], sp[3 * 65]); o.z = pk2(sp[4 * 65], sp[5 * 65]); o.w = pk2(sp[6 * 65], sp[7 * 65]);
        *(GAS v4u*)(WT + (size_t)(n0 + n) * K + k0 + 8 * c8) = o; }
    LDS_WAIT(); asm volatile("" ::: "memory");
}
__device__ __forceinline__ void convert_small(PRef P, int l, Ctx& C) {
    const int lane = fresh_tid() & 63;
    LAS float* scr = (LAS float*)(C.lds + RING_OFF + C.wave * 16384);
    const int gw = (int)blockIdx.x * 8 + C.wave, NGW = C.G * 8;
    const float* win = P.w_in + (size_t)l * DM * PIN; const float* wout = P.w_out + (size_t)l * MIXW * DM;
    for (int it = gw; it < 16 * 120 + 18 * 32 + 160; it += NGW) {
        if (it < 16 * 120) { const int kb = it / 120, nb = it % 120; const int n0 = nb * 32; int col0, nv;
            if (nb < 80) { col0 = n0; nv = 32; } else if (nb < 116) { col0 = n0 + 16; nv = 32; } else if (nb == 116) { col0 = 2560; nv = 16; } else { col0 = 0; nv = 0; }
            conv_item(win, PIN, col0, nv, kb * 64, P.WIN_T, DM, n0, scr, lane); }
        else if (it < 16 * 120 + 18 * 32) { const int r = it - 16 * 120; const int kb = r / 32, nb = r % 32; conv_item(wout, DM, nb * 32, 32, kb * 64, P.WOUT_T, MIXW, nb * 32, scr, lane); }
        else {
            const int r = it - 16 * 120 - 18 * 32; const int nb = r >> 2, kb = r & 3, n0 = nb * 32; const float* src = P.w_up; int c0 = 0, nv = 0, ks = 0;
            if (n0 < 512) { if (kb == 0) { src = P.w_up + ((size_t)l * 2 + n0 / 256) * 64 * 256; c0 = n0 % 256; nv = 32; } }
            else if (n0 < 1024) { if (kb == 1) { src = P.a_up + ((size_t)l * 2 + (n0 - 512) / 256) * 64 * 256; c0 = (n0 - 512) % 256; nv = 32; } }
            else if (kb >= 2) { src = P.g_up + (size_t)l * 128 * 256; c0 = n0 - 1024; nv = 32; ks = (kb - 2) * 64; }
            conv_item(src, 256, c0, nv, ks, P.WL_T, 256, n0, scr, lane, kb * 64); }
    }
}
__device__ __forceinline__ void convert_moe(PRef P, int l, Ctx& C, int wi = -1, int nw = 0) {
    const int lane = fresh_tid() & 63;
    LAS float* scr = (LAS float*)(C.lds + RING_OFF + C.wave * 16896);
    const int gw = (wi >= 0 ? wi : (int)blockIdx.x) * 8 + C.wave, NGW = (nw ? nw : C.G) * 8;
    constexpr int NIT = NEXP * 16 * 32 + NEXP * 16 * 16;
    const GAS float* wg_ = (const GAS float*)P.w_gate + (size_t)l * NEXP * DM * DM; const GAS float* wu_ = (const GAS float*)P.w_upx + (size_t)l * NEXP * DM * DM; const GAS float* wd_ = (const GAS float*)P.w_down + (size_t)l * NEXP * DM * DM;
    GAS bf16_t* WGU = (GAS bf16_t*)P.WGU_T; GAS bf16_t* WD = (GAS bf16_t*)P.WD_T;
    float r[64]; const GAS float* src = wg_; GAS bf16_t* dst = WGU;
    auto decode = [&](int it, const GAS float*& sp, GAS bf16_t*& dp) {
        if (it < NEXP * 16 * 32) { const int e = it / 512, rr = it % 512, kb = rr % 16, nb = rr / 16; const int n0 = nb * 64, j = n0 / 256, half = (n0 / 128) & 1, c0 = 128 * j + (n0 & 127);
            sp = (half ? wu_ : wg_) + (size_t)e * DM * DM + (size_t)(kb * 64) * DM + c0 + lane; dp = WGU + (size_t)e * 2048 * 1024 + (size_t)n0 * DM + kb * 64; }
        else { const int q = it - NEXP * 16 * 32; const int e = q / 256, rr = q % 256, kb = rr % 16, nb = rr / 16;
            sp = wd_ + (size_t)e * DM * DM + (size_t)(kb * 64) * DM + nb * 64 + lane; dp = WD + (size_t)e * 1024 * 1024 + (size_t)(nb * 64) * DM + kb * 64; } };
    if (gw < NIT) { decode(gw, src, dst);
#pragma unroll
        for (int i = 0; i < 64; ++i) r[i] = __builtin_nontemporal_load(src + (size_t)i * DM); }
    for (int it = gw; it < NIT; it += NGW) {
#pragma unroll
        for (int i = 0; i < 64; ++i) scr[i * 65 + lane] = r[i];
        GAS bf16_t* cdst = dst;
        if (it + NGW < NIT) { decode(it + NGW, src, dst);
#pragma unroll
            for (int i = 0; i < 64; ++i) r[i] = __builtin_nontemporal_load(src + (size_t)i * DM); }
        LDS_WAIT(); asm volatile("" ::: "memory");
        const int c8 = lane & 7;
#pragma unroll
        for (int j = 0; j < 8; ++j) { const int n = (lane >> 3) + 8 * j; const LAS float* sp = scr + (8 * c8) * 65 + n;
            v4u o; o.x = pk2(sp[0 * 65], sp[1 * 65]); o.y = pk2(sp[2 * 65], sp[3 * 65]); o.z = pk2(sp[4 * 65], sp[5 * 65]); o.w = pk2(sp[6 * 65], sp[7 * 65]);
            *(GAS v4u*)(cdst + (size_t)n * DM + 8 * c8) = o; }
        LDS_WAIT(); asm volatile("" ::: "memory");
    }
}
namespace attn_body {
using bf16=unsigned short;
using bf16x8=__attribute__((ext_vector_type(8)))short;
using s16x4=__attribute__((ext_vector_type(4)))short;
using f32x16=__attribute__((ext_vector_type(16)))float;
using u32x4=__attribute__((ext_vector_type(4)))unsigned;
constexpr int BATCH=NB,NHEAD=4,SEQ=NS,D=64,QP=512,KP=512,OP=1152;
constexpr int NW=8,QBLK=32,QB=QBLK*NW,KVBLK=64,NQB=SEQ/QB;
constexpr int ATTN_UNIT_ROWS=QB;
__device__ __forceinline__ int crow(int r,int hi){return (r&3)+8*(r>>2)+4*hi;}
#define SBAR() __builtin_amdgcn_sched_barrier(0)
__device__ __forceinline__ void cmask(f32x16&p0,f32x16&p1,int jb,int qrel,int hi){
  const float NEG=-INFINITY; int kb=64*jb+4*hi;
  #pragma unroll
  for(int r=0;r<16;++r){int kv=kb+(r&3)+8*(r>>2); if(kv>qrel)p0[r]=NEG; if(kv+32>qrel)p1[r]=NEG;}
}

constexpr int NSLOT=3, SLOTB=8192;
constexpr int LDS_K=0, LDS_V=NSLOT*SLOTB, LDS_WS=2*NSLOT*SLOTB, LDS_OST=LDS_WS+NW*64*4, LDS_BYTES=LDS_OST+NW*4096;
constexpr float C2=0.125f*1.4426950408889634f;
__device__ __forceinline__ void glds16(const void*gsrc,unsigned lds_dst){unsigned keep;
  asm volatile("s_mov_b32 %0, m0\n\ts_mov_b32 m0, %2\n\ts_nop 0\n\tglobal_load_lds_dwordx4 %1, off\n\ts_mov_b32 m0, %0":"=&s"(keep):"v"(gsrc),"s"(lds_dst):"memory");}
__device__ __forceinline__ float max3f(float a,float b,float c){float r;asm("v_max3_f32 %0, %1, %2, %3":"=v"(r):"v"(a),"v"(b),"v"(c));return r;}
__device__ __forceinline__ float max2f(float a,float b){float r;asm("v_max_f32_e32 %0, %1, %2":"=v"(r):"v"(a),"v"(b));return r;}
__device__ __forceinline__ float fadd_s(float a,float b){float r;asm("v_add_f32_e32 %0, %1, %2":"=v"(r):"v"(a),"v"(b));return r;}
__device__ __forceinline__ float fsub_s(float a,float b){float r;asm("v_sub_f32_e32 %0, %1, %2":"=v"(r):"v"(a),"v"(b));return r;}
typedef float f32x2_t __attribute__((ext_vector_type(2))); typedef __bf16 bf16x2_t __attribute__((ext_vector_type(2)));
__device__ __forceinline__ unsigned cvtpk_s(float lo,float hi){f32x2_t v={lo,hi};bf16x2_t b=__builtin_convertvector(v,bf16x2_t);return __builtin_bit_cast(unsigned,b);}
#define WAIT_BAR(N) asm volatile("s_waitcnt vmcnt(" #N ") lgkmcnt(0)\n\ts_barrier":::"memory")

__device__ __forceinline__ void qkt(f32x16&p0,f32x16&p1,const char*Kslot,const bf16x8*qr,const f32x16&negm,int r32,int hi){
  const char*kb=Kslot+hi*1024+r32*16;
  #pragma unroll
  for(int d0=0;d0<4;++d0){
    const bf16x8 b0=*reinterpret_cast<const bf16x8*>(kb+d0*2048);
    const bf16x8 b1=*reinterpret_cast<const bf16x8*>(kb+d0*2048+512);
    if(d0==0){p0=__builtin_amdgcn_mfma_f32_32x32x16_bf16(b0,qr[0],negm,0,0,0);p1=__builtin_amdgcn_mfma_f32_32x32x16_bf16(b1,qr[0],negm,0,0,0);}
    else{p0=__builtin_amdgcn_mfma_f32_32x32x16_bf16(b0,qr[d0],p0,0,0,0);p1=__builtin_amdgcn_mfma_f32_32x32x16_bf16(b1,qr[d0],p1,0,0,0);}}
}
typedef __attribute__((address_space(3))) const char* lds_cptr;
typedef short v4i16_t __attribute__((ext_vector_type(4)));
__device__ __forceinline__ void kload8(bf16x8*kf,lds_cptr kp){
  kf[0]=*(const __attribute__((address_space(3))) bf16x8*)(kp);      kf[1]=*(const __attribute__((address_space(3))) bf16x8*)(kp+512);
  kf[2]=*(const __attribute__((address_space(3))) bf16x8*)(kp+2048); kf[3]=*(const __attribute__((address_space(3))) bf16x8*)(kp+2560);
  kf[4]=*(const __attribute__((address_space(3))) bf16x8*)(kp+4096); kf[5]=*(const __attribute__((address_space(3))) bf16x8*)(kp+4608);
  kf[6]=*(const __attribute__((address_space(3))) bf16x8*)(kp+6144); kf[7]=*(const __attribute__((address_space(3))) bf16x8*)(kp+6656);
}
__device__ __forceinline__ void kload2(bf16x8*kf,lds_cptr kp,int j){ kf[2*j]=*(const __attribute__((address_space(3))) bf16x8*)(kp+j*2048); kf[2*j+1]=*(const __attribute__((address_space(3))) bf16x8*)(kp+j*2048+512); }
__device__ __forceinline__ s16x4 vtr(lds_cptr p){ return __builtin_bit_cast(s16x4,__builtin_amdgcn_ds_read_tr16_b64_v4i16((__attribute__((address_space(3))) v4i16_t*)p)); }
__device__ __forceinline__ float rowmax(const f32x16&p0,const f32x16&p1){
  float a=max3f(p0[0],p0[1],p1[0]),b=max3f(p0[2],p0[3],p1[1]);a=max3f(a,p1[2],p1[3]);
  #pragma unroll
  for(int r=4;r<16;r+=4){a=max3f(a,p0[r],p0[r+1]);b=max3f(b,p0[r+2],p0[r+3]);a=max3f(a,p1[r],p1[r+1]);b=max3f(b,p1[r+2],p1[r+3]);}
  const float m=max2f(a,b);
  auto rr=__builtin_amdgcn_permlane32_swap(__float_as_uint(m),__float_as_uint(m),false,false);
  return max2f(__uint_as_float(rr[0]),__uint_as_float(rr[1]));
}
__device__ __forceinline__ void pv(f32x16*o,int vb,bf16x8 pa0,bf16x8 pa1,bf16x8 pa2,bf16x8 pa3){
  #pragma unroll
  for(int d0=0;d0<2;++d0){s16x4 lo[4],hi[4];
    #pragma unroll
    for(int ks=0;ks<4;++ks){
      asm volatile("ds_read_b64_tr_b16 %0,%1 offset:%c2":"=&v"(lo[ks]):"v"(vb),"i"(d0*4096+ks*1024):"memory");
      asm volatile("ds_read_b64_tr_b16 %0,%1 offset:%c2":"=&v"(hi[ks]):"v"(vb),"i"(d0*4096+ks*1024+512):"memory");}
    asm volatile("s_waitcnt lgkmcnt(0)":::"memory");SBAR();
    #define PK(k) (bf16x8){lo[k][0],lo[k][1],lo[k][2],lo[k][3],hi[k][0],hi[k][1],hi[k][2],hi[k][3]}
    o[d0]=__builtin_amdgcn_mfma_f32_32x32x16_bf16(pa0,PK(0),o[d0],0,0,0);
    o[d0]=__builtin_amdgcn_mfma_f32_32x32x16_bf16(pa1,PK(1),o[d0],0,0,0);
    o[d0]=__builtin_amdgcn_mfma_f32_32x32x16_bf16(pa2,PK(2),o[d0],0,0,0);
    o[d0]=__builtin_amdgcn_mfma_f32_32x32x16_bf16(pa3,PK(3),o[d0],0,0,0);
    #undef PK
  }
}

#ifndef ATTN_STORE16
#define ATTN_STORE16(p,v) (*(u32x4*)(p)=(v))
#endif
template<int THRL> __device__ __forceinline__ void attn_unit(int b,int qb,const bf16*Q,const bf16*__restrict__ K,const bf16*__restrict__ V,bf16*O,char*shm){
  const int tid=fresh_tid(),lane=tid&63,r32=lane&31,hi=lane>>5; const int wid=__builtin_amdgcn_readfirstlane(tid>>6);
  const long rowbase=(long)b*SEQ; const int q0=qb*QB;
  const bf16*Qw=Q+(rowbase+q0+wid*QBLK)*QP;
  const bf16*Kh=K+rowbase*KP,*Vh=V+rowbase*KP;
  const unsigned lds0=(unsigned)(uintptr_t)shm;
  float*wsf=(float*)(shm+LDS_WS)+wid*64;
  const bf16*ksrc=Kh+(long)lane*KP+wid*8;
  const bf16*vsrc=Vh+(long)(16*(wid&3)+(lane>>2))*KP+(wid>>2)*32+(lane&3)*8;
  const unsigned kdst=lds0+LDS_K+wid*1024, vdst=lds0+LDS_V+wid*1024;
  #define DMA_K(t,slot) glds16(ksrc+(long)(t)*KVBLK*KP,(unsigned)__builtin_amdgcn_readfirstlane(kdst+(slot)))
  #define DMA_V(t,slot) glds16(vsrc+(long)(t)*KVBLK*KP,(unsigned)__builtin_amdgcn_readfirstlane(vdst+(slot)))
  const int vb0=(int)(lds0+LDS_V)+((lane>>4)&1)*32+(lane&3)*8+(4*hi+((lane&15)>>2))*64;
  const char*Kbase=shm+LDS_K; bf16x8 kf[8];
  const lds_cptr shm3=(lds_cptr)shm; const lds_cptr kp0=shm3+LDS_K+hi*1024+r32*16; const lds_cptr vp0=shm3+LDS_V+((lane>>4)&1)*32+(lane&3)*8+(4*hi+((lane&15)>>2))*64;
  constexpr int NT=SEQ/KVBLK;
  DMA_K(0,0);DMA_V(0,0);DMA_K(1,SLOTB);
  bf16x8 qr[4];
  #pragma unroll
  for(int d0=0;d0<4;++d0)qr[d0]=*reinterpret_cast<const bf16x8*>(&Qw[(long)r32*QP+d0*16+hi*8]);
  float mhat=0.f,l_reg=0.f;f32x16 o[2];o[0]=f32x16{};o[1]=f32x16{};f32x16 negm=f32x16{};asm volatile("":"+v"(negm));
  #define CMASK(P0,P1,t) do{}while(0)
  bool resc=false;
  #define START(P0,P1) do{ const float rm=rowmax(P0,P1); resc=false; \
    { const float dl=rm; mhat=fadd_s(mhat,dl); \
      _Pragma("unroll") for(int r=0;r<16;++r){P0[r]=fsub_s(P0[r],dl);P1[r]=fsub_s(P1[r],dl);} \
      _Pragma("unroll") for(int r=0;r<16;++r)negm[r]=-mhat; asm volatile("":"+v"(negm)); } \
    _Pragma("unroll") for(int r=0;r<16;++r)P0[r]=__builtin_amdgcn_exp2f(P0[r]); }while(0)
  #define RESC() do{ if(resc){ asm volatile("s_waitcnt lgkmcnt(0)":::"memory"); \
      _Pragma("unroll") for(int d_=0;d_<2;++d_) _Pragma("unroll") for(int r=0;r<16;++r)o[d_][r]*=wsf[crow(r,hi)]; } }while(0)
  f32x16 pA0,pA1,pB0,pB1;
  int sl_prev=0,sl_cur=0,sl_next=SLOTB;
  #define ROT() do{sl_prev=sl_cur;sl_cur=sl_next;sl_next=(sl_next==(NSLOT-1)*SLOTB)?0:sl_next+SLOTB;}while(0)
  DMA_K(2,2*SLOTB);
  WAIT_BAR(3);
  qkt(pA0,pA1,Kbase,qr,negm,r32,hi);asm volatile("s_nop 15\n\ts_nop 7":"+v"(pA0),"+v"(pA1));CMASK(pA0,pA1,0);
  START(pA0,pA1);
  _Pragma("unroll") for(int r=0;r<16;++r)pA1[r]=__builtin_amdgcn_exp2f(pA1[r]);
  WAIT_BAR(0);
  DMA_K(3,0);DMA_V(1,SLOTB);
  ROT();
  kload8(kf,kp0+sl_cur);
  WAIT_BAR(2);
  s16x4 vlo[8],vhi[8]; u32x4 pw0,pw1,pw2,pw3;
  #define PKW(P,B) cvtpk_s(P[B],P[B+1])
  #define PAF(k) __builtin_bit_cast(bf16x8,pw##k)
  #define VFR(i) (bf16x8){vlo[i][0],vlo[i][1],vlo[i][2],vlo[i][3],vhi[i][0],vhi[i][1],vhi[i][2],vhi[i][3]}
  #define PIN(x) asm volatile("":"+v"(x))
  #define MX3(a,b,c) __builtin_fmaxf(__builtin_fmaxf((a),(b)),(c))
  #define GAPA(MF,A0,A1,A2,A3,W0,W1,PW) do{ MF; sacc+=A0; sacc+=A1; sacc+=A2; sacc+=A3; PIN(sacc); W0; W1; PIN(PW); SBAR(); }while(0)
  #define EX(v) __builtin_amdgcn_exp2f(v)
  #define GAPB(MF,X,B) do{ MF; X[B]=EX(X[B]); X[B+1]=EX(X[B+1]); X[B+2]=EX(X[B+2]); X[B+3]=EX(X[B+3]); PIN(X); SBAR(); }while(0)
  #define VRD(i) do{ vlo[i]=vtr(vp_+(((i)>>2)*4096+((i)&3)*1024)); vhi[i]=vtr(vp_+(((i)>>2)*4096+((i)&3)*1024+512)); }while(0)
  #define KRD(G,j) do{ if(G){ kload2(kf,kp0+sl_next,j); SBAR(); } }while(0)
  #define STEP(C0,C1,P0,P1,t,GK,GV,GL) do{ SBAR(); \
    const lds_cptr vp_=vp0+sl_prev; \
    VRD(0); SBAR(); float sacc=(P0[0]+P0[1]); \
    GAPA(C0=__builtin_amdgcn_mfma_f32_32x32x16_bf16(kf[0],qr[0],negm,0,0,0), P0[2],P0[3],P0[4],P0[5],     pw0[0]=PKW(P0,0), pw0[1]=PKW(P0,2), pw0); \
    VRD(4); SBAR(); GAPA(C1=__builtin_amdgcn_mfma_f32_32x32x16_bf16(kf[1],qr[0],negm,0,0,0), P0[6],P0[7],P0[8],P0[9],     pw0[2]=PKW(P0,4), pw0[3]=PKW(P0,6), pw0); \
    VRD(1); SBAR(); GAPA(C0=__builtin_amdgcn_mfma_f32_32x32x16_bf16(kf[2],qr[1],C0,0,0,0),   P0[10],P0[11],P0[12],P0[13], pw1[0]=PKW(P0,8), pw1[1]=PKW(P0,10), pw1); \
    VRD(5); SBAR(); GAPA(C1=__builtin_amdgcn_mfma_f32_32x32x16_bf16(kf[3],qr[1],C1,0,0,0),   P0[14],P0[15],P1[0],P1[1],   pw1[2]=PKW(P0,12),pw1[3]=PKW(P0,14), pw1); \
    VRD(2); SBAR(); GAPA(C0=__builtin_amdgcn_mfma_f32_32x32x16_bf16(kf[4],qr[2],C0,0,0,0),   P1[2],P1[3],P1[4],P1[5],     pw2[0]=PKW(P1,0), pw2[1]=PKW(P1,2), pw2); \
    VRD(6); SBAR(); GAPA(C1=__builtin_amdgcn_mfma_f32_32x32x16_bf16(kf[5],qr[2],C1,0,0,0),   P1[6],P1[7],P1[8],P1[9],     pw2[2]=PKW(P1,4), pw2[3]=PKW(P1,6), pw2); \
    VRD(3); SBAR(); GAPA(C0=__builtin_amdgcn_mfma_f32_32x32x16_bf16(kf[6],qr[3],C0,0,0,0),   P1[10],P1[11],P1[12],P1[13], pw3[0]=PKW(P1,8), pw3[1]=PKW(P1,10), pw3); \
    VRD(7); SBAR(); GAPA(C1=__builtin_amdgcn_mfma_f32_32x32x16_bf16(kf[7],qr[3],C1,0,0,0),   P1[14],P1[15],0.f,0.f,       pw3[2]=PKW(P1,12),pw3[3]=PKW(P1,14), pw3); \
    l_reg+=sacc; \
    if(GK){DMA_K((t)+3,sl_cur);} if(GV){DMA_V((t)+1,sl_next);} \
    CMASK(C0,C1,t); \
    { float a=MX3(C0[0],C0[1],C1[0]),b=MX3(C0[2],C0[3],C1[1]); a=MX3(a,C1[2],C1[3]); \
      _Pragma("unroll") for(int r=4;r<16;r+=4){a=MX3(a,C0[r],C0[r+1]);b=MX3(b,C0[r+2],C0[r+3]);a=MX3(a,C1[r],C1[r+1]);b=MX3(b,C1[r+2],C1[r+3]);} \
      float rm=__builtin_fmaxf(a,b); { auto rr=__builtin_amdgcn_permlane32_swap(__float_as_uint(rm),__float_as_uint(rm),false,false); rm=__builtin_fmaxf(__uint_as_float(rr[0]),__uint_as_float(rr[1])); } \
      resc=false; \
      if(__builtin_expect(__any(rm>(float)THRL),0)){ const float dl=__builtin_fmaxf(rm,0.f); mhat+=dl; \
        _Pragma("unroll") for(int r=0;r<16;++r){C0[r]-=dl;C1[r]-=dl;} \
        _Pragma("unroll") for(int r=0;r<16;++r)negm[r]=-mhat; asm volatile("":"+v"(negm)); \
        const float f=__builtin_amdgcn_exp2f(-dl); l_reg*=f; if(hi==0)wsf[r32]=f; resc=true; } } \
    SBAR(); \
    GAPB(o[0]=__builtin_amdgcn_mfma_f32_32x32x16_bf16(PAF(0),VFR(0),o[0],0,0,0), C0,0); \
    GAPB(o[1]=__builtin_amdgcn_mfma_f32_32x32x16_bf16(PAF(0),VFR(4),o[1],0,0,0), C0,4); \
    KRD(GL,0); GAPB(o[0]=__builtin_amdgcn_mfma_f32_32x32x16_bf16(PAF(1),VFR(1),o[0],0,0,0), C0,8); \
    KRD(GL,1); GAPB(o[1]=__builtin_amdgcn_mfma_f32_32x32x16_bf16(PAF(1),VFR(5),o[1],0,0,0), C0,12); \
    KRD(GL,2); GAPB(o[0]=__builtin_amdgcn_mfma_f32_32x32x16_bf16(PAF(2),VFR(2),o[0],0,0,0), C1,0); \
    KRD(GL,3); GAPB(o[1]=__builtin_amdgcn_mfma_f32_32x32x16_bf16(PAF(2),VFR(6),o[1],0,0,0), C1,4); \
    GAPB(o[0]=__builtin_amdgcn_mfma_f32_32x32x16_bf16(PAF(3),VFR(3),o[0],0,0,0), C1,8); \
    GAPB(o[1]=__builtin_amdgcn_mfma_f32_32x32x16_bf16(PAF(3),VFR(7),o[1],0,0,0), C1,12); \
    }while(0)
  int t=1;
  for(;t+5<NT;t+=2){
    STEP(pB0,pB1,pA0,pA1,t,true,true,true);     WAIT_BAR(2); RESC(); ROT();
    STEP(pA0,pA1,pB0,pB1,t+1,true,true,true);   WAIT_BAR(2); RESC(); ROT();
  }
  #define ENDW(tt) do{ if((tt)+3<NT){WAIT_BAR(2);} else if((tt)+2<NT){WAIT_BAR(1);} else {WAIT_BAR(0);} }while(0)
  for(;t+1<NT;t+=2){
    STEP(pB0,pB1,pA0,pA1,t,(t+3<NT),(t+1<NT),(t+1<NT));       ENDW(t);   RESC(); ROT();
    STEP(pA0,pA1,pB0,pB1,t+1,(t+4<NT),(t+2<NT),(t+2<NT));     ENDW(t+1); RESC(); ROT();
  }
  STEP(pB0,pB1,pA0,pA1,NT-1,false,false,false); RESC();
  { float sacc=pB0[0]+pB0[1]; _Pragma("unroll") for(int r=2;r<16;++r)sacc+=pB0[r]; _Pragma("unroll") for(int r=0;r<16;++r)sacc+=pB1[r]; l_reg+=sacc;
    pw0=(u32x4){PKW(pB0,0),PKW(pB0,2),PKW(pB0,4),PKW(pB0,6)};pw1=(u32x4){PKW(pB0,8),PKW(pB0,10),PKW(pB0,12),PKW(pB0,14)};pw2=(u32x4){PKW(pB1,0),PKW(pB1,2),PKW(pB1,4),PKW(pB1,6)};pw3=(u32x4){PKW(pB1,8),PKW(pB1,10),PKW(pB1,12),PKW(pB1,14)};
    SBAR(); pv(o,vb0+sl_cur,PAF(0),PAF(1),PAF(2),PAF(3)); }
  #undef PKW
  #undef PAF
  #undef VFR
  #undef PIN
  #undef MX3
  #undef GAPA
  #undef GAPB
  #undef EX
  #undef VRD
  #undef KRD
  #undef STEP
  #undef ENDW
  {auto rr=__builtin_amdgcn_permlane32_swap(__float_as_uint(l_reg),__float_as_uint(l_reg),false,false);l_reg=__uint_as_float(rr[0])+__uint_as_float(rr[1]);}
  if(hi==0)wsf[32+r32]=l_reg;asm volatile("s_waitcnt lgkmcnt(0)":::"memory");
  float rli[16];
  #pragma unroll
  for(int r=0;r<16;++r)rli[r]=__builtin_amdgcn_rcpf(wsf[32+crow(r,hi)]);
  bf16*Ow=O+(rowbase+q0+wid*QBLK)*OP;
  { bf16*stg=(bf16*)(shm+LDS_OST)+wid*2048;
    #pragma unroll
    for(int r=0;r<16;++r){const int orow=crow(r,hi);
      #pragma unroll
      for(int d0=0;d0<2;++d0)stg[orow*64+d0*32+r32]=f2bf_hw(o[d0][r]*rli[r]);}
    asm volatile("s_waitcnt lgkmcnt(0)":::"memory");
    #pragma unroll
    for(int i=0;i<4;++i){const int row=i*8+(lane>>3),ch=lane&7; const u32x4 v=*(const u32x4*)(stg+row*64+ch*8); ATTN_STORE16(Ow+(long)row*OP+ch*8,v);} }
  asm volatile("s_waitcnt lgkmcnt(0)\n\ts_barrier":::"memory");
  #undef DMA_K
  #undef DMA_V
  #undef CMASK
  #undef START
  #undef RESC
  #undef ROT
}
constexpr int ATTN_LDS_BYTES=LDS_BYTES;
#undef SBAR
#undef WAIT_BAR
}

__device__ __forceinline__ void ph_attnB_mfma(PRef P, Ctx& C, unsigned* ctr, volatile LAS int* tk) {
    const bf16_t* PB = uni(P.PB); bf16_t* MIX = uni(P.MIX); const int tid = fresh_tid();
    for (;;) { if (tid == 0) *tk = (int)__hip_atomic_fetch_add(ctr, 1u, __ATOMIC_RELAXED, __HIP_MEMORY_SCOPE_AGENT);
        __syncthreads(); const int u = *tk; if (u >= NB * 4 * (NS / 256)) break;
        const int qb = u % (NS / 256), h = (u / (NS / 256)) & 3, b = u / (4 * (NS / 256)); const int g = h >> 1;
        attn_body::attn_unit<8>(b, qb, PB + h * 64, PB + 256 + g * 64, PB + 384 + g * 64, MIX + 256 + h * 64, C.lds_g); }
}
typedef unsigned u32x4g __attribute__((ext_vector_type(4)));
__device__ __forceinline__ void unpack8(const u32x4g w, float (&f)[8]) { f[0] = __uint_as_float(w.x << 16); f[1] = __uint_as_float(w.x & 0xffff0000u); f[2] = __uint_as_float(w.y << 16); f[3] = __uint_as_float(w.y & 0xffff0000u);
    f[4] = __uint_as_float(w.z << 16); f[5] = __uint_as_float(w.z & 0xffff0000u); f[6] = __uint_as_float(w.w << 16); f[7] = __uint_as_float(w.w & 0xffff0000u); }
__device__ __forceinline__ u32x4g pack8(const float (&f)[8]) { u32x4g w; w.x = pk2(f[0], f[1]); w.y = pk2(f[2], f[3]); w.z = pk2(f[4], f[5]); w.w = pk2(f[6], f[7]); return w; }
__device__ __forceinline__ float oct_sum(float v) { v += __shfl_xor(v, 1); v += __shfl_xor(v, 2); v += __shfl_xor(v, 4); return v; }
__device__ __forceinline__ void ph_prepA_shift_v(PRef P, int l, long gid, long gs) {
    const float* __restrict__ mp = P.mu_prev + l * 1024; const float* __restrict__ mn = P.mu_next + l * 1024; const bf16_t* __restrict__ PA = P.PA; bf16_t* __restrict__ AP = P.AP; bf16_t* __restrict__ LT = P.LT;
#pragma unroll 4
    for (long i = gid; i < (long)MROWS * 32; i += gs) {
        const long t = i >> 5; const int c0 = 768 + (int)(i & 31) * 8; const int s = (int)(t % NS);
        float f[8], pv[8], nx[8], o[8];
        unpack8(*(const u32x4g*)(PA + t * 1024 + c0), f);
        if (s > 0) unpack8(*(const u32x4g*)(PA + (t - 1) * 1024 + c0), pv); else {
#pragma unroll
            for (int j = 0; j < 8; ++j) pv[j] = 0.f; }
        if (s < NS - 1) unpack8(*(const u32x4g*)(PA + (t + 1) * 1024 + c0), nx); else {
#pragma unroll
            for (int j = 0; j < 8; ++j) nx[j] = 0.f; }
        const bool is_tanh = c0 < 832, is_id = c0 >= 832 && c0 < 896; const float am = is_tanh ? -2.0f : -1.0f;
#pragma unroll
        for (int j = 0; j < 8; ++j) { const float v = f[j] + mp[c0 + j] * (pv[j] - f[j]) + mn[c0 + j] * (nx[j] - f[j]);
            const float sg = __builtin_amdgcn_rcpf(1.0f + __expf(am * v)); o[j] = is_id ? v : (is_tanh ? 2.0f * sg - 1.0f : sg); }
        *(u32x4g*)(LT + t * 256 + (c0 - 768)) = pack8(o);
    }
}
__device__ __forceinline__ void ph_lora_fused(PRef P, int l, Ctx& C) {
    typedef short bf16x8l __attribute__((ext_vector_type(8))); typedef float f32x4l __attribute__((ext_vector_type(4)));
    const int tid = fresh_tid(), lane = tid & 63, wave = C.wave, x = lane & 15, q = lane >> 4;
    constexpr int LDL = 280;
    LAS bf16_t* Ls = (LAS bf16_t*)C.lds;
    const GAS bf16_t* PA = (const GAS bf16_t*)uni(P.PA); GAS bf16_t* AP = (GAS bf16_t*)uni(P.AP); GAS bf16_t* GA = (GAS bf16_t*)uni(P.GA); const GAS bf16_t* WL = (const GAS bf16_t*)uni(P.WL_T);
    const GAS float* mp = (const GAS float*)P.mu_prev + l * 1024 + 768; const GAS float* mn = (const GAS float*)P.mu_next + l * 1024 + 768;
    const GAS float* w0 = (const GAS float*)P.w0 + l * 512; const GAS float* a0 = (const GAS float*)P.a0 + l * 512;
    bf16x8l wf[5][2][4]; f32x4l bs[5][2];
#pragma unroll
    for (int pi = 0; pi < 5; ++pi) { const int pr = pi < 2 ? wave * 2 + pi : (pi < 4 ? 16 + wave * 2 + (pi - 2) : 32 + wave), n0 = pr * 32, kb = pi < 2 ? 0 : (pi < 4 ? 64 : 128), nks = pi < 4 ? 2 : 4;
        const int nrow = n0 + 8 * (x >> 2) + (x & 3);
#pragma unroll
        for (int ks = 0; ks < nks; ++ks) { wf[pi][0][ks] = *(const GAS bf16x8l*)(WL + (size_t)nrow * 256 + kb + ks * 32 + q * 8); wf[pi][1][ks] = *(const GAS bf16x8l*)(WL + (size_t)(nrow + 4) * 256 + kb + ks * 32 + q * 8); }
        const f32x4l z4 = {0.f, 0.f, 0.f, 0.f};
        bs[pi][0] = pi < 2 ? *(const GAS f32x4l*)(w0 + n0 + 8 * q) : (pi < 4 ? *(const GAS f32x4l*)(a0 + n0 - 512 + 8 * q) : z4);
        bs[pi][1] = pi < 2 ? *(const GAS f32x4l*)(w0 + n0 + 8 * q + 4) : (pi < 4 ? *(const GAS f32x4l*)(a0 + n0 - 512 + 8 * q + 4) : z4); }
    for (int rb = (int)blockIdx.x; rb < MROWS / 128; rb += C.G) { const long t0 = (long)rb * 128;
#pragma unroll
        for (int hb = 0; hb < 2; ++hb) { u32x4g rf[4], rp[4], rn[4];
#pragma unroll
            for (int u = 0; u < 4; ++u) { const int it = tid + (hb * 4 + u) * 512; const int r = it >> 5, c8 = it & 31; const long t = t0 + r; const int s = (int)(t % NS); const u32x4g z = {0u, 0u, 0u, 0u};
                const GAS u32x4g* p = (const GAS u32x4g*)(PA + t * 1024 + 768 + c8 * 8); rf[u] = __builtin_nontemporal_load(p); rp[u] = s > 0 ? __builtin_nontemporal_load(p - 128) : z; rn[u] = s < NS - 1 ? __builtin_nontemporal_load(p + 128) : z; }
#pragma unroll
            for (int u = 0; u < 4; ++u) { const int it = tid + (hb * 4 + u) * 512; const int r = it >> 5, c8 = it & 31, c0 = c8 * 8; float f[8], pv[8], nx[8], o[8]; unpack8(rf[u], f); unpack8(rp[u], pv); unpack8(rn[u], nx);
                const bool is_tanh = c0 < 64, is_id = c0 >= 64 && c0 < 128; const float am = is_tanh ? -2.0f : -1.0f;
                const f32x4l p0 = *(const GAS f32x4l*)(mp + c0), p1 = *(const GAS f32x4l*)(mp + c0 + 4), q0 = *(const GAS f32x4l*)(mn + c0), q1 = *(const GAS f32x4l*)(mn + c0 + 4);
#pragma unroll
                for (int j = 0; j < 8; ++j) { const float v = f[j] + (j < 4 ? p0[j & 3] : p1[j & 3]) * (pv[j] - f[j]) + (j < 4 ? q0[j & 3] : q1[j & 3]) * (nx[j] - f[j]);
                    const float sg = __builtin_amdgcn_rcpf(1.0f + __expf(am * v)); o[j] = is_id ? v : (is_tanh ? 2.0f * sg - 1.0f : sg); }
                *(LAS u32x4g*)(Ls + r * LDL + c0) = pack8(o); } }
        __syncthreads();
#pragma unroll
        for (int pi = 0; pi < 5; ++pi) { const int pr = pi < 2 ? wave * 2 + pi : (pi < 4 ? 16 + wave * 2 + (pi - 2) : 32 + wave), n0 = pr * 32, kb = pi < 2 ? 0 : (pi < 4 ? 64 : 128), nks = pi < 4 ? 2 : 4;
            GAS bf16_t* ob = pi < 4 ? AP + 768 + n0 + 8 * q : GA + (n0 - 1024) + 8 * q; const int ldd = pi < 4 ? 1792 : 256; const float sc = pi < 2 ? 0.6065306597f : 1.0f;
#pragma unroll 2
            for (int rt = 0; rt < 8; ++rt) { f32x4l a0v = {0.f, 0.f, 0.f, 0.f}, a1v = {0.f, 0.f, 0.f, 0.f};
#pragma unroll
                for (int ks = 0; ks < nks; ++ks) { const bf16x8l af = *(const LAS bf16x8l*)(Ls + (rt * 16 + x) * LDL + kb + ks * 32 + q * 8);
                    a0v = __builtin_amdgcn_mfma_f32_16x16x32_bf16(wf[pi][0][ks], af, a0v, 0, 0, 0); a1v = __builtin_amdgcn_mfma_f32_16x16x32_bf16(wf[pi][1][ks], af, a1v, 0, 0, 0); }
                f32x4l v0 = a0v + bs[pi][0], v1 = a1v + bs[pi][1];
                if (pi < 4) {
#pragma unroll
                    for (int i = 0; i < 4; ++i) { v0[i] = sc * __builtin_amdgcn_rcpf(1.0f + __expf(-v0[i])); v1[i] = sc * __builtin_amdgcn_rcpf(1.0f + __expf(-v1[i])); } }
                u32x4g w; w.x = pk2(v0[0], v0[1]); w.y = pk2(v0[2], v0[3]); w.z = pk2(v1[0], v1[1]); w.w = pk2(v1[2], v1[3]);
                *(GAS u32x4g*)(ob + (size_t)(t0 + rt * 16 + x) * ldd) = w; } }
        __syncthreads();
    }
}
__device__ __forceinline__ void ph_prepC_conv_v(PRef P, int l, long gid, long gs) {
    const float* __restrict__ cw = P.conv + (size_t)l * 5 * 768; const bf16_t* __restrict__ PC = P.PC; bf16_t* __restrict__ CP = P.CP;
#pragma unroll 2
    for (long i = gid; i < (long)MROWS * 96; i += gs) {
        const long t = i / 96; const int cg = (int)(i % 96), c0 = cg * 8; const int s = (int)(t % NS);
        float a[8];
#pragma unroll
        for (int j = 0; j < 8; ++j) a[j] = 0.f;
#pragma unroll
        for (int q = 0; q < 5; ++q) { const int sq = s + q - 2;
            if (sq >= 0 && sq < NS) { float x[8]; unpack8(*(const u32x4g*)(PC + (t + q - 2) * 1024 + c0), x);
#pragma unroll
                for (int j = 0; j < 8; ++j) a[j] += x[j] * cw[q * 768 + c0 + j]; } }
        float ss = 0.f;
#pragma unroll
        for (int j = 0; j < 8; ++j) { a[j] = siluf_(a[j]); ss += a[j] * a[j]; }
        ss = oct_sum(ss);
        float sc = 1.0f;
        if (cg < 64) sc = 1.0f / sqrtf(ss + 1e-12f);
        if (cg < 32) sc *= 0.125f;
#pragma unroll
        for (int j = 0; j < 8; ++j) a[j] *= sc;
        *(u32x4g*)(CP + t * 768 + c0) = pack8(a);
    }
}
__device__ __forceinline__ void ph_fixA_v(PRef P, int l, long gid, long gs) {
    const float* lw = P.ln_w + l * 256; const float* lb = P.ln_b + l * 256; const bf16_t* __restrict__ YA = P.YA; const bf16_t* __restrict__ PA = P.PA; const float* __restrict__ mp = P.mu_prev + l * 1024; const float* __restrict__ mn = P.mu_next + l * 1024; const bf16_t* __restrict__ GA = P.GA; const float* __restrict__ BON = P.RN; bf16_t* __restrict__ MIX = P.MIX;
#pragma unroll 4
    for (long i = gid; i < (long)MROWS * 32; i += gs) {
        const long t = i >> 5; const int c0 = (int)(i & 31) * 8, h = c0 >> 6;
        float y0[8], y1[8], v[8], g[8], y[8];
        unpack8(__builtin_nontemporal_load((const u32x4g*)(YA + t * 256 + c0)), y0); unpack8(__builtin_nontemporal_load((const u32x4g*)(YA + ((size_t)MROWS + t) * 256 + c0)), y1);
        { const int s = (int)(t % NS); float f[8], pv[8], nx[8]; unpack8(*(const u32x4g*)(PA + t * 1024 + 512 + c0), f);
          if (s > 0) unpack8(*(const u32x4g*)(PA + (t - 1) * 1024 + 512 + c0), pv); else {
#pragma unroll
              for (int j = 0; j < 8; ++j) pv[j] = 0.f; }
          if (s < NS - 1) unpack8(*(const u32x4g*)(PA + (t + 1) * 1024 + 512 + c0), nx); else {
#pragma unroll
              for (int j = 0; j < 8; ++j) nx[j] = 0.f; }
#pragma unroll
          for (int j = 0; j < 8; ++j) v[j] = f[j] + mp[512 + c0 + j] * (pv[j] - f[j]) + mn[512 + c0 + j] * (nx[j] - f[j]); }
        unpack8(__builtin_nontemporal_load((const u32x4g*)(GA + t * 256 + c0)), g);
        float sm = 0.f;
#pragma unroll
        for (int j = 0; j < 8; ++j) { y[j] = y0[j] + y1[j]; sm += y[j]; }
        const float mean = oct_sum(sm) * (1.0f / 64); float var = 0.f;
#pragma unroll
        for (int j = 0; j < 8; ++j) { const float d = y[j] - mean; var += d * d; }
        const float rstd = 1.0f / sqrtf(oct_sum(var) * (1.0f / 64) + 64e-5f);
        const float bo = BON[t * 4 + h] + BON[((size_t)MROWS + t) * 4 + h];
#pragma unroll
        for (int j = 0; j < 8; ++j) y[j] = ((y[j] - mean) * rstd * lw[c0 + j] + lb[c0 + j] + bo * v[j]) * g[j];
        *(u32x4g*)(MIX + t * MIXW + c0) = pack8(y);
    }
}
__device__ __forceinline__ void ph_fixC_v(PRef P, int l, long gid, long gs) {
    const float* __restrict__ ng = P.gdn_norm_g + l * 64; const bf16_t* __restrict__ OC = P.OC; const bf16_t* __restrict__ PC = P.PC; bf16_t* __restrict__ MIX = P.MIX;
#pragma unroll 4
    for (long i = gid; i < (long)MROWS * 32; i += gs) {
        const long t = i >> 5; const int c0 = (int)(i & 31) * 8;
        float o0[8], o1[8], z[8], o[8];
        unpack8(__builtin_nontemporal_load((const u32x4g*)(OC + t * 256 + c0)), o0); unpack8(__builtin_nontemporal_load((const u32x4g*)(OC + ((size_t)MROWS + t) * 256 + c0)), o1); unpack8(__builtin_nontemporal_load((const u32x4g*)(PC + t * 1024 + 768 + c0)), z);
        float ss = 0.f;
#pragma unroll
        for (int j = 0; j < 8; ++j) { o[j] = o0[j] + o1[j]; ss += o[j] * o[j]; }
        const float rs = 1.0f / sqrtf(oct_sum(ss) * (1.0f / 64) + 1e-6f);
#pragma unroll
        for (int j = 0; j < 8; ++j) o[j] = o[j] * rs * ng[(c0 & 63) + j] * (z[j] * __builtin_amdgcn_rcpf(1.0f + __expf(-z[j])));
        *(u32x4g*)(MIX + t * MIXW + 512 + c0) = pack8(o);
    }
}
__device__ __forceinline__ void ph_fixD_v(PRef P, long gid, long gs) {
    const float* ML = P.ML; bf16_t* MIX = P.MIX;
    for (long i = gid; i < (long)MROWS * 48; i += gs) {
        const long t = i / 48; const int cg = (int)(i % 48), hd = cg >> 3, br = hd >> 1, jh = hd & 1;
        float m[3], lv[3]; float mx = -1e30f;
#pragma unroll
        for (int b2 = 0; b2 < 3; ++b2) { m[b2] = ML[t * 12 + (b2 * 2 + jh) * 2]; lv[b2] = ML[t * 12 + (b2 * 2 + jh) * 2 + 1]; mx = fmaxf(mx, m[b2]); }
        float sum = 0.f, mine = 0.f;
#pragma unroll
        for (int b2 = 0; b2 < 3; ++b2) { const float dn = lv[b2] * __expf(m[b2] - mx); sum += dn; mine = b2 == br ? dn : mine; }
        const float w = mine / sum; float x[8];
        u32x4g* p = (u32x4g*)(MIX + t * MIXW + 768 + cg * 8); unpack8(*p, x);
#pragma unroll
        for (int j = 0; j < 8; ++j) x[j] *= w;
        *p = pack8(x);
    }
}
__device__ __forceinline__ void ph_topk_lds(PRef P, Ctx& C) {
    const int tid = fresh_tid(), lane = tid & 63, wave = C.wave; LAS unsigned long long* keys = (LAS unsigned long long*)C.lds;
    LAS int* sel = (LAS int*)(C.lds + NS * 8);
    LAS int* wc = sel + NS / 2;
    const GAS float* AFF = (const GAS float*)uni(P.AFF); GAS int* IDX = (GAS int*)uni(P.IDX); GAS float* GATE = (GAS float*)uni(P.GATE); GAS int* SLOT = (GAS int*)uni(P.SLOT);
    const GAS bf16_t* HN = (const GAS bf16_t*)uni(P.XN); GAS bf16_t* XS = (GAS bf16_t*)uni(P.XS);
    for (int it = (int)blockIdx.x; it < NB * NEXP * 2; it += C.G) { const int half = it & 1, be = it >> 1, e = be % NEXP, b = be / NEXP;
        const GAS float* af = AFF + (size_t)b * NS * NEXP + e;
        unsigned long long k[NS / 512];
#pragma unroll
        for (int j = 0; j < NS / 512; ++j) { const int s = tid + 512 * j; k[j] = ((unsigned long long)__float_as_uint(af[(size_t)s * NEXP]) << 32) | (unsigned)(0xFFFFFFFFu - (unsigned)s); keys[s] = k[j]; }
        unsigned long long T = 0ull; int round = 0, cntT = NS;
#pragma unroll 1
        for (int bit = 61; bit >= 0 && cntT != CAP; --bit) { if (bit == 31) { T |= 0xFFFFF000ull; bit = 11; }
            const unsigned long long cand = T | (1ull << bit); int c = 0;
#pragma unroll
            for (int j = 0; j < NS / 512; ++j) c += __popcll(__ballot(k[j] >= cand));
            if (lane == 0) wc[(round & 1) * 8 + wave] = c;
            __syncthreads();
            int tot = 0;
#pragma unroll
            for (int w = 0; w < 8; ++w) tot += wc[(round & 1) * 8 + w];
            if (tot >= CAP) { T = cand; cntT = tot; }
            ++round; }
        const int s0 = half * (NS / 2) + 4 * tid; unsigned long long mk[4]; int mysel = 0;
#pragma unroll
        for (int j = 0; j < 4; ++j) { mk[j] = keys[s0 + j]; mysel += mk[j] >= T ? 1 : 0; }
        int pre = mysel;
#pragma unroll
        for (int o = 1; o < 64; o <<= 1) { const int t = __shfl_up(pre, o); if (lane >= o) pre += t; }
        __syncthreads();
        if (lane == 63) wc[wave] = pre;
        __syncthreads();
        int woff = 0, htot = 0;
#pragma unroll
        for (int w = 0; w < 8; ++w) { const int t = wc[w]; htot += t; woff += w < wave ? t : 0; }
        const int hbase = half ? CAP - htot : 0;
        int local = woff + pre - mysel;
#pragma unroll
        for (int j = 0; j < 4; ++j) { const int s = s0 + j; const long t = (long)b * NS + s;
            if (mk[j] >= T) { const int slot = hbase + local; const long p = ((long)e * NB + b) * CAP + slot; IDX[p] = (int)t; GATE[p] = __uint_as_float((unsigned)(mk[j] >> 32)); SLOT[t * NEXP + e] = slot;
                sel[local] = (s << 10) | slot; ++local; }
            else SLOT[t * NEXP + e] = -1; }
        __syncthreads();
    }
}
template <int CTRL> __device__ __forceinline__ float dppf(float x) { return __builtin_bit_cast(float, __builtin_amdgcn_mov_dpp(__builtin_bit_cast(int, x), CTRL, 0xf, 0xf, true)); }
constexpr int DPP_XOR1 = 0xB1, DPP_XOR2 = 0x4E, DPP_ROR4 = 0x124, DPP_ROR8 = 0x128;
__device__ __forceinline__ float xrow_sum(float x) {
    auto s = __builtin_amdgcn_permlane16_swap(__float_as_uint(x), __float_as_uint(x), false, false); x = __uint_as_float(s[0]) + __uint_as_float(s[1]);
    auto t = __builtin_amdgcn_permlane32_swap(__float_as_uint(x), __float_as_uint(x), false, false); return __uint_as_float(t[0]) + __uint_as_float(t[1]); }
__device__ __forceinline__ float xrow_max(float x) {
    auto s = __builtin_amdgcn_permlane16_swap(__float_as_uint(x), __float_as_uint(x), false, false); x = fmaxf(__uint_as_float(s[0]), __uint_as_float(s[1]));
    auto t = __builtin_amdgcn_permlane32_swap(__float_as_uint(x), __float_as_uint(x), false, false); return fmaxf(__uint_as_float(t[0]), __uint_as_float(t[1])); }
__device__ __forceinline__ float wave_sum(float v) {
    v += dppf<DPP_XOR1>(v); v += dppf<DPP_XOR2>(v); v += dppf<DPP_ROR4>(v); v += dppf<DPP_ROR8>(v); return xrow_sum(v); }
__device__ __forceinline__ void ph_norm_rows_w(const float* x, const float* g, bf16_t* XN, Ctx& C) {
    const int lane = fresh_tid() & 63;
    const int gw = (int)blockIdx.x * 8 + C.wave, NGW = C.G * 8;
    for (int row = gw; row < MROWS; row += NGW) {
        const GAS f32x4* xr = (const GAS f32x4*)(x + (size_t)row * DM) + lane; f32x4 v[4]; float ss = 0.f;
#pragma unroll
        for (int j = 0; j < 4; ++j) { v[j] = __builtin_nontemporal_load(xr + 64 * j); ss += (v[j].x * v[j].x + v[j].y * v[j].y) + (v[j].z * v[j].z + v[j].w * v[j].w); }
        const float rs = 1.0f / sqrtf(wave_sum(ss) * (1.0f / DM) + 1e-6f);
        GAS unsigned long long* o8 = (GAS unsigned long long*)(XN + (size_t)row * DM) + lane;
#pragma unroll
        for (int j = 0; j < 4; ++j) { const f32x4 gg = ((const GAS f32x4*)g)[lane + 64 * j];
            o8[64 * j] = (unsigned long long)pk2(v[j].x * rs * gg.x, v[j].y * rs * gg.y) | ((unsigned long long)pk2(v[j].z * rs * gg.z, v[j].w * rs * gg.w) << 32); }
    }
}
__device__ __forceinline__ void ph_router_mfma(PRef P, int l, Ctx& C) {
    typedef short bf16x8r __attribute__((ext_vector_type(8))); typedef float f32x4r __attribute__((ext_vector_type(4)));
    const int tid = fresh_tid(), lane = tid & 63, x = lane & 15, q = lane >> 4;
    const int gw = (int)blockIdx.x * 8 + C.wave, NGW = C.G * 8;
    const GAS float* g = (const GAS float*)(P.norm_ffn_g + l * DM); const GAS float* rw = (const GAS float*)(P.router_w + (size_t)l * DM * NEXP); const GAS float* rb = (const GAS float*)(P.router_b + l * NEXP);
    const GAS bf16_t* xin = (const GAS bf16_t*)P.XR; GAS bf16_t* HN = (GAS bf16_t*)P.XN; GAS float* AFF = (GAS float*)P.AFF;
    LAS bf16_t* Wt = (LAS bf16_t*)C.lds;
    LAS float* gl = (LAS float*)(C.lds + 65536);
#pragma unroll
    for (int it_ = 0; it_ < DM * NEXP / 512; ++it_) { const int idx = tid + it_ * 512; const int c = idx >> 4, e = idx & 15; const float w = rw[idx] * g[c]; const bf16_t hi = f2bf_hw(w); const bf16_t lo = f2bf_hw(w - __uint_as_float((unsigned)hi << 16));
        const int ks = c >> 5, k = c & 31; Wt[((ks * 2 + 0) * 16 + e) * 32 + k] = hi; Wt[((ks * 2 + 1) * 16 + e) * 32 + k] = lo; }
    for (int c = tid; c < DM; c += 512) gl[c] = g[c];
    __syncthreads();
    for (int blk = gw; blk < MROWS / 16; blk += NGW) {
        const size_t row = (size_t)blk * 16 + x; const GAS bf16x8r* xp = (const GAS bf16x8r*)(xin + row * DM + 8 * q);
        bf16x8r xf[32];
#pragma unroll
        for (int ks = 0; ks < 32; ++ks) xf[ks] = __builtin_nontemporal_load(xp + ks * 4);
        f32x4r acc = {0.f, 0.f, 0.f, 0.f}, sq = {0.f, 0.f, 0.f, 0.f};
#pragma unroll
        for (int ks = 0; ks < 32; ++ks) { const LAS bf16x8r* wp = (const LAS bf16x8r*)(Wt + ((ks * 2) * 16 + x) * 32 + q * 8);
            const bf16x8r whi = wp[0], wlo = wp[64];
            acc = __builtin_amdgcn_mfma_f32_16x16x32_bf16(whi, xf[ks], acc, 0, 0, 0); acc = __builtin_amdgcn_mfma_f32_16x16x32_bf16(wlo, xf[ks], acc, 0, 0, 0);
            sq = __builtin_amdgcn_mfma_f32_16x16x32_bf16(xf[ks], xf[ks], sq, 0, 0, 0);
            if (ks & 1) __builtin_amdgcn_sched_barrier(0); }
        float dv = (x & 3) == 0 ? sq[0] : ((x & 3) == 1 ? sq[1] : ((x & 3) == 2 ? sq[2] : sq[3])); dv = q == (x >> 2) ? dv : 0.f;
        const float rs = 1.0f / sqrtf(xrow_sum(dv) * (1.0f / DM) + 1e-6f);
        const f32x4r rb4 = *(const GAS f32x4r*)(rb + 4 * q); f32x4r lg; float mx = -1e30f;
#pragma unroll
        for (int i = 0; i < 4; ++i) { lg[i] = acc[i] * rs + rb4[i]; mx = fmaxf(mx, lg[i]); }
        mx = xrow_max(mx); float sum = 0.f;
#pragma unroll
        for (int i = 0; i < 4; ++i) { lg[i] = __expf(lg[i] - mx); sum += lg[i]; }
        sum = xrow_sum(sum); const float inv = 1.0f / sum;
        *(GAS f32x4r*)(AFF + row * NEXP + 4 * q) = lg * inv;
        GAS u32x4g* hp = (GAS u32x4g*)(HN + row * DM + 8 * q);
#pragma unroll
        for (int ks = 0; ks < 32; ++ks) { const u32x4g w = __builtin_bit_cast(u32x4g, xf[ks]); float f[8]; unpack8(w, f);
            const f32x4r g0 = *(const LAS f32x4r*)(gl + 32 * ks + 8 * q), g1 = *(const LAS f32x4r*)(gl + 32 * ks + 8 * q + 4);
#pragma unroll
            for (int j = 0; j < 4; ++j) { f[j] = f[j] * rs * g0[j]; f[4 + j] = f[4 + j] * rs * g1[j]; }
            hp[ks * 4] = pack8(f); if (ks & 1) __builtin_amdgcn_sched_barrier(0); }
    }
}
__device__ __forceinline__ void ph_router_w(PRef P, int l, Ctx& C) {
    const int tid = fresh_tid(), lane = tid & 63;
    const int gw = (int)blockIdx.x * 8 + C.wave, NGW = C.G * 8;
    const float* g = P.norm_ffn_g + l * DM; const float* rw = P.router_w + (size_t)l * DM * NEXP; const float* rb = P.router_b + l * NEXP;
    const bf16_t* xin = P.XR; bf16_t* HN = P.XN; GAS float* AFF = (GAS float*)P.AFF;
    LAS float* T = (LAS float*)C.lds;
    for (int idx = tid; idx < DM * NEXP / 4; idx += 512) { const int c = idx >> 2, e4 = idx & 3; const int j = c >> 8, ln = (c & 255) >> 2, i = c & 3;
        *(LAS f32x4*)(T + ((j * 4 + i) * 64 + ln) * 20 + e4 * 4) = *(const GAS f32x4*)(rw + (size_t)c * NEXP + e4 * 4); }
    __syncthreads();
    unsigned long long nx[4];
    if (gw < MROWS) { const GAS unsigned long long* xr = (const GAS unsigned long long*)(xin + (size_t)gw * DM) + lane;
#pragma unroll
        for (int j = 0; j < 4; ++j) nx[j] = xr[64 * j]; }
    const float rbl = rb[lane >> 2];
    for (int row = gw; row < MROWS; row += NGW) {
        unsigned long long cw[4];
#pragma unroll
        for (int j = 0; j < 4; ++j) cw[j] = nx[j];
        if (row + NGW < MROWS) { const GAS unsigned long long* xr = (const GAS unsigned long long*)(xin + (size_t)(row + NGW) * DM) + lane;
#pragma unroll
            for (int j = 0; j < 4; ++j) nx[j] = xr[64 * j]; }
        f32x4 v[4]; float ss = 0.f;
#pragma unroll
        for (int j = 0; j < 4; ++j) { const unsigned lo = (unsigned)cw[j], hi = (unsigned)(cw[j] >> 32);
            v[j] = (f32x4){__uint_as_float(lo << 16), __uint_as_float(lo & 0xffff0000u), __uint_as_float(hi << 16), __uint_as_float(hi & 0xffff0000u)};
            ss += (v[j].x * v[j].x + v[j].y * v[j].y) + (v[j].z * v[j].z + v[j].w * v[j].w); }
        const float rs = 1.0f / sqrtf(wave_sum(ss) * (1.0f / DM) + 1e-6f);
        float lg[NEXP];
#pragma unroll
        for (int e = 0; e < NEXP; ++e) lg[e] = 0.f;
        GAS unsigned long long* o8 = (GAS unsigned long long*)(HN + (size_t)row * DM) + lane;
#pragma unroll
        for (int j = 0; j < 4; ++j) { const f32x4 gg = ((const GAS f32x4*)g)[lane + 64 * j]; v[j] = (f32x4){v[j].x * rs * gg.x, v[j].y * rs * gg.y, v[j].z * rs * gg.z, v[j].w * rs * gg.w};
            o8[64 * j] = (unsigned long long)pk2(v[j].x, v[j].y) | ((unsigned long long)pk2(v[j].z, v[j].w) << 32); }
        { const LAS f32x4* wr = (const LAS f32x4*)(T + lane * 20); f32x4 wb[2][4];
#pragma unroll
          for (int e4 = 0; e4 < 4; ++e4) wb[0][e4] = wr[e4];
#pragma unroll
          for (int gi = 0; gi < 16; ++gi) { const float xv = v[gi >> 2][gi & 3];
            if (gi + 1 < 16) {
#pragma unroll
                for (int e4 = 0; e4 < 4; ++e4) wb[(gi + 1) & 1][e4] = wr[(gi + 1) * 64 * 5 + e4]; }
#pragma unroll
            for (int e4 = 0; e4 < 4; ++e4) { const f32x4 w4 = wb[gi & 1][e4]; lg[e4 * 4] += xv * w4.x; lg[e4 * 4 + 1] += xv * w4.y; lg[e4 * 4 + 2] += xv * w4.z; lg[e4 * 4 + 3] += xv * w4.w; }
            __builtin_amdgcn_sched_barrier(0); } }
        float t8[8], t4[4], t2[2], lgt;
#pragma unroll
        for (int k = 0; k < 8; ++k) { auto sw = __builtin_amdgcn_permlane32_swap(__float_as_uint(lg[k]), __float_as_uint(lg[8 + k]), false, false); t8[k] = __uint_as_float(sw[0]) + __uint_as_float(sw[1]); }
#pragma unroll
        for (int k = 0; k < 4; ++k) { auto sw = __builtin_amdgcn_permlane16_swap(__float_as_uint(t8[k]), __float_as_uint(t8[4 + k]), false, false); t4[k] = __uint_as_float(sw[0]) + __uint_as_float(sw[1]); }
        { const bool up = (lane & 8) != 0;
#pragma unroll
          for (int k = 0; k < 2; ++k) { const float snd = up ? t4[k] : t4[2 + k], mine = up ? t4[2 + k] : t4[k]; t2[k] = mine + dppf<DPP_ROR8>(snd); } }
        { const bool up = (lane & 4) != 0; const float snd = up ? t2[0] : t2[1], mine = up ? t2[1] : t2[0]; lgt = mine + __shfl_xor(snd, 4); }
        lgt += dppf<DPP_XOR1>(lgt); lgt += dppf<DPP_XOR2>(lgt); lgt += rbl;
        float mx = fmaxf(lgt, dppf<DPP_ROR4>(lgt)); mx = fmaxf(mx, dppf<DPP_ROR8>(mx)); mx = xrow_max(mx);
        const float pe = __expf(lgt - mx); float sum = pe + dppf<DPP_ROR4>(pe); sum += dppf<DPP_ROR8>(sum); sum = xrow_sum(sum);
        if ((lane & 3) == 0) AFF[(size_t)row * NEXP + (lane >> 2)] = pe / sum;
    }
}
__device__ __forceinline__ void ph_combine_norm_w(PRef P, int l, Ctx& C) {
    const int lane = fresh_tid() & 63;
    const int gw = (int)blockIdx.x * 8 + C.wave, NGW = C.G * 8;
    GAS float* out = (GAS float*)P.out; GAS bf16_t* XR = (GAS bf16_t*)P.XR; const GAS bf16_t* YS = (const GAS bf16_t*)P.YS; const GAS int* SLOT = (const GAS int*)P.SLOT; GAS bf16_t* XN = (GAS bf16_t*)P.XN;
    const float* __restrict__ g = l == 0 ? P.norm_mix_g + DM : P.norm_final_g;
    unsigned long long nx[2][4]; int nsl[2];
    if (gw * 2 < MROWS) {
#pragma unroll
        for (int r = 0; r < 2; ++r) { const GAS unsigned long long* xr = (const GAS unsigned long long*)(XR + (size_t)(gw * 2 + r) * DM) + lane;
#pragma unroll
            for (int j = 0; j < 4; ++j) nx[r][j] = __builtin_nontemporal_load(xr + 64 * j);
            nsl[r] = lane < NEXP ? SLOT[(size_t)(gw * 2 + r) * NEXP + lane] : -1; } }
    for (int row0 = gw * 2; row0 < MROWS; row0 += NGW * 2) {
        f32x4 v[2][4]; int csl[2];
#pragma unroll
        for (int r = 0; r < 2; ++r) { csl[r] = nsl[r];
#pragma unroll
            for (int j = 0; j < 4; ++j) { const unsigned lo = (unsigned)nx[r][j], hi = (unsigned)(nx[r][j] >> 32);
                v[r][j] = (f32x4){__uint_as_float(lo << 16), __uint_as_float(lo & 0xffff0000u), __uint_as_float(hi << 16), __uint_as_float(hi & 0xffff0000u)}; } }
        if (row0 + NGW * 2 < MROWS) {
#pragma unroll
            for (int r = 0; r < 2; ++r) { const GAS unsigned long long* xr = (const GAS unsigned long long*)(XR + (size_t)(row0 + NGW * 2 + r) * DM) + lane;
#pragma unroll
                for (int j = 0; j < 4; ++j) nx[r][j] = __builtin_nontemporal_load(xr + 64 * j);
                nsl[r] = lane < NEXP ? SLOT[(size_t)(row0 + NGW * 2 + r) * NEXP + lane] : -1; } }
        const int b = row0 / NS;
        unsigned m[2];
#pragma unroll
        for (int r = 0; r < 2; ++r) m[r] = (unsigned)__ballot(csl[r] >= 0);
        while (m[0] | m[1]) {
            unsigned long long buf[2][2][4]; bool has[2][2];
#pragma unroll
            for (int r = 0; r < 2; ++r)
#pragma unroll
                for (int k = 0; k < 2; ++k) { has[r][k] = m[r] != 0u;
                    if (has[r][k]) { const int e = __builtin_ctz(m[r]); m[r] &= m[r] - 1u; const int sl = __builtin_amdgcn_readlane(csl[r], e);
                        const GAS unsigned long long* yr = (const GAS unsigned long long*)(YS + (((size_t)e * NB + b) * CAP + sl) * DM) + lane;
#pragma unroll
                        for (int j = 0; j < 4; ++j) buf[r][k][j] = __builtin_nontemporal_load(yr + 64 * j); } }
#pragma unroll
            for (int r = 0; r < 2; ++r)
#pragma unroll
                for (int k = 0; k < 2; ++k) if (has[r][k]) {
#pragma unroll
                    for (int j = 0; j < 4; ++j) { const unsigned lo = (unsigned)buf[r][k][j], hi = (unsigned)(buf[r][k][j] >> 32);
                        v[r][j].x += __uint_as_float(lo << 16); v[r][j].y += __uint_as_float(lo & 0xffff0000u); v[r][j].z += __uint_as_float(hi << 16); v[r][j].w += __uint_as_float(hi & 0xffff0000u); } }
        }
#pragma unroll
        for (int r = 0; r < 2; ++r) { float ss = 0.f;
#pragma unroll
            for (int j = 0; j < 4; ++j) ss += (v[r][j].x * v[r][j].x + v[r][j].y * v[r][j].y) + (v[r][j].z * v[r][j].z + v[r][j].w * v[r][j].w);
            const float rs = 1.0f / sqrtf(wave_sum(ss) * (1.0f / DM) + 1e-6f);
            if (l == 0) { GAS unsigned long long* x8 = (GAS unsigned long long*)(XR + (size_t)(row0 + r) * DM) + lane; GAS unsigned long long* o8 = (GAS unsigned long long*)(XN + (size_t)(row0 + r) * DM) + lane;
#pragma unroll
                for (int j = 0; j < 4; ++j) { x8[64 * j] = (unsigned long long)pk2(v[r][j].x, v[r][j].y) | ((unsigned long long)pk2(v[r][j].z, v[r][j].w) << 32); const f32x4 gg = ((const GAS f32x4*)g)[lane + 64 * j];
                    o8[64 * j] = (unsigned long long)pk2(v[r][j].x * rs * gg.x, v[r][j].y * rs * gg.y) | ((unsigned long long)pk2(v[r][j].z * rs * gg.z, v[r][j].w * rs * gg.w) << 32); } }
            else { GAS f32x4* xo = (GAS f32x4*)(out + (size_t)(row0 + r) * DM) + lane;
#pragma unroll
                for (int j = 0; j < 4; ++j) { const f32x4 gg = ((const GAS f32x4*)g)[lane + 64 * j]; const f32x4 o = {v[r][j].x * rs * gg.x, v[r][j].y * rs * gg.y, v[r][j].z * rs * gg.z, v[r][j].w * rs * gg.w}; xo[64 * j] = o; } } }
    }
}
namespace dwin {
typedef short bf16x8 __attribute__((ext_vector_type(8)));
typedef float f32x4 __attribute__((ext_vector_type(4)));
typedef unsigned u32x4 __attribute__((ext_vector_type(4)));
constexpr int LDK = 72, LDV = 264;
__device__ __forceinline__ int t5b(int rel) { const int n = rel < 0 ? -rel : rel; int v; if (n < 8) v = n; else { int lg = 8 + (int)(logf((float)n / 8.0f) / 4.852030263919617f * 8.0f); v = lg < 15 ? lg : 15; } return (rel > 0 ? 16 : 0) + v; }
__device__ __forceinline__ void attnD_mfma(PRef P, Ctx& C, unsigned* ctr, volatile LAS int* tk) {
    const int tid = fresh_tid(), lane = tid & 63, wave = C.wave, x = lane & 15, q = lane >> 4;
    LAS bf16_t* Qs = (LAS bf16_t*)C.lds; LAS bf16_t* Ks = Qs + 128 * LDK; LAS bf16_t* VT = Ks + 256 * LDK; LAS float* tab = (LAS float*)(VT + 64 * LDV);
    typedef GAS bf16_t gbf; typedef GAS u32x4 gu32x4;
    const gbf* PD = (const gbf*)uni(P.PD); gbf* MIX = (gbf*)uni(P.MIX); GAS float* ML = (GAS float*)uni(P.ML); const float* rb = uni(P.rel_bias);
    constexpr int NSU = NB * 6 * (NS / 128);
    struct SU { int b, hd, dil, L, rho, i0; };
    auto decode = [&](int su, SU& u) { const int ib_all = su % (NS / 128); u.hd = (su / (NS / 128)) % 6; u.b = su / (6 * (NS / 128)); const int br = u.hd >> 1; u.dil = br == 0 ? 1 : (br == 1 ? 4 : 16); u.L = NS / u.dil;
        u.rho = ib_all / (u.L / 128); u.i0 = (ib_all % (u.L / 128)) * 128; };
    u32x4 kv0[2], vv0[2], kv1[2], vv1[2], qv[2]; float tabv = 0.f;
    auto issue = [&](const SU& u) { const gbf* base = PD + ((size_t)u.b * NS + u.rho) * 1280 + u.hd * 64; const long rstep = (long)u.dil * 1280;
#pragma unroll
        for (int it_ = 0; it_ < 2; ++it_) { const int idx = tid + it_ * 512; const int w = (idx >> 3) * 2, part = idx & 7, ik = u.i0 - 64 + w;
            const u32x4 z = {0u, 0u, 0u, 0u}; kv0[it_] = z; vv0[it_] = z; kv1[it_] = z; vv1[it_] = z; const gbf* rp = base + (long)ik * rstep + part * 8;
            if (ik >= 0 && ik < u.L) { kv0[it_] = *(const gu32x4*)(rp + 384); vv0[it_] = *(const gu32x4*)(rp + 768); }
            if (ik + 1 >= 0 && ik + 1 < u.L) { kv1[it_] = *(const gu32x4*)(rp + rstep + 384); vv1[it_] = *(const gu32x4*)(rp + rstep + 768); }
            const int r = idx >> 3; qv[it_] = *(const gu32x4*)(base + (long)(u.i0 + r) * rstep + part * 8); }
        if (tid < 224) tabv = (tid >= 32 && tid <= 160) ? rb[t5b((tid - 96) * u.dil) * 6 + u.hd] * 1.4426950408889634f : -1e30f; };
    if (tid == 0) tk[0] = (int)__hip_atomic_fetch_add(ctr, 1u, __ATOMIC_RELAXED, __HIP_MEMORY_SCOPE_AGENT);
    __syncthreads();
    int su = tk[0], par = 0; SU cu; cu.b = cu.hd = cu.rho = cu.i0 = 0; cu.dil = 1; cu.L = NS;
    if (su < NSU) { decode(su, cu); issue(cu); }
    while (su < NSU) {
        const int hd = cu.hd, b = cu.b, dil = cu.dil, L = cu.L, rho = cu.rho, i0 = cu.i0;
#pragma unroll
        for (int it_ = 0; it_ < 2; ++it_) { const int idx = tid + it_ * 512; const int w = (idx >> 3) * 2, part = idx & 7;
            *(LAS u32x4*)(Ks + w * LDK + part * 8) = kv0[it_]; *(LAS u32x4*)(Ks + (w + 1) * LDK + part * 8) = kv1[it_];
            const int pos = (w & ~31) + 8 * ((w >> 2) & 3) + 4 * ((w >> 4) & 1) + (w & 3); const unsigned a[4] = {vv0[it_].x, vv0[it_].y, vv0[it_].z, vv0[it_].w}, c[4] = {vv1[it_].x, vv1[it_].y, vv1[it_].z, vv1[it_].w};
#pragma unroll
            for (int j = 0; j < 4; ++j) { *(LAS unsigned*)(VT + (part * 8 + 2 * j) * LDV + pos) = (a[j] & 0xffffu) | (c[j] << 16); *(LAS unsigned*)(VT + (part * 8 + 2 * j + 1) * LDV + pos) = (a[j] >> 16) | (c[j] & 0xffff0000u); }
            const int r = idx >> 3; *(LAS u32x4*)(Qs + r * LDK + part * 8) = qv[it_]; }
        if (tid < 224) tab[tid] = tabv;
        if (tid == 0) tk[par ^ 1] = (int)__hip_atomic_fetch_add(ctr, 1u, __ATOMIC_RELAXED, __HIP_MEMORY_SCOPE_AGENT);
        __syncthreads();
        const int sun = tk[par ^ 1];
        if (sun < NSU) { decode(sun, cu); issue(cu); }
        const int r0 = wave * 16, tstart = (r0 >> 4) & ~1, qw = 64 + r0 + x;
        f32x4 st[10];
        bf16x8 qa[2];
#pragma unroll
        for (int ks = 0; ks < 2; ++ks) qa[ks] = *(const LAS bf16x8*)(Qs + (r0 + x) * LDK + ks * 32 + q * 8);
#pragma unroll
        for (int t = 0; t < 10; ++t) { f32x4 acc = {0.f, 0.f, 0.f, 0.f};
#pragma unroll
            for (int ks = 0; ks < 2; ++ks) { const bf16x8 ka = *(const LAS bf16x8*)(Ks + ((tstart + t) * 16 + x) * LDK + ks * 32 + q * 8); acc = __builtin_amdgcn_mfma_f32_16x16x32_bf16(ka, qa[ks], acc, 0, 0, 0); }
            st[t] = acc; }
        float mx = -1e30f;
        { const int tb = 32 + 4 * q - x - 16 * (wave & 1);
          const LAS float* tp = tab + tb;
#pragma unroll
          for (int t = 0; t < 10; ++t)
#pragma unroll
            for (int i = 0; i < 4; ++i) st[t][i] = fmaf(st[t][i], 0.125f * 1.4426950408889634f, tp[16 * t + i]);
          if (i0 == 0 || i0 + 128 == L) {
#pragma unroll
            for (int t = 0; t < 10; ++t)
#pragma unroll
              for (int i = 0; i < 4; ++i) { const int ik = i0 - 64 + 16 * (tstart + t) + 4 * q + i; st[t][i] = (ik >= 0 && ik < L) ? st[t][i] : -1e30f; } }
#pragma unroll
          for (int t = 0; t < 10; ++t)
#pragma unroll
            for (int i = 0; i < 4; ++i) mx = fmaxf(mx, st[t][i]); }
        mx = fmaxf(mx, __shfl_xor(mx, 16)); mx = fmaxf(mx, __shfl_xor(mx, 32));
        float ls = 0.f;
#pragma unroll
        for (int t = 0; t < 10; ++t)
#pragma unroll
            for (int i = 0; i < 4; ++i) { const float p = exp2f(st[t][i] - mx); st[t][i] = p; ls += p; }
        ls += __shfl_xor(ls, 16); ls += __shfl_xor(ls, 32);
        f32x4 o[4];
#pragma unroll
        for (int n = 0; n < 4; ++n) o[n] = (f32x4){0.f, 0.f, 0.f, 0.f};
#pragma unroll
        for (int s5 = 0; s5 < 5; ++s5) { bf16x8 pa;
            { const unsigned w0 = pk2(st[2 * s5][0], st[2 * s5][1]), w1 = pk2(st[2 * s5][2], st[2 * s5][3]);
              const unsigned w2 = pk2(st[2 * s5 + 1][0], st[2 * s5 + 1][1]), w3 = pk2(st[2 * s5 + 1][2], st[2 * s5 + 1][3]);
              const u32x4 pw = {w0, w1, w2, w3}; pa = __builtin_bit_cast(bf16x8, pw); }
#pragma unroll
            for (int n = 0; n < 4; ++n) { const bf16x8 vb = *(const LAS bf16x8*)(VT + (16 * n + x) * LDV + 32 * ((tstart >> 1) + s5) + 8 * q); o[n] = __builtin_amdgcn_mfma_f32_16x16x32_bf16(vb, pa, o[n], 0, 0, 0); } }
        { const float inv = 1.0f / ls; const size_t tq = (size_t)b * NS + rho + (size_t)dil * (i0 + r0 + x);
#pragma unroll
          for (int n = 0; n < 4; ++n) *(GAS unsigned long long*)(MIX + tq * MIXW + 768 + hd * 64 + 16 * n + 4 * q) = (unsigned long long)pk2(o[n][0] * inv, o[n][1] * inv) | ((unsigned long long)pk2(o[n][2] * inv, o[n][3] * inv) << 32); }
        if (q == 0) { const size_t tq = (size_t)b * NS + rho + (size_t)dil * (i0 + r0 + x); ML[tq * 12 + hd * 2] = mx * 0.6931471805599453f; ML[tq * 12 + hd * 2 + 1] = ls; }
        __syncthreads();
        su = sun; par ^= 1;
    }
}
}

namespace scan {
typedef short bf16x8 __attribute__((ext_vector_type(8)));
typedef float f32x4 __attribute__((ext_vector_type(4)));
typedef unsigned u32x4 __attribute__((ext_vector_type(4)));
typedef GAS bf16_t gbf;
typedef GAS float gfl; typedef GAS u32x4 gu32x4; typedef GAS unsigned long long gu64; typedef GAS bf16x8 gbf16x8;
constexpr int NCHT = NS / 64, SPLIT_A = NCHT / 2, SPLIT_C = NCHT / 2, PSLOT = NCHT / 2;
constexpr int LDH = 72, LDF = 68, MAT = 64 * LDH;

__device__ __forceinline__ f32x4 mm_tile(const LAS bf16_t* A, const LAS bf16_t* Bt, int tm, int tn, int lane, f32x4 acc) {
    const int r = lane & 15, q = lane >> 4;
#pragma unroll
    for (int ks = 0; ks < 2; ++ks) {
        const bf16x8 a = *(const LAS bf16x8*)(A + (tm * 16 + r) * LDH + ks * 32 + q * 8);
        const bf16x8 b = *(const LAS bf16x8*)(Bt + (tn * 16 + r) * LDH + ks * 32 + q * 8);
        acc = __builtin_amdgcn_mfma_f32_16x16x32_bf16(a, b, acc, 0, 0, 0);
    }
    __builtin_amdgcn_sched_barrier(0);
    return acc;
}
__device__ __forceinline__ float bfl(unsigned w) { return __uint_as_float(w << 16); }
__device__ __forceinline__ float bfh(unsigned w) { return __uint_as_float(w & 0xffff0000u); }
__device__ __forceinline__ unsigned pk(float lo, float hi) { return pk2(lo, hi); }
__device__ __forceinline__ float ldsbf(const LAS bf16_t* p) { return __uint_as_float(((unsigned)*p) << 16); }
__device__ __forceinline__ void st4bf(LAS bf16_t* p, f32x4 v) { *(LAS unsigned long long*)p = (unsigned long long)pk(v[0], v[1]) | ((unsigned long long)pk(v[2], v[3]) << 32); }
__device__ __forceinline__ f32x4 ld4bf(const LAS bf16_t* p) { const unsigned long long w = *(const LAS unsigned long long*)p; const unsigned lo = (unsigned)w, hi = (unsigned)(w >> 32); return (f32x4){bfl(lo), bfh(lo), bfl(hi), bfh(hi)}; }
struct Frag { bf16x8 f[2]; };
__device__ __forceinline__ Frag ldfrag(const LAS bf16_t* M, int tile, int lane) { Frag r; const LAS bf16_t* p = M + (tile * 16 + (lane & 15)) * LDH + (lane >> 4) * 8;
    r.f[0] = *(const LAS bf16x8*)p; r.f[1] = *(const LAS bf16x8*)(p + 32); return r; }
__device__ __forceinline__ f32x4 fmm(const Frag& x, const Frag& y, f32x4 acc) { acc = __builtin_amdgcn_mfma_f32_16x16x32_bf16(x.f[0], y.f[0], acc, 0, 0, 0); return __builtin_amdgcn_mfma_f32_16x16x32_bf16(x.f[1], y.f[1], acc, 0, 0, 0); }
__device__ __forceinline__ f32x4 mm_flip(const LAS bf16_t* Y, const LAS bf16_t* X, int tr, int tc, int lane, f32x4 acc) { return mm_tile(X, Y, tc, tr, lane, acc); }

constexpr int LDD = 20, LDT = 32;
__device__ __forceinline__ void diag_inverse(const LAS float* Ld, LAS bf16_t* Tb, int lane) {
    const int c = lane & 31; float x[16]; unsigned dep = 0u;
#pragma unroll
    for (int i = 0; i < 16; ++i) {
        const LAS float* Lr = (const LAS float*)((const LAS char*)Ld + dep) + i * LDD;
        float a = c == i ? 1.0f : 0.f;
#pragma unroll
        for (int j4 = 0; j4 * 4 < i; ++j4) { const f32x4 l4 = *(const LAS f32x4*)(Lr + 4 * j4);
#pragma unroll
            for (int e = 0; e < 4; ++e) if (4 * j4 + e < i) a -= l4[e] * x[4 * j4 + e]; }
        x[i] = a;
        asm volatile("" : "+v"(dep) : "v"(a));
    }
    if (lane < 32) {
#pragma unroll
        for (int i = 0; i < 16; ++i) Tb[i * LDT + c] = c < 16 ? f2bf_hw(x[i]) : (bf16_t)0;
    }
}
template <class RhsF> __device__ __forceinline__ void solve_blocked(const LAS bf16_t* Lb, const LAS bf16_t* Tb, LAS bf16_t* XT, LAS bf16_t* RTw, RhsF rhs, int wave, int lane) {
    const int x = lane & 15, q = lane >> 4; LAS bf16_t* xrow = XT + (wave * 16 + x) * LDH;
#pragma unroll
    for (int a = 0; a < 4; ++a) *(LAS unsigned long long*)(xrow + 16 * a + 4 * q) = 0ull;
    *(LAS unsigned long long*)(RTw + x * LDT + 16 + 4 * q) = 0ull;
#pragma unroll
    for (int b = 0; b < 4; ++b) {
        f32x4 acc = {0.f, 0.f, 0.f, 0.f};
        if (b > 0) acc = mm_flip(XT, Lb, wave, b, lane, acc);
        f32x4 r;
#pragma unroll
        for (int i = 0; i < 4; ++i) r[i] = rhs(16 * b + 4 * q + i, wave * 16 + x) - acc[i];
        st4bf(RTw + x * LDT + 4 * q, r);
        const bf16x8 ta = *(const LAS bf16x8*)(Tb + b * 16 * LDT + x * LDT + q * 8), rb = *(const LAS bf16x8*)(RTw + x * LDT + q * 8);
        const f32x4 z4 = {0.f, 0.f, 0.f, 0.f};
        const f32x4 xo = __builtin_amdgcn_mfma_f32_16x16x32_bf16(ta, rb, z4, 0, 0, 0);
        st4bf(xrow + 16 * b + 4 * q, xo);
    }
}

template <class StoreF> __device__ __forceinline__ void seq_step(const LAS bf16_t* Qh, const LAS bf16_t* Gms, const LAS bf16_t* ZT, LAS bf16_t* ZTn, f32x4 (&loc)[2], f32x4 (&hmt)[2], int wave, int lane, StoreF st) {
    const int tc = wave & 3; const Frag xz = ldfrag(ZT, tc, lane), xg = ldfrag(Gms, tc, lane);
#pragma unroll
    for (int u = 0; u < 2; ++u) { const int tr = (wave >> 2) + 2 * u; const int rr = tr * 16 + (lane & 15), c0 = tc * 16 + 4 * (lane >> 4);
        const f32x4 o = fmm(xz, ldfrag(Qh, tr, lane), loc[u]);
        const f32x4 zn = fmm(xg, ldfrag(ZT, tr, lane), hmt[u]);
        st4bf(ZTn + rr * LDH + c0, zn); st(rr, c0, o); }
}

__device__ __forceinline__ void phi_step(const LAS bf16_t* Qh, const LAS bf16_t* Gms, LAS bf16_t* PhiT, gbf* psi, long rstride, int wave, int lane) {
    const int tc = wave & 3; const Frag xp = ldfrag(PhiT, tc, lane), xg = ldfrag(Gms, tc, lane); const f32x4 z4 = {0.f, 0.f, 0.f, 0.f};
    f32x4 pn[2];
#pragma unroll
    for (int u = 0; u < 2; ++u) { const int tr = (wave >> 2) + 2 * u; const int rr = tr * 16 + (lane & 15), c0 = tc * 16 + 4 * (lane >> 4);
        const f32x4 ps = fmm(xp, ldfrag(Qh, tr, lane), z4);
        pn[u] = fmm(xg, ldfrag(PhiT, tr, lane), z4);
        *(gu64*)(psi + (long)rr * rstride + c0) = (unsigned long long)pk(ps[0], ps[1]) | ((unsigned long long)pk(ps[2], ps[3]) << 32); }
    __syncthreads();
#pragma unroll
    for (int u = 0; u < 2; ++u) { const int tr = (wave >> 2) + 2 * u; st4bf(PhiT + (tr * 16 + (lane & 15)) * LDH + tc * 16 + 4 * (lane >> 4), pn[u]); }
}
__device__ __forceinline__ void scan_correct(PRef P, Ctx& C) {
    const int tid = fresh_tid(), lane = tid & 63, wave = C.wave; constexpr int NA = NCHT - SPLIT_A, NC = NCHT - SPLIT_C;
    const gbf* PSI = (const gbf*)uni(P.LT); const gbf* ZM = (const gbf*)uni(P.ZMID); const gbf* AP = (const gbf*)uni(P.AP); gbf* YAb = (gbf*)uni(P.YA); gbf* OCb = (gbf*)uni(P.OC);
    for (int it = (int)blockIdx.x; it < 64 * (NA + NC); it += C.G) { const int mix = it >= 64 * NA, r = mix ? it - 64 * NA : it, nch = mix ? NC : NA, sq = r / nch, cc = r % nch, c0 = mix ? SPLIT_C : SPLIT_A; const int d = sq >> 5, b = sq >> 2 & 7, h = sq & 3;
        const gbf* zm = ZM + ((size_t)mix * 64 + sq) * 4096; gbf* OUT = (mix ? OCb : YAb) + (size_t)d * MROWS * 256 + h * 64;
        const int tc = wave & 3; Frag xz; { const gbf* p = zm + (tc * 16 + (lane & 15)) * 64 + (lane >> 4) * 8; xz.f[0] = *(const gbf16x8*)p; xz.f[1] = *(const gbf16x8*)(p + 32); }
#pragma unroll
        for (int u = 0; u < 2; ++u) { const int tr = (wave >> 2) + 2 * u, t = tr * 16 + (lane & 15); const int s_ = (c0 + cc) * 64 + t; const long t_ = (long)b * NS + (d == 0 ? s_ : NS - 1 - s_);
            const gbf* p = (mix ? AP + t_ * 1792 + (d * 4 + h) * 64 : PSI + ((size_t)sq * PSLOT + cc) * 4096 + t * 64) + (lane >> 4) * 8;
            Frag yp; yp.f[0] = *(const gbf16x8*)p; yp.f[1] = *(const gbf16x8*)(p + 32);
            const f32x4 z4 = {0.f, 0.f, 0.f, 0.f}; const f32x4 a = fmm(xz, yp, z4);
            gu64* o8 = (gu64*)(OUT + t_ * 256 + tc * 16 + 4 * (lane >> 4)); const unsigned long long w = *o8; const unsigned lo = (unsigned)w, hi = (unsigned)(w >> 32);
            *o8 = (unsigned long long)pk(bfl(lo) + a[0], bfh(lo) + a[1]) | ((unsigned long long)pk(bfl(hi) + a[2], bfh(hi) + a[3]) << 32); }
    }
}

__device__ __forceinline__ void scanC(PRef P, int l, int sq, int half, Ctx& C) {
    const int tid = fresh_tid(), lane0 = tid & 63, wave = C.wave;
    const int d = sq >> 5, b = (sq >> 2) & 7, h = sq & 3;
    LAS bf16_t* Qs = (LAS bf16_t*)C.lds; LAS bf16_t* Ks = Qs + MAT; LAS bf16_t* Vs = Ks + MAT; LAS bf16_t* KgT = Vs + MAT; LAS bf16_t* Aqs = KgT + MAT;
    LAS bf16_t* XT = Aqs + MAT; LAS bf16_t* Qh = XT + 2 * MAT; LAS bf16_t* Gms = Qh + MAT; LAS bf16_t* ZT = Gms + MAT;
    LAS bf16_t* Lb = ZT + 2 * MAT; LAS bf16_t* Tb = Lb + MAT; LAS bf16_t* RT = Tb + 4 * 16 * LDT; LAS float* Ld = (LAS float*)(RT + 8 * 16 * LDT); LAS float* sg = Ld + 4 * 16 * LDD; LAS float* sgc = sg + 64; LAS float* sbet = sgc + 64; LAS float* sbeg = sbet + 64; LAS float* segc = sbeg + 64; LAS float* segl = segc + 64; LAS float* cwt = segl + 64; LAS bf16_t* PhiT = (LAS bf16_t*)(cwt + 960);
    for (int i = tid; i < MAT / 2; i += 512) ((LAS unsigned*)(ZT + ((half ? SPLIT_C : 0) & 1) * MAT))[i] = 0u;
    const gbf* PC = (const gbf*)uni(P.PC); const gfl* CBG = (const gfl*)uni(P.CBG);
    { const float* cw = uni(P.conv) + (size_t)l * 5 * 768; for (int i = tid; i < 960; i += 512) { const int ar = i / 320, tp = (i / 64) % 5, ch = i & 63; cwt[i] = cw[tp * 768 + ar * 256 + h * 64 + ch]; } } gbf* OC = (gbf*)uni(P.OC) + (size_t)d * MROWS * 256 + h * 64;
    const int lt = tid >> 3, lp = tid & 7;
    u32x4 raw[3][5]; float rbeta = 0.f, rg = 0.f; int rs = 0;
#define SCANC_LOAD(c) do { const int s_ = (c) * 64 + lt; const int sp_ = d == 0 ? s_ : NS - 1 - s_; const long t_ = (long)b * NS + sp_; rs = sp_; const gbf* p_ = PC + t_ * 1024 + h * 64 + lp * 8; \
        if ((c) != 0 && (c) != NS / 64 - 1) { _Pragma("unroll") for (int tp_ = 0; tp_ < 5; ++tp_) _Pragma("unroll") for (int ar_ = 0; ar_ < 3; ++ar_) raw[ar_][tp_] = *(const gu32x4*)(p_ + (long)(tp_ - 2) * 1024 + ar_ * 256); } \
        else { _Pragma("unroll") for (int tp_ = 0; tp_ < 5; ++tp_) { const int so_ = sp_ + tp_ - 2; const bool ok_ = so_ >= 0 && so_ < NS; _Pragma("unroll") for (int ar_ = 0; ar_ < 3; ++ar_) \
            raw[ar_][tp_] = ok_ ? *(const gu32x4*)(p_ + (long)(tp_ - 2) * 1024 + ar_ * 256) : (u32x4){0u, 0u, 0u, 0u}; } }     \
        if (lp == 0) { rbeta = CBG[t_ * 16 + d * 4 + h]; rg = CBG[t_ * 16 + 8 + d * 4 + h]; } } while (0)
    const int cbeg = half ? SPLIT_C : 0, cend = half ? NCHT : SPLIT_C;
    if (half) for (int i = tid; i < 64 * 64; i += 512) PhiT[(i >> 6) * LDH + (i & 63)] = (i >> 6) == (i & 63) ? (bf16_t)0x3F80 : (bf16_t)0;
    gbf* APp = (gbf*)uni(P.AP) + (d * 4 + h) * 64; gbf* ZMID = (gbf*)uni(P.ZMID) + ((size_t)64 + sq) * 4096;
    SCANC_LOAD(cbeg);
    __syncthreads();
    for (int c = cbeg; c < cend; ++c) {
        int lane = lane0; asm volatile("" : "+v"(lane));
        u32x4 rq, rk, rv;
        { float a[3][8];
#pragma unroll
          for (int ar = 0; ar < 3; ++ar) {
#pragma unroll
            for (int j = 0; j < 8; ++j) a[ar][j] = 0.f;
#pragma unroll
            for (int tp = 0; tp < 5; ++tp) { const unsigned w[4] = {raw[ar][tp].x, raw[ar][tp].y, raw[ar][tp].z, raw[ar][tp].w}; const LAS float* cwp = cwt + (ar * 5 + tp) * 64 + lp * 8;
              const f32x4 c0 = *(const LAS f32x4*)cwp, c1 = *(const LAS f32x4*)(cwp + 4);
#pragma unroll
              for (int j = 0; j < 4; ++j) { a[ar][2 * j] += bfl(w[j]) * (j < 2 ? c0[2 * j] : c1[2 * j - 4]); a[ar][2 * j + 1] += bfh(w[j]) * (j < 2 ? c0[2 * j + 1] : c1[2 * j - 3]); } }
            float ss = 0.f;
#pragma unroll
            for (int j = 0; j < 8; ++j) { const float x = a[ar][j]; const float sv = x * __builtin_amdgcn_rcpf(1.0f + __expf(-x)); a[ar][j] = sv; ss += sv * sv; }
            ss += __shfl_xor(ss, 1); ss += __shfl_xor(ss, 2); ss += __shfl_xor(ss, 4);
            const float scl = ar == 2 ? 1.0f : (ar == 0 ? 0.125f : 1.0f) / sqrtf(ss + 1e-12f);
#pragma unroll
            for (int j = 0; j < 8; ++j) a[ar][j] *= scl; }
          rq = (u32x4){pk(a[0][0], a[0][1]), pk(a[0][2], a[0][3]), pk(a[0][4], a[0][5]), pk(a[0][6], a[0][7])};
          rk = (u32x4){pk(a[1][0], a[1][1]), pk(a[1][2], a[1][3]), pk(a[1][4], a[1][5]), pk(a[1][6], a[1][7])};
          rv = (u32x4){pk(a[2][0], a[2][1]), pk(a[2][2], a[2][3]), pk(a[2][4], a[2][5]), pk(a[2][6], a[2][7])}; }
        *(LAS u32x4*)(Qs + lt * LDH + lp * 8) = rq; *(LAS u32x4*)(Ks + lt * LDH + lp * 8) = rk; *(LAS u32x4*)(Vs + lt * LDH + lp * 8) = rv;
        if (lp == 0) { sg[lt] = rg; sbet[lt] = rbeta; }
        const u32x4 kraw = rk;
        __syncthreads();
        if (c + 1 < cend) SCANC_LOAD(c + 1);
        if (wave == 0) {
            float g = sg[lane];
#pragma unroll
            for (int o = 1; o < 64; o <<= 1) { const float t = __shfl_up(g, o); if (lane >= o) g += t; }
            const float gl = __shfl(g, 63);
            sgc[lane] = g; const float eg = __expf(g); segc[lane] = eg; sbeg[lane] = sbet[lane] * eg; segl[lane] = __expf(gl - g);
        }
        __syncthreads();
        { const float sc = segl[lt]; const unsigned kw[4] = {kraw.x, kraw.y, kraw.z, kraw.w};
#pragma unroll
          for (int j = 0; j < 4; ++j) { KgT[(lp * 8 + 2 * j) * LDH + lt] = f2bf_hw(bfl(kw[j]) * sc); KgT[(lp * 8 + 2 * j + 1) * LDH + lt] = f2bf_hw(bfh(kw[j]) * sc); } }
        const int x = lane & 15, q4 = 4 * (lane >> 4); f32x4 ms, mi;
#pragma unroll
        for (int i = 0; i < 4; ++i) { ms[i] = q4 + i < x ? 1.0f : 0.f; mi[i] = q4 + i <= x ? 1.0f : 0.f; }
        auto gram = [&](const LAS bf16_t* rowsM, const Frag& xk, int tc, int tr, bool isq) __attribute__((always_inline)) {
            const int ri = tr * 16 + x; const f32x4 gj = *(const LAS f32x4*)(sgc + tc * 16 + q4); f32x4 v = {0.f, 0.f, 0.f, 0.f};
            if (tc <= tr) { v = fmm(xk, ldfrag(rowsM, tr, lane), v); const float gi = sgc[ri], sc = isq ? 1.0f : sbet[ri];
#pragma unroll
              for (int i = 0; i < 4; ++i) v[i] *= __expf(fminf(gi - gj[i], 0.f)) * sc;
              if (tc == tr) { v *= isq ? mi : ms; if (!isq) *(LAS f32x4*)(Ld + ri * LDD + q4) = v; } }
            st4bf((isq ? Aqs : Lb) + ri * LDH + tc * 16 + q4, v); };
        { const int tc = wave & 3; const Frag xk = ldfrag(Ks, tc, lane);
#pragma unroll
          for (int u = 0; u < 2; ++u) gram(Ks, xk, tc, 2 * u + (wave >> 2), false); }
        __syncthreads();
        if (wave < 4) diag_inverse(Ld + wave * 16 * LDD, Tb + wave * 16 * LDT, lane);
        else { const int tc = wave & 3; const Frag xk = ldfrag(Ks, tc, lane);
#pragma unroll
          for (int tr = 0; tr < 4; ++tr) gram(Qs, xk, tc, tr, true); }
        __syncthreads();
        { const LAS bf16_t* src = wave < 4 ? Vs : Ks; const LAS float* scl = wave < 4 ? sbet : sbeg;
          solve_blocked(Lb, Tb, XT, RT + wave * 16 * LDT, [&](int j, int col) { return ldsbf(src + j * LDH + (col & 63)) * scl[j]; }, wave, lane); }
        __syncthreads();
        f32x4 loc[2], hmt[2];
        { const float egl_all = segc[63]; const int tc = wave & 3; const f32x4 z4 = {0.f, 0.f, 0.f, 0.f};
          const Frag xw = ldfrag(XT + 64 * LDH, tc, lane), xu = ldfrag(XT, tc, lane), xkg = ldfrag(KgT, tc, lane);
#pragma unroll
          for (int u = 0; u < 2; ++u) { const int tr = (wave >> 2) + 2 * u; const int rr = tr * 16 + (lane & 15), c0 = tc * 16 + 4 * (lane >> 4);
            const Frag ya = ldfrag(Aqs, tr, lane), ykg = ldfrag(KgT, tr, lane), yu = ldfrag(XT, tr, lane);
            const f32x4 aw = fmm(xw, ya, z4);
            loc[u] = fmm(xu, ya, z4);
            const f32x4 gw = fmm(xw, ykg, z4);
            hmt[u] = fmm(xkg, yu, z4);
            const f32x4 q4 = ld4bf(Qs + rr * LDH + c0); const float eg = segc[rr]; f32x4 qh, gm;
#pragma unroll
            for (int i = 0; i < 4; ++i) { qh[i] = q4[i] * eg - aw[i]; gm[i] = (rr == c0 + i ? egl_all : 0.f) - gw[i]; }
            st4bf(Qh + rr * LDH + c0, qh); st4bf(Gms + rr * LDH + c0, gm); } }
        __syncthreads();
        { const int cbase = c * 64;
          seq_step(Qh, Gms, ZT + (c & 1) * MAT, ZT + ((c & 1) ^ 1) * MAT, loc, hmt, wave, lane, [&](int t, int v0, f32x4 o) { const int s_ = cbase + t; const long t_ = (long)b * NS + (d == 0 ? s_ : NS - 1 - s_);
              *(gu64*)(OC + t_ * 256 + v0) = (unsigned long long)pk(o[0], o[1]) | ((unsigned long long)pk(o[2], o[3]) << 32); });
          if (half) { const long t0_ = (long)b * NS + (d == 0 ? cbase : NS - 1 - cbase); phi_step(Qh, Gms, PhiT, APp + t0_ * 1792, d == 0 ? 1792 : -1792, wave, lane); } }
    }
    __syncthreads();
    if (!half) { const LAS bf16_t* zf = ZT + (cend & 1) * MAT; const int row = tid >> 3, part = tid & 7; *(gu32x4*)(ZMID + row * 64 + part * 8) = *(const LAS u32x4*)(zf + row * LDH + part * 8); }
#undef SCANC_LOAD
}

__device__ __forceinline__ void scanA(PRef P, int l, int sq, int half, Ctx& C) {
    const int tid = fresh_tid(), lane0 = tid & 63, wave = C.wave;
    const int d = sq >> 5, b = (sq >> 2) & 7, h = sq & 3;
    LAS bf16_t* ARs = (LAS bf16_t*)C.lds;
    LAS bf16_t* BKs = ARs + 2 * MAT;
    LAS bf16_t* BhT = BKs + 2 * MAT; LAS bf16_t* KhT = BhT + MAT; LAS bf16_t* VT = KhT + MAT;
    LAS bf16_t* Mak = VT + MAT;
    LAS bf16_t* Mrb = Mak + MAT;
    LAS bf16_t* Mrk = Mrb + MAT; LAS bf16_t* ZT = Mrk + MAT;
    LAS float* cs = (LAS float*)(ZT + 2 * MAT);
    LAS bf16_t* Lb = (LAS bf16_t*)cs; LAS float* Ld = (LAS float*)(Lb + MAT);
    LAS bf16_t* RH = (LAS bf16_t*)(cs + 64 * LDF);
    LAS float* sct = (LAS float*)(RH + MAT);
    LAS float* segs = sct + 128;
    LAS float* mut = segs + 512;
    LAS bf16_t* Tb = (LAS bf16_t*)(mut + 384);
    LAS bf16_t* XT = BKs; LAS bf16_t* Qh = Mak; LAS bf16_t* RT = Mak; LAS bf16_t* Gms = RH;
    LAS bf16_t* PhiT = Tb + 4 * 16 * LDT;
    for (int i = tid; i < MAT / 2; i += 512) ((LAS unsigned*)(ZT + ((half ? SPLIT_A : 0) & 1) * MAT))[i] = 0u;
    if (half) for (int i = tid; i < 64 * 64; i += 512) PhiT[(i >> 6) * LDH + (i & 63)] = (i >> 6) == (i & 63) ? (bf16_t)0x3F80 : (bf16_t)0;
    const int cbeg = half ? SPLIT_A : 0, cend = half ? NCHT : SPLIT_A;
    gbf* PSI = (gbf*)uni(P.LT) + (size_t)sq * PSLOT * 4096; gbf* ZMID = (gbf*)uni(P.ZMID) + (size_t)sq * 4096;
    const gbf* PA = (const gbf*)uni(P.PA);
    { const float* mp = uni(P.mu_prev) + l * 1024; const float* mn = uni(P.mu_next) + l * 1024; for (int i = tid; i < 384; i += 512) { const int pn = i / 192, ar = (i / 64) % 3, ch = i & 63; mut[i] = (pn ? mn : mp)[ar * 256 + h * 64 + ch]; } }
    const gbf* AP = (const gbf*)uni(P.AP); gfl* BON = (gfl*)uni(P.RN) + (size_t)d * MROWS * 4 + h; gbf* YA = (gbf*)uni(P.YA) + (size_t)d * MROWS * 256 + h * 64;
    const float* kkp = uni(P.k_k) + l * 256 + h * 64; const float* kap = uni(P.k_a) + l * 256 + h * 64; const float* rkp = uni(P.r_k) + l * 256 + h * 64;
    const int lt = tid >> 3, lp = tid & 7;
    float kkc[8], kac[8], rkc[8];
#pragma unroll
    for (int j = 0; j < 8; ++j) { kkc[j] = kkp[lp * 8 + j]; kac[j] = kap[lp * 8 + j]; rkc[j] = rkp[lp * 8 + j]; }
    u32x4 raw[3][3], re, ra; long rtok = 0; bf16_t re8[8];
#define SCANA_LOAD(c) do { const int s_ = (c) * 64 + lt; const long t_ = (long)b * NS + (d == 0 ? s_ : NS - 1 - s_); const gbf* p_ = AP + t_ * 1792 + h * 64 + lp * 8; \
        { const int sp_ = d == 0 ? s_ : NS - 1 - s_; const gbf* q_ = PA + t_ * 1024 + h * 64 + lp * 8; const bool in_ = (c) != 0 && (c) != NS / 64 - 1; _Pragma("unroll") for (int ar_ = 0; ar_ < 3; ++ar_) { raw[ar_][1] = *(const gu32x4*)(q_ + ar_ * 256); \
            if (in_) { raw[ar_][0] = *(const gu32x4*)(q_ + ar_ * 256 - 1024); raw[ar_][2] = *(const gu32x4*)(q_ + ar_ * 256 + 1024); } \
            else { raw[ar_][0] = sp_ > 0 ? *(const gu32x4*)(q_ + ar_ * 256 - 1024) : (u32x4){0u, 0u, 0u, 0u}; raw[ar_][2] = sp_ < NS - 1 ? *(const gu32x4*)(q_ + ar_ * 256 + 1024) : (u32x4){0u, 0u, 0u, 0u}; } } } \
        re = *(const gu32x4*)(p_ + 768 + d * 256); ra = *(const gu32x4*)(p_ + 1280 + d * 256); rtok = t_; \
        _Pragma("unroll") for (int j_ = 0; j_ < 8; ++j_) { const int s2_ = (c) * 64 + (tid >> 6) * 8 + j_; const long t2_ = (long)b * NS + (d == 0 ? s2_ : NS - 1 - s2_); re8[j_] = AP[t2_ * 1792 + 768 + d * 256 + h * 64 + (tid & 63)]; } } while (0)
    SCANA_LOAD(cbeg);
    __syncthreads();
    for (int c = cbeg; c < cend; ++c) {
        int lane = lane0; asm volatile("" : "+v"(lane));
        u32x4 wr, wk, wv; const u32x4 we = re, wa = ra; const long wtok = rtok;
        { u32x4 o3[3];
#pragma unroll
          for (int ar = 0; ar < 3; ++ar) { const unsigned f[4] = {raw[ar][1].x, raw[ar][1].y, raw[ar][1].z, raw[ar][1].w}, pv[4] = {raw[ar][0].x, raw[ar][0].y, raw[ar][0].z, raw[ar][0].w}, nx[4] = {raw[ar][2].x, raw[ar][2].y, raw[ar][2].z, raw[ar][2].w};
            const LAS float* mpp = mut + ar * 64 + lp * 8; const LAS float* mnp = mut + 192 + ar * 64 + lp * 8; float o[8];
#pragma unroll
            for (int j = 0; j < 4; ++j) { const float f0 = bfl(f[j]), f1 = bfh(f[j]);
              o[2 * j] = f0 + mpp[2 * j] * (bfl(pv[j]) - f0) + mnp[2 * j] * (bfl(nx[j]) - f0); o[2 * j + 1] = f1 + mpp[2 * j + 1] * (bfh(pv[j]) - f1) + mnp[2 * j + 1] * (bfh(nx[j]) - f1); }
            o3[ar] = (u32x4){pk(o[0], o[1]), pk(o[2], o[3]), pk(o[4], o[5]), pk(o[6], o[7])}; }
          wr = o3[0]; wk = o3[1]; wv = o3[2]; }
        { const int kch = tid & 63, seg = tid >> 6; float run[8]; float acc = 0.f;
#pragma unroll
          for (int j = 0; j < 8; ++j) { acc -= __uint_as_float(((unsigned)re8[j]) << 16); run[j] = acc; }
          segs[seg * 64 + kch] = acc;
          __syncthreads();
          if (c + 1 < cend) SCANA_LOAD(c + 1);
          float off = 0.f, tot = 0.f;
#pragma unroll
          for (int s2 = 0; s2 < 8; ++s2) { const float sv = segs[s2 * 64 + kch]; tot += sv; off += s2 < seg ? sv : 0.f; }
#pragma unroll
          for (int j = 0; j < 8; ++j) cs[(seg * 8 + j) * LDF + kch] = run[j] + off;
          if (seg == 0) { sct[kch] = __expf(tot); sct[64 + kch] = tot; } }
        __syncthreads();
        for (int rep_ = 0; rep_ < ((KNOB_SDUP & 1) ? 2 : 1); ++rep_) { const unsigned wrr[4] = {wr.x, wr.y, wr.z, wr.w}, wkk[4] = {wk.x, wk.y, wk.z, wk.w}, wvv[4] = {wv.x, wv.y, wv.z, wv.w}, wee[4] = {we.x, we.y, we.z, we.w}, waa[4] = {wa.x, wa.y, wa.z, wa.w};
          float at[8], rt[8], bt[8], kt[8];
          float ssq = 0.f, bon = 0.f;
#pragma unroll
          for (int j = 0; j < 8; ++j) { const float k_ = (j & 1) ? bfh(wkk[j >> 1]) : bfl(wkk[j >> 1]), r_ = (j & 1) ? bfh(wrr[j >> 1]) : bfl(wrr[j >> 1]), al = (j & 1) ? bfh(waa[j >> 1]) : bfl(waa[j >> 1]);
            const float kx_ = k_ * kkc[j]; ssq += kx_ * kx_; bon += r_ * (k_ * (1.0f + (al - 1.0f) * kac[j])) * rkc[j]; }
          ssq += __shfl_xor(ssq, 1); ssq += __shfl_xor(ssq, 2); ssq += __shfl_xor(ssq, 4); bon += __shfl_xor(bon, 1); bon += __shfl_xor(bon, 2); bon += __shfl_xor(bon, 4);
          const float rn = 1.0f / sqrtf(ssq + 1e-12f);
          if (lp == 0) BON[wtok * 4] = 0.5f * bon;
#pragma unroll
          for (int j = 0; j < 8; ++j) { const int ch = lp * 8 + j; const unsigned sh = (j & 1) ? 0u : 16u;
            const float r_ = (j & 1) ? bfh(wrr[j >> 1]) : bfl(wrr[j >> 1]), k_ = (j & 1) ? bfh(wkk[j >> 1]) : bfl(wkk[j >> 1]), v_ = (j & 1) ? bfh(wvv[j >> 1]) : bfl(wvv[j >> 1]);
            const float e_ = (j & 1) ? bfh(wee[j >> 1]) : bfl(wee[j >> 1]), al = (j & 1) ? bfh(waa[j >> 1]) : bfl(waa[j >> 1]); (void)sh;
            const float tot = sct[64 + ch], csv = cs[lt * LDF + ch];
            const float ecs = __expf(csv), eics = __builtin_amdgcn_rcpf(ecs), ecx = __expf(csv + e_), ect = sct[ch] * eics; (void)tot;
            const float kk = k_ * kkc[j] * rn, kx = k_ * (1.0f + (al - 1.0f) * kac[j]), bb = kk * al;
            at[j] = -kk * ecx; rt[j] = r_ * ecs; bt[j] = bb * eics; kt[j] = kx * eics;
            BhT[ch * LDH + lt] = f2bf_hw(bb * ect); KhT[ch * LDH + lt] = f2bf_hw(kx * ect); VT[ch * LDH + lt] = f2bf_hw(v_);
            }
          u32x4 w; w.x = pk(at[0], at[1]); w.y = pk(at[2], at[3]); w.z = pk(at[4], at[5]); w.w = pk(at[6], at[7]); *(LAS u32x4*)(ARs + lt * LDH + lp * 8) = w;
          w.x = pk(rt[0], rt[1]); w.y = pk(rt[2], rt[3]); w.z = pk(rt[4], rt[5]); w.w = pk(rt[6], rt[7]); *(LAS u32x4*)(ARs + (64 + lt) * LDH + lp * 8) = w;
          w.x = pk(bt[0], bt[1]); w.y = pk(bt[2], bt[3]); w.z = pk(bt[4], bt[5]); w.w = pk(bt[6], bt[7]); *(LAS u32x4*)(BKs + lt * LDH + lp * 8) = w;
          w.x = pk(kt[0], kt[1]); w.y = pk(kt[2], kt[3]); w.z = pk(kt[4], kt[5]); w.w = pk(kt[6], kt[7]); *(LAS u32x4*)(BKs + (64 + lt) * LDH + lp * 8) = w; }
        __syncthreads();
        { const int tc8 = wave, tc = tc8 & 3; const bool hi = tc8 >= 4; const Frag xb = ldfrag(BKs, tc8, lane);
          const int x = lane & 15, q4 = 4 * (lane >> 4); const float sg = hi ? 1.0f : -1.0f;
          f32x4 ms, mi;
#pragma unroll
          for (int i = 0; i < 4; ++i) { ms[i] = q4 + i < x ? sg : 0.f; mi[i] = q4 + i <= x ? 1.0f : 0.f; }
          LAS bf16_t* d0 = (hi ? Mak : Lb) + x * LDH + tc * 16 + q4;
          LAS bf16_t* d1 = (hi ? Mrk : Mrb) + x * LDH + tc * 16 + q4;
#pragma unroll
          for (int u = 0; u < 8; ++u) { const int tr = u & 3; const bool rows = u >= 4;
            f32x4 v = {0.f, 0.f, 0.f, 0.f};
            if (tc <= tr) { v = fmm(xb, ldfrag(ARs, u, lane), v);
              if (tc == tr) { v *= rows ? mi : ms; if (!rows && !hi) *(LAS f32x4*)(Ld + (tr * 16 + x) * LDD + q4) = v; }
              else if (!rows) v *= sg; }
            st4bf((rows ? d1 : d0) + tr * 16 * LDH, v);
          } }
        __syncthreads();
        if (wave >= 4) { const int tc = wave & 3; const Frag xv = ldfrag(VT, tc, lane); const f32x4 z4 = {0.f, 0.f, 0.f, 0.f};
#pragma unroll
          for (int tr = 0; tr < 4; ++tr) { const f32x4 acc = fmm(xv, ldfrag(Mak, tr, lane), z4); st4bf(RH + (tr * 16 + (lane & 15)) * LDH + tc * 16 + 4 * (lane >> 4), acc); } }
        else diag_inverse(Ld + wave * 16 * LDD, Tb + wave * 16 * LDT, lane);
        __syncthreads();
        for (int rep_ = 0; rep_ < ((KNOB_SDUP & 4) ? 2 : 1); ++rep_) {
          if (wave < 4) solve_blocked(Lb, Tb, XT, RT + wave * 16 * LDT, [&](int j, int col) { return ldsbf(RH + j * LDH + (col & 63)); }, wave, lane);
          else solve_blocked(Lb, Tb, XT, RT + wave * 16 * LDT, [&](int j, int col) { return ldsbf(ARs + j * LDH + (col & 63)); }, wave, lane); }
        __syncthreads();
        f32x4 loc[2], hmt[2];
        { const int tc = wave & 3; const f32x4 z4 = {0.f, 0.f, 0.f, 0.f};
          const Frag xw = ldfrag(XT + 64 * LDH, tc, lane), xu = ldfrag(XT, tc, lane), xv = ldfrag(VT, tc, lane), xbh = ldfrag(BhT, tc, lane), xkh = ldfrag(KhT, tc, lane);
#pragma unroll
          for (int u = 0; u < 2; ++u) { const int tr = (wave >> 2) + 2 * u; const int rr = tr * 16 + (lane & 15), c0 = tc * 16 + 4 * (lane >> 4);
            const Frag yrb = ldfrag(Mrb, tr, lane), yrk = ldfrag(Mrk, tr, lane), ybh = ldfrag(BhT, tr, lane), yu = ldfrag(XT, tr, lane), yv = ldfrag(VT, tr, lane);
            const f32x4 qw = fmm(xw, yrb, z4);
            loc[u] = fmm(xv, yrk, fmm(xu, yrb, z4));
            const f32x4 gw = fmm(xw, ybh, z4);
            hmt[u] = fmm(xkh, yv, fmm(xbh, yu, z4));
            const f32x4 r4 = ld4bf(ARs + (64 + rr) * LDH + c0); f32x4 qh, gm;
#pragma unroll
            for (int i = 0; i < 4; ++i) { qh[i] = r4[i] + qw[i]; gm[i] = (rr == c0 + i ? sct[rr] : 0.f) + gw[i]; }
            st4bf(Qh + rr * LDH + c0, qh); st4bf(Gms + rr * LDH + c0, gm); } }
        __syncthreads();
        { const int cbase = c * 64;
          seq_step(Qh, Gms, ZT + (c & 1) * MAT, ZT + ((c & 1) ^ 1) * MAT, loc, hmt, wave, lane, [&](int t, int v0, f32x4 o) { const int s_ = cbase + t; const long t_ = (long)b * NS + (d == 0 ? s_ : NS - 1 - s_);
              *(gu64*)(YA + t_ * 256 + v0) = (unsigned long long)pk(o[0], o[1]) | ((unsigned long long)pk(o[2], o[3]) << 32); });
          if (half) phi_step(Qh, Gms, PhiT, PSI + (size_t)(c - cbeg) * 4096, 64, wave, lane); }
    }
    __syncthreads();
    if (!half) { const LAS bf16_t* zf = ZT + (cend & 1) * MAT; const int row = tid >> 3, part = tid & 7;
        *(gu32x4*)(ZMID + row * 64 + part * 8) = *(const LAS u32x4*)(zf + row * LDH + part * 8); }
#undef SCANA_LOAD
}
}

#define CW_TICKET 8192
__device__ __forceinline__ void ph_mixers(PRef P, int l, Ctx& C) {
    const int bx = (int)blockIdx.x;
    if (bx < 128) { scan::scanA(P, l, bx >> 1, bx & 1, C); if (KNOB_DUP & 65536) { __syncthreads(); scan::scanA(P, l, bx >> 1, bx & 1, C); } }
    else { scan::scanC(P, l, (bx - 128) >> 1, bx & 1, C); if (KNOB_DUP & 32768) { __syncthreads(); scan::scanC(P, l, (bx - 128) >> 1, bx & 1, C); } }
    __syncthreads();
    unsigned* ctr = uni(P.CTL) + CW_TICKET + l * 128; volatile LAS int* tk = (volatile LAS int*)(C.lds + MISC_OFF) + 16;
    ph_attnB_mfma(P, C, ctr, tk);
    __syncthreads();
    dwin::attnD_mfma(P, C, ctr + 64, tk);
}
#endif
#ifdef CPU_EMU
#define FRESH_GID() const long gid = C.gid, gs = C.gs
#else
#define FRESH_GID() int tid_ = threadIdx.x; OPAQUE(tid_); const long gid = (long)blockIdx.x * 512 + tid_, gs = (long)gridDim.x * 512
#endif
#if defined(CPU_EMU) || KNOB_SCAN == 0
#define SCANS(l) do { ph_scanA(P, l, gid, gs); ph_scanC(P, l, (gid + gs / 2) % gs, gs); } while (0)
#elif KNOB_SCAN == 1
#define SCANS(l) do { ph_scan_chunked(P, l, C); ph_scanA(P, l, (gid + gs / 2) % gs, gs); } while (0)
#elif KNOB_SCAN == 2
#define SCANS(l) do { ph_scan_chunked(P, l, C); ph_scanC(P, l, (gid + gs / 2) % gs, gs); } while (0)
#else
#define SCANS(l) ph_scan_chunked(P, l, C)
#endif
#ifdef CPU_EMU
#define CONVERT_SMALL(l) do {} while (0)
#define CONVERT_MOE(l) do {} while (0)
#define GEMM_IN(l) ph_gemm_in(P, l, gid, gs)
#define GEMM_OUT(l, xs) ph_gemm_out(P, l, xs, gid, gs)
#define GEMM_GU(l) ph_gemm_gu(P, l, gid, gs)
#define GEMM_DOWN(l) ph_gemm_down(P, l, gid, gs)
#else
#if KNOB_CONVERT
#define CONVERT_SMALL(l) convert_small(P, l, C)
#define CONVERT_MOE(l) convert_moe(P, l, C)
#else
#define CONVERT_SMALL(l) do {} while (0)
#define CONVERT_MOE(l) do {} while (0)
#endif
#if KNOB_MFMA & 1
#define GEMM_IN(l) gemm_in_mfma(P, C)
#else
#define GEMM_IN(l) ph_gemm_in(P, l, gid, gs)
#endif
#if KNOB_MFMA & 2
#define GEMM_OUT(l, xs) ph_gemm_out(P, l, xs, gid, gs)
#else
#define GEMM_OUT(l, xs) ph_gemm_out(P, l, xs, gid, gs)
#endif
#if KNOB_MFMA & 4
#define GEMM_GU(l) gemm_gu_mfma(P, C)
#else
#define GEMM_GU(l) ph_gemm_gu(P, l, gid, gs)
#endif
#if KNOB_MFMA & 8
#define GEMM_DOWN(l) gemm_down_mfma(P, C)
#else
#define GEMM_DOWN(l) ph_gemm_down(P, l, gid, gs)
#endif
#endif
DEVFN void layer_fwd(PRef P, Ctx& C, const int l) {
    {
        #define XSRC (l == 0 ? P.x : P.out)
#ifdef CPU_EMU
        { FRESH_GID(); ph_rowrs(XSRC, P.RS, gid, gs); GRID_SYNC(); }
        { FRESH_GID(); ph_norm_bf16(XSRC, P.RS, P.norm_mix_g + l * DM, P.XN, gid, gs); GRID_SYNC(); }
#else
        if (l == 0) { ph_norm_rows_w(P.x, P.norm_mix_g, P.XN, C); CONVERT_SMALL(0); GRID_SYNC(); }
#endif
        { FRESH_GID(); GEMM_IN(l); if (KNOB_DUP & 256) { GRID_SYNC(); GEMM_IN(l); } GRID_SYNC(); }
#ifdef CPU_EMU
        { FRESH_GID(); ph_prepA_shift(P, l, gid, gs); ph_prepB(P, l, gid, gs); ph_prepC_conv(P, l, gid, gs); ph_prepC_bg(P, l, gid, gs); GRID_SYNC(); }
#else
        { FRESH_GID(); ph_lora_fused(P, l, C); ph_prepB(P, l, gid, gs); ph_prepC_bg(P, l, gid, gs); if (KNOB_DUP & 16) { GRID_SYNC(); ph_lora_fused(P, l, C); ph_prepC_bg(P, l, gid, gs); } GRID_SYNC(); }
#endif
#ifdef CPU_EMU
        { FRESH_GID(); ph_prepA_lora(P, l, gid, gs); GRID_SYNC(); }
#else
#endif
#ifdef CPU_EMU
        { FRESH_GID(); ph_prepA_rn(P, l, gid, gs); GRID_SYNC(); }
#endif
#ifdef CPU_EMU
        { FRESH_GID(); SCANS(l); GRID_SYNC(); }
        { FRESH_GID(); ph_attnB(P, gid, gs); ph_attnD(P, gid, gs); GRID_SYNC(); }
#else
        { ph_mixers(P, l, C); GRID_SYNC(); }
        if (KNOB_DUP & 4096) { unsigned* ctr = uni(P.CTL) + CW_TICKET + l * 128; volatile LAS int* tk = (volatile LAS int*)(C.lds + MISC_OFF) + 16; ph_attnB_mfma(P, C, ctr + 32, tk); GRID_SYNC(); }
        if (KNOB_DUP & 8192) { unsigned* ctr = uni(P.CTL) + CW_TICKET + l * 128; volatile LAS int* tk = (volatile LAS int*)(C.lds + MISC_OFF) + 16; dwin::attnD_mfma(P, C, ctr + 96, tk); GRID_SYNC(); }
        { scan::scan_correct(P, C); GRID_SYNC(); }
#endif
#ifdef CPU_EMU
        { FRESH_GID(); ph_fixA(P, l, gid, gs); ph_fixC(P, l, gid, gs); ph_fixD(P, gid, gs); GRID_SYNC(); }
#else
        { FRESH_GID(); ph_fixA_v(P, l, gid, gs); ph_fixC_v(P, l, gid, gs); ph_fixD_v(P, gid, gs); if (KNOB_DUP & 32) { GRID_SYNC(); ph_fixA_v(P, l, gid, gs); ph_fixC_v(P, l, gid, gs); } GRID_SYNC(); }
#endif
#ifdef CPU_EMU
        { FRESH_GID(); GEMM_OUT(l, XSRC); GRID_SYNC(); }
#else
        { if (l == 0) gemm_out_mfma<false>(P, P.x, C); else gemm_out_mfma<true>(P, P.XR, C); __syncthreads(); CONVERT_MOE(l); if (KNOB_DUP & 1024) { __syncthreads(); CONVERT_MOE(l); } GRID_SYNC(); }
#endif
#ifdef CPU_EMU
        { FRESH_GID(); ph_router(P, l, gid, gs); GRID_SYNC(); }
        { FRESH_GID(); ph_norm_bf16(P.out, P.RS, P.norm_ffn_g + l * DM, P.XN, gid, gs); ph_topk(P, gid, gs); GRID_SYNC(); }
#else
        { ph_router_mfma(P, l, C); if (KNOB_DUP & 128) { GRID_SYNC(); ph_router_mfma(P, l, C); } GRID_SYNC(); }
        { ph_topk_lds(P, C); if (KNOB_DUP & 2) { GRID_SYNC(); ph_topk_lds(P, C); } GRID_SYNC(); }
#endif
#ifdef CPU_EMU
        { FRESH_GID(); ph_gather(P, gid, gs); GRID_SYNC(); }
#endif
        { FRESH_GID(); GEMM_GU(l); if (KNOB_DUP & 512) { GRID_SYNC(); GEMM_GU(l); } GRID_SYNC(); }
        { FRESH_GID(); GEMM_DOWN(l); if (KNOB_DUP & 512) { GRID_SYNC(); GEMM_DOWN(l); } GRID_SYNC(); }
#ifdef CPU_EMU
        { FRESH_GID(); ph_combine(P, gid, gs); GRID_SYNC(); }
#else
        { ph_combine_norm_w(P, l, C); if (l == 0) { CONVERT_SMALL(1); GRID_SYNC(); } }
#endif
    }
}
DEVFN void forward(PRef P, Ctx& C) {
    layer_fwd(P, C, 0); layer_fwd(P, C, 1);
#ifdef CPU_EMU
    { FRESH_GID(); ph_rowrs(P.out, P.RS, gid, gs); GRID_SYNC(); }
    { FRESH_GID(); ph_final(P, gid, gs); }
#endif
}
#define WS_CTL_BYTES 65536
#define WS_SMALLW_BYTES ((size_t)(3840 * 1024 + 1024 * 1152 + 1280 * 256 + 128 * 4096) * 2)
#define WS_TOTAL_BYTES (WS_CTL_BYTES + (size_t)WS_ROW_BYTES * MROWS + WS_SMALLW_BYTES)
static void carve(Params& p, unsigned char* ws0) {
    p.CTL = (unsigned*)ws0; unsigned char* ws = ws0 + WS_CTL_BYTES;
    const size_t M = MROWS; size_t o = 0;
    auto take = [&](size_t bytes_per_row) { unsigned char* r = ws + o; o += bytes_per_row * M; return r; };
    p.XN = (bf16_t*)take(2048); p.CP = p.XN;
    unsigned char* big = ws + o;
    p.PA = (bf16_t*)take(2048);
#ifdef CPU_EMU
    p.YA = p.PA; p.OC = p.PA + (size_t)2 * M * 256;
#else
    p.YA = p.XN; p.OC = p.XN + (size_t)2 * M * 256;
#endif
    p.PB = (bf16_t*)take(1024); p.PC = (bf16_t*)take(2048); p.PD = (bf16_t*)take(2560); p.AP = (bf16_t*)take(3584);
    p.XS = (bf16_t*)big; p.YS = p.XS; p.HID = (bf16_t*)(big + (size_t)4096 * M);
    p.WGU_T = (bf16_t*)(big + (size_t)8192 * M); p.WD_T = p.WGU_T + (size_t)NEXP * 2048 * 1024;
    p.LT = (bf16_t*)take(512); p.GA = (bf16_t*)take(512); p.RN = (float*)take(16); p.BON = (float*)take(16); p.CBG = (float*)take(64);
    p.ML = (float*)take(48);
#ifdef CPU_EMU
    p.MIX = (bf16_t*)take(2304);
#else
    p.XR = (bf16_t*)take(2304);
#endif
    p.RS = (float*)take(4); p.AFF = (float*)take(64); p.SLOT = (int*)take(64);
    p.IDX = (int*)take(8); p.GATE = (float*)take(8);
    p.WIN_T = (bf16_t*)(ws + o); p.WOUT_T = p.WIN_T + (size_t)3840 * 1024; p.WL_T = p.WOUT_T + (size_t)1024 * 1152; p.ZMID = p.WL_T + (size_t)1280 * 256;
}
static void fill_inputs(Params& p, void* const* d_in) {
    const float** f = (const float**)&p.x;
    for (int i = 0; i < 30; ++i) f[i] = (const float*)d_in[i];
}

#ifndef CPU_EMU
__global__ void __launch_bounds__(512, 2) mega_fwd(Params P) {
    extern __shared__ __attribute__((aligned(16))) unsigned char lds_raw[];
    Ctx C; C.lds = (LAS unsigned char*)lds_raw; C.lds_g = (char*)lds_raw; C.wave = __builtin_amdgcn_readfirstlane(threadIdx.x >> 6); C.G = gridDim.x;
    for (int u = threadIdx.x; u < 1024 / 4; u += 512) ((LAS unsigned*)(C.lds + LDSCTL_OFF))[u] = 0u;
    __syncthreads();
    { const unsigned* src = (const unsigned*)&P; LAS unsigned* dst = (LAS unsigned*)(C.lds + PARAMS_OFF);
      for (int u = threadIdx.x; u < (int)(sizeof(Params) / 4); u += 512) dst[u] = src[u]; }
    __syncthreads();
    PRef PL = *(const LAS Params*)(C.lds + PARAMS_OFF);
    C.bar = xcd_barrier_post(uni(PL.CTL) + CW_BAR, (volatile LAS unsigned*)(C.lds + MISC_OFF) + 8);
    forward(PL, C);
}

extern "C" void kernel_launch(void* const* d_in, const int* in_sizes, int n_in, void* d_out, int out_size, void* d_ws, size_t ws_size,
                              hipStream_t stream) {
    static int grid = 0;
    if (grid == 0) {
        int dev = 0, cus = 0, per_cu = 0;
        (void)hipGetDevice(&dev);
        (void)hipDeviceGetAttribute(&cus, hipDeviceAttributeMultiprocessorCount, dev);
        (void)hipFuncSetAttribute((const void*)mega_fwd, hipFuncAttributeMaxDynamicSharedMemorySize, LDS_BYTES);
        (void)hipOccupancyMaxActiveBlocksPerMultiprocessor(&per_cu, (const void*)mega_fwd, 512, LDS_BYTES);
        (void)hipGetLastError();
        grid = cus;
        if (per_cu < 1) fprintf(stderr, "kernel_launch: occupancy query reports %d blocks per CU\n", per_cu);
        if (WS_TOTAL_BYTES > ws_size) fprintf(stderr, "workspace too small: need %zu have %zu\n", (size_t)WS_TOTAL_BYTES, ws_size);
    }
    Params p; memset(&p, 0, sizeof(p));
    fill_inputs(p, d_in);
    p.out = (float*)d_out;
    p.MIX = (bf16_t*)d_out;
    carve(p, (unsigned char*)d_ws);
    (void)hipMemsetAsync(d_ws, 0, WS_CTL_BYTES, stream);
    void* args[] = {&p};
    static int mode = 0;
    if (mode != 2) {
        hipError_t e = hipLaunchCooperativeKernel((const void*)mega_fwd, dim3(grid), dim3(512), args, LDS_BYTES, stream);
        if (e == hipSuccess) { mode = 1; return; }
        fprintf(stderr, "cooperative launch failed: %s (grid %d); using a plain launch\n", hipGetErrorString(e), grid);
        (void)hipGetLastError(); mode = 2;
    }
    hipLaunchKernelGGL(mega_fwd, dim3(grid), dim3(512), LDS_BYTES, stream, p);
}
#endif
```

```cpp
#ifdef CPU_EMU
#include <cmath>
#include <cstdint>
#include <cstring>
#include <cstdio>
#include <cstdlib>
#define DEVFN static inline
#define GRID_SYNC() _Pragma("omp barrier")
struct Ctx { long gid, gs; };
#else
#include <hip/hip_runtime.h>
#include <hip/hip_cooperative_groups.h>
#include <cstdio>
#include <cstdint>
#include <cstring>
namespace cg = cooperative_groups;
#define DEVFN __device__ __forceinline__
#define GRID_SYNC() do { xcd_barrier(C.bar); if (KNOB_DUP & 2048) xcd_barrier(C.bar); } while (0)
#endif

#ifndef KNOB_CONVERT
#define KNOB_CONVERT 1
#endif
#ifndef KNOB_SCAN
#define KNOB_SCAN 3
#endif
#ifndef KNOB_ATTNB
#define KNOB_ATTNB 1
#endif
#ifndef KNOB_DUP
#define KNOB_DUP 0
#endif
#ifndef KNOB_SDUP
#define KNOB_SDUP 0
#endif
#ifndef KNOB_MFMA
#define KNOB_MFMA 15
#endif
#ifndef NB
#define NB 8
#endif
#ifndef NS
#define NS 4096
#endif
#define MROWS (NB * NS)
#define DM 1024
#define PIN 3728
#define MIXW 1152
#define NEXP 16
#define CAP (2 * NS / NEXP)
#define NPAIR (NB * NEXP * CAP)

typedef unsigned short bf16_t;
struct uint4v { unsigned x, y, z, w; };

DEVFN float bf2f(bf16_t v) { unsigned u = ((unsigned)v) << 16; float f; memcpy(&f, &u, 4); return f; }
DEVFN bf16_t f2bf(float f) { unsigned u; memcpy(&u, &f, 4); u = (u + 0x7fffu + ((u >> 16) & 1u)) >> 16; return (bf16_t)u; }
DEVFN float sigmoidf_(float x) { return 1.0f / (1.0f + expf(-x)); }
DEVFN float softplusf_(float x) { return (x > 0.f ? x : 0.f) + log1pf(expf(-fabsf(x))); }
DEVFN float siluf_(float x) { return x * sigmoidf_(x); }
DEVFN float bfpair(unsigned w, int odd) { unsigned u = odd ? (w & 0xffff0000u) : (w << 16); float f; memcpy(&f, &u, 4); return f; }
#define MEMBAR() asm volatile("" ::: "memory")
#ifdef CPU_EMU
#define OPAQUE(x) asm volatile("" : "+r"(x))
#else
#define OPAQUE(x) asm volatile("" : "+v"(x))
#endif
#ifdef CPU_EMU
DEVFN float fsin_(float x) { return sinf(x); }
DEVFN float fcos_(float x) { return cosf(x); }
#else
DEVFN float fsin_(float x) { return __sinf(x); }
DEVFN float fcos_(float x) { return __cosf(x); }
#endif

struct Params {
    const float *x, *norm_mix_g, *norm_ffn_g, *norm_final_g, *w_in, *w_out, *mu_prev, *mu_next, *w0, *w_up, *a0, *a_up, *g_up,
        *k_k, *k_a, *r_k, *ln_w, *ln_b, *q_norm, *k_norm, *conv, *a_log, *dt_bias, *gdn_norm_g, *rel_bias, *router_w, *router_b,
        *w_gate, *w_upx, *w_down;
    float* out;
    bf16_t *XN, *PA, *PB, *PC, *PD, *AP, *LT, *GA, *CP, *YA, *OC, *MIX, *HID, *YS, *XS, *WIN_T, *WOUT_T, *WGU_T, *WD_T, *WL_T, *ZMID, *XR;
    unsigned* CTL;
    float *RN, *BON, *CBG, *ML, *RS, *AFF, *GATE;
    int *SLOT, *IDX;
    int pad0, pad1;
};

#ifdef CPU_EMU
typedef const Params& PRef;
#else
typedef const __attribute__((address_space(3))) Params& PRef;
#endif
#define WS_ROW_BYTES 16932

DEVFN void ph_rowrs(const float* x, float* rs, long gid, long gs) {
    for (long r = gid; r < MROWS; r += gs) {
        const float* xr = x + r * DM; float s = 0.f;
        for (int c = 0; c < DM; ++c) s += xr[c] * xr[c];
        rs[r] = 1.0f / sqrtf(s * (1.0f / DM) + 1e-6f);
    }
}
DEVFN void ph_norm_bf16(const float* x, const float* rs, const float* g, bf16_t* o, long gid, long gs) {
    for (long i = gid; i < (long)MROWS * DM; i += gs) { long r = i / DM; int c = (int)(i % DM); o[i] = f2bf(x[i] * rs[r] * g[c]); }
}
DEVFN void ph_gemm_in(PRef P, int l, long gid, long gs) {
    const float* W = P.w_in + (size_t)l * DM * PIN;
    for (long it = gid; it < (long)(MROWS / 8) * PIN; it += gs) {
        const long rg = it / PIN; const int c = (int)(it % PIN);
        float acc[8];
#pragma unroll
        for (int j = 0; j < 8; ++j) acc[j] = 0.f;
        const bf16_t* a = P.XN + rg * 8 * DM;
        for (int k = 0; k < DM; ++k) {
            const float w = W[(size_t)k * PIN + c];
#pragma unroll
            for (int j = 0; j < 8; ++j) acc[j] += bf2f(a[j * DM + k]) * w;
        }
        bf16_t* dst; int pitch, cc;
        if (c < 1024) { dst = P.PA; pitch = 1024; cc = c; }
        else if (c < 1536) { dst = P.PB; pitch = 512; cc = c - 1024; }
        else if (c < 2560) { dst = P.PC; pitch = 1024; cc = c - 1536; }
        else if (c < 2576) { dst = P.PD; pitch = 1280; cc = 1152 + (c - 2560); }
        else { dst = P.PD; pitch = 1280; cc = c - 2576; }
#pragma unroll
        for (int j = 0; j < 8; ++j) dst[(rg * 8 + j) * pitch + cc] = f2bf(acc[j]);
    }
}
DEVFN void ph_prepA_shift(PRef P, int l, long gid, long gs) {
    const float* mp = P.mu_prev + l * 1024; const float* mn = P.mu_next + l * 1024;
    for (long i = gid; i < (long)MROWS * 1024; i += gs) {
        const long t = i / 1024; const int c = (int)(i % 1024); const int s = (int)(t % NS);
        const float f = bf2f(P.PA[i]);
        const float pv = s > 0 ? bf2f(P.PA[i - 1024]) : 0.f;
        const float nx = s < NS - 1 ? bf2f(P.PA[i + 1024]) : 0.f;
        const float o = f + mp[c] * (pv - f) + mn[c] * (nx - f);
        if (c < 768) P.AP[t * 1792 + c] = f2bf(o); else P.LT[t * 256 + (c - 768)] = f2bf(c < 832 ? tanhf(o) : (c < 896 ? o : sigmoidf_(o)));
    }
}
DEVFN void ph_prepA_lora(PRef P, int l, long gid, long gs) {
    const float* w0 = P.w0 + l * 512; const float* a0 = P.a0 + l * 512;
    const float* wu = P.w_up + (size_t)l * 2 * 64 * 256; const float* au = P.a_up + (size_t)l * 2 * 64 * 256; const float* gu = P.g_up + (size_t)l * 128 * 256;
    for (long i = gid; i < (long)MROWS * 256; i += gs) {
        const long t = i / 256; const int c = (int)(i % 256);
        const bf16_t* lt = P.LT + t * 256;
        float aw0 = 0.f, aw1 = 0.f, aa0 = 0.f, aa1 = 0.f, ag = 0.f;
        for (int r = 0; r < 64; ++r) {
            const float tw = bf2f(lt[r]); const float ad = bf2f(lt[64 + r]);
            aw0 += tw * wu[r * 256 + c]; aw1 += tw * wu[(64 + r) * 256 + c];
            aa0 += ad * au[r * 256 + c]; aa1 += ad * au[(64 + r) * 256 + c];
        }
        for (int r = 0; r < 128; ++r) ag += bf2f(lt[128 + r]) * gu[r * 256 + c];
        bf16_t* ap = P.AP + t * 1792;
        ap[768 + c] = f2bf(0.6065306597f * sigmoidf_(w0[c] + aw0));
        ap[1024 + c] = f2bf(0.6065306597f * sigmoidf_(w0[256 + c] + aw1));
        ap[1280 + c] = f2bf(sigmoidf_(a0[c] + aa0));
        ap[1536 + c] = f2bf(sigmoidf_(a0[256 + c] + aa1));
        P.GA[i] = f2bf(ag);
    }
}
DEVFN void ph_prepA_rn(PRef P, int l, long gid, long gs) {
    const float* kk = P.k_k + l * 256; const float* ka = P.k_a + l * 256; const float* rk = P.r_k + l * 256;
    for (long i = gid; i < (long)MROWS * 4; i += gs) {
        const long t = i / 4; const int h = (int)(i % 4); const bf16_t* ap = P.AP + t * 1792;
        float s = 0.f, bo = 0.f;
        for (int j = 0; j < 64; ++j) {
            const int c = h * 64 + j; const float k = bf2f(ap[256 + c]); const float kx = k * kk[c]; s += kx * kx;
            const float am = 0.5f * (bf2f(ap[1280 + c]) + bf2f(ap[1536 + c]));
            bo += bf2f(ap[c]) * (k * (1.0f + (am - 1.0f) * ka[c])) * rk[c];
        }
        P.RN[i] = 1.0f / sqrtf(s + 1e-12f); P.BON[i] = bo;
    }
}
DEVFN void ph_prepB(PRef P, int l, long gid, long gs) {
    for (long i = gid; i < (long)MROWS * 6; i += gs) {
        const long t = i / 6; const int hh = (int)(i % 6); const int s = (int)(t % NS);
        bf16_t* p = P.PB + t * 512 + hh * 64; const float* g = (hh < 4 ? P.q_norm : P.k_norm) + l * 64;
        float v[64]; float ss = 0.f;
#pragma unroll
        for (int j = 0; j < 64; ++j) { v[j] = bf2f(p[j]); ss += v[j] * v[j]; }
        const float rs = 1.0f / sqrtf(ss * (1.0f / 64) + 1e-6f);
#pragma unroll
        for (int j = 0; j < 64; ++j) v[j] = v[j] * rs * g[j];
        const float sc = hh < 4 ? 0.125f * 1.4426950408889634f : 1.0f;
        const float rowid = (float)(s / 64), colid = (float)(s % 64);
#pragma unroll
        for (int j = 0; j < 16; ++j) {
            const float inv = exp2f(-(float)j * 0.8304820237218406f);
            const float ar = rowid * inv, ac = colid * inv; const float cr = fcos_(ar), sr = fsin_(ar), cc = fcos_(ac), sc2 = fsin_(ac);
            const float x1 = v[j], x2 = v[16 + j]; p[j] = f2bf((x1 * cr - x2 * sr) * sc); p[16 + j] = f2bf((x2 * cr + x1 * sr) * sc);
            const float y1 = v[32 + j], y2 = v[48 + j]; p[32 + j] = f2bf((y1 * cc - y2 * sc2) * sc); p[48 + j] = f2bf((y2 * cc + y1 * sc2) * sc);
        }
    }
}
DEVFN void ph_prepC_conv(PRef P, int l, long gid, long gs) {
    const float* cw = P.conv + (size_t)l * 5 * 768;
    for (long i = gid; i < (long)MROWS * 12; i += gs) {
        const long t = i / 12; const int g = (int)(i % 12); const int s = (int)(t % NS);
        float v[64]; float ss = 0.f;
#pragma unroll
        for (int j = 0; j < 64; ++j) {
            const int c = g * 64 + j; float a = 0.f;
#pragma unroll
            for (int q = 0; q < 5; ++q) { const int sq = s + q - 2; if (sq >= 0 && sq < NS) a += bf2f(P.PC[(t + q - 2) * 1024 + c]) * cw[q * 768 + c]; }
            a = siluf_(a); v[j] = a; ss += a * a;
        }
        float sc = 1.0f;
        if (g < 8) sc = 1.0f / sqrtf(ss + 1e-12f);
        if (g < 4) sc *= 0.125f;
#pragma unroll
        for (int j = 0; j < 64; ++j) P.CP[t * 768 + g * 64 + j] = f2bf(v[j] * sc);
    }
}
DEVFN void ph_prepC_bg(PRef P, int l, long gid, long gs) {
    for (long i = gid; i < (long)MROWS * 8; i += gs) {
        const long t = i / 8; const int dh = (int)(i % 8);
        const float b = bf2f(P.PD[t * 1280 + 1152 + dh]), al = bf2f(P.PD[t * 1280 + 1160 + dh]);
        P.CBG[t * 16 + dh] = sigmoidf_(b);
        P.CBG[t * 16 + 8 + dh] = -expf(P.a_log[l * 8 + dh]) * softplusf_(al + P.dt_bias[l * 8 + dh]);
    }
}
DEVFN void ph_scanA(PRef P, int l, long gid, long gs) {
    const float* kkp = P.k_k + l * 256; const float* kap = P.k_a + l * 256;
    for (long it = gid; it < (long)2 * NB * 4 * 64; it += gs) {
        const int v = (int)(it % 64), h = (int)((it / 64) % 4), b = (int)((it / 256) % NB), d = (int)(it / (256 * NB));
        float S[64];
#pragma unroll
        for (int j = 0; j < 64; ++j) S[j] = 0.f;
        for (int s = 0; s < NS; ++s) {
            MEMBAR();
            const long t = (long)b * NS + (d == 0 ? s : NS - 1 - s);
            const bf16_t* ap = P.AP + t * 1792 + h * 64; const float rn = P.RN[t * 4 + h];
            const float vv = bf2f(ap[512 + v]);
            float sa = 0.f;
#pragma unroll
            for (int j0 = 0; j0 < 64; j0 += 16) {
#pragma unroll
                for (int j = j0; j < j0 + 16; ++j) sa += S[j] * (bf2f(ap[256 + j]) * kkp[h * 64 + j] * rn);
                MEMBAR();
            }
            sa = -sa; float y = 0.f;
#pragma unroll
            for (int j0 = 0; j0 < 64; j0 += 8) {
#pragma unroll
                for (int j = j0; j < j0 + 8; ++j) {
                    const float k = bf2f(ap[256 + j]); const float kkv = k * kkp[h * 64 + j] * rn;
                    const float a = bf2f(ap[1280 + d * 256 + j]); const float w = expf(-bf2f(ap[768 + d * 256 + j]));
                    const float kx = k * (1.0f + (a - 1.0f) * kap[h * 64 + j]);
                    S[j] = S[j] * w + sa * (kkv * a) + vv * kx;
                    y += S[j] * bf2f(ap[j]);
                }
                MEMBAR();
            }
            P.YA[((size_t)d * MROWS + t) * 256 + h * 64 + v] = f2bf(y);
        }
    }
}
DEVFN void ph_scanC(PRef P, int l, long gid, long gs) {
    for (long it = gid; it < (long)2 * NB * 4 * 64; it += gs) {
        const int v = (int)(it % 64), h = (int)((it / 64) % 4), b = (int)((it / 256) % NB), d = (int)(it / (256 * NB));
        float S[64];
#pragma unroll
        for (int j = 0; j < 64; ++j) S[j] = 0.f;
        for (int s = 0; s < NS; ++s) {
            MEMBAR();
            const long t = (long)b * NS + (d == 0 ? s : NS - 1 - s);
            const bf16_t* cp = P.CP + t * 768 + h * 64;
            const float beta = P.CBG[t * 16 + d * 4 + h], eg = expf(P.CBG[t * 16 + 8 + d * 4 + h]);
            float pred = 0.f;
#pragma unroll
            for (int j0 = 0; j0 < 64; j0 += 16) {
#pragma unroll
                for (int j = j0; j < j0 + 16; ++j) pred += S[j] * bf2f(cp[256 + j]);
                MEMBAR(); }
            const float dd = beta * (bf2f(cp[512 + v]) - eg * pred); float o = 0.f;
#pragma unroll
            for (int j0 = 0; j0 < 64; j0 += 16) {
#pragma unroll
                for (int j = j0; j < j0 + 16; ++j) { S[j] = S[j] * eg + dd * bf2f(cp[256 + j]); o += S[j] * bf2f(cp[j]); }
                MEMBAR(); }
            P.OC[((size_t)d * MROWS + t) * 256 + h * 64 + v] = f2bf(o);
        }
    }
}
DEVFN void ph_attnB(PRef P, long gid, long gs) {
    for (long it = gid; it < (long)NB * 4 * NS; it += gs) {
        const int s = (int)(it % NS), h = (int)((it / NS) % 4), b = (int)(it / (4 * NS)); const int g = h / 2;
        const long t = (long)b * NS + s;
        unsigned q2[32]; float acc[64];
#pragma unroll
        for (int j = 0; j < 32; ++j) { memcpy(&q2[j], P.PB + t * 512 + h * 64 + 2 * j, 4); acc[2 * j] = 0.f; acc[2 * j + 1] = 0.f; }
        float m = -1e30f, lsum = 0.f;
        for (int kx = 0; kx < NS; ++kx) {
            const bf16_t* kp = P.PB + ((long)b * NS + kx) * 512 + 256 + g * 64; const bf16_t* vp = kp + 128;
            float sc = 0.f;
#pragma unroll
            for (int j = 0; j < 32; ++j) OPAQUE(q2[j]);
#pragma unroll
            for (int j0 = 0; j0 < 64; j0 += 16) {
#pragma unroll
                for (int j = j0; j < j0 + 16; ++j) sc += bfpair(q2[j >> 1], j & 1) * bf2f(kp[j]);
                MEMBAR(); }
            if (sc > m) { const float f = exp2f(m - sc); lsum *= f;
#pragma unroll
                for (int j = 0; j < 64; ++j) acc[j] *= f;
                m = sc; }
            const float p = exp2f(sc - m); lsum += p;
#pragma unroll
            for (int j0 = 0; j0 < 64; j0 += 16) {
#pragma unroll
                for (int j = j0; j < j0 + 16; ++j) acc[j] += p * bf2f(vp[j]);
                MEMBAR(); }
        }
        const float il = 1.0f / lsum;
#pragma unroll
        for (int j = 0; j < 64; ++j) P.MIX[t * MIXW + 256 + h * 64 + j] = f2bf(acc[j] * il);
    }
}
DEVFN int t5_bucket(int rel) {
    const int n = rel < 0 ? -rel : rel; int v;
    if (n < 8) v = n; else { int lg = 8 + (int)(logf((float)n / 8.0f) / 4.852030263919617f * 8.0f); v = lg < 15 ? lg : 15; }
    return (rel > 0 ? 16 : 0) + v;
}
DEVFN void ph_attnD(PRef P, long gid, long gs) {
    for (long it = gid; it < (long)NB * 6 * NS; it += gs) {
        const int s = (int)(it % NS), hd = (int)((it / NS) % 6), b = (int)(it / (6 * NS)); const int br = hd / 2; const int dil = br == 0 ? 1 : (br == 1 ? 4 : 16);
        const long t = (long)b * NS + s;
        unsigned q2[32]; float acc[64];
#pragma unroll
        for (int j = 0; j < 32; ++j) { memcpy(&q2[j], P.PD + t * 1280 + hd * 64 + 2 * j, 4); acc[2 * j] = 0.f; acc[2 * j + 1] = 0.f; }
        float m = -1e30f, lsum = 0.f;
        for (int jj = -64; jj <= 64; ++jj) {
            const int sk = s + jj * dil; if (sk < 0 || sk >= NS) continue;
            const bf16_t* kp = P.PD + ((long)b * NS + sk) * 1280 + 384 + hd * 64; const bf16_t* vp = kp + 384;
            float sc = 0.f;
#pragma unroll
            for (int j = 0; j < 32; ++j) OPAQUE(q2[j]);
#pragma unroll
            for (int j0 = 0; j0 < 64; j0 += 16) {
#pragma unroll
                for (int j = j0; j < j0 + 16; ++j) sc += bfpair(q2[j >> 1], j & 1) * bf2f(kp[j]);
                MEMBAR(); }
            sc = sc * 0.125f + P.rel_bias[t5_bucket(jj * dil) * 6 + hd];
            if (sc > m) { const float f = expf(m - sc); lsum *= f;
#pragma unroll
                for (int j = 0; j < 64; ++j) acc[j] *= f;
                m = sc; }
            const float p = expf(sc - m); lsum += p;
#pragma unroll
            for (int j0 = 0; j0 < 64; j0 += 16) {
#pragma unroll
                for (int j = j0; j < j0 + 16; ++j) acc[j] += p * bf2f(vp[j]);
                MEMBAR(); }
        }
        const float il = 1.0f / lsum;
#pragma unroll
        for (int j = 0; j < 64; ++j) P.MIX[t * MIXW + 768 + hd * 64 + j] = f2bf(acc[j] * il);
        P.ML[t * 12 + hd * 2] = m; P.ML[t * 12 + hd * 2 + 1] = lsum;
    }
}
DEVFN void ph_fixA(PRef P, int l, long gid, long gs) {
    const float* lw = P.ln_w + l * 256; const float* lb = P.ln_b + l * 256;
    for (long i = gid; i < (long)MROWS * 4; i += gs) {
        const long t = i / 4; const int h = (int)(i % 4);
        float y[64]; float mean = 0.f;
#pragma unroll
        for (int j = 0; j < 64; ++j) { y[j] = bf2f(P.YA[t * 256 + h * 64 + j]) + bf2f(P.YA[((size_t)MROWS + t) * 256 + h * 64 + j]); mean += y[j]; }
        mean *= (1.0f / 64); float var = 0.f;
#pragma unroll
        for (int j = 0; j < 64; ++j) { const float d = y[j] - mean; var += d * d; }
        const float rstd = 1.0f / sqrtf(var * (1.0f / 64) + 64e-5f); const float bo = P.BON[i];
#pragma unroll
        for (int j = 0; j < 64; ++j) { const int c = h * 64 + j;
            const float o = ((y[j] - mean) * rstd * lw[c] + lb[c] + bo * bf2f(P.AP[t * 1792 + 512 + c])) * bf2f(P.GA[t * 256 + c]);
            P.MIX[t * MIXW + c] = f2bf(o); }
    }
}
DEVFN void ph_fixC(PRef P, int l, long gid, long gs) {
    const float* ng = P.gdn_norm_g + l * 64;
    for (long i = gid; i < (long)MROWS * 4; i += gs) {
        const long t = i / 4; const int h = (int)(i % 4);
        float o[64]; float ss = 0.f;
#pragma unroll
        for (int j = 0; j < 64; ++j) { o[j] = bf2f(P.OC[t * 256 + h * 64 + j]) + bf2f(P.OC[((size_t)MROWS + t) * 256 + h * 64 + j]); ss += o[j] * o[j]; }
        const float rs = 1.0f / sqrtf(ss * (1.0f / 64) + 1e-6f);
#pragma unroll
        for (int j = 0; j < 64; ++j) P.MIX[t * MIXW + 512 + h * 64 + j] = f2bf(o[j] * rs * ng[j] * siluf_(bf2f(P.PC[t * 1024 + 768 + h * 64 + j])));
    }
}
DEVFN void ph_fixD(PRef P, long gid, long gs) {
    for (long i = gid; i < (long)MROWS * 2; i += gs) {
        const long t = i / 2; const int jh = (int)(i % 2);
        float m[3], lv[3]; float mx = -1e30f;
#pragma unroll
        for (int br = 0; br < 3; ++br) { m[br] = P.ML[t * 12 + (br * 2 + jh) * 2]; lv[br] = P.ML[t * 12 + (br * 2 + jh) * 2 + 1]; mx = m[br] > mx ? m[br] : mx; }
        float den[3], sum = 0.f;
#pragma unroll
        for (int br = 0; br < 3; ++br) { den[br] = lv[br] * expf(m[br] - mx); sum += den[br]; }
#pragma unroll
        for (int br = 0; br < 3; ++br) { const float w = den[br] / sum; bf16_t* p = P.MIX + t * MIXW + 768 + (br * 2 + jh) * 64;
            for (int j = 0; j < 64; ++j) p[j] = f2bf(bf2f(p[j]) * w); }
    }
}
DEVFN void ph_gemm_out(PRef P, int l, const float* xsrc, long gid, long gs) {
    const float* W = P.w_out + (size_t)l * MIXW * DM;
    for (long it = gid; it < (long)(MROWS / 8) * DM; it += gs) {
        const long rg = it / DM; const int c = (int)(it % DM);
        float acc[8];
#pragma unroll
        for (int j = 0; j < 8; ++j) acc[j] = 0.f;
        const bf16_t* a = P.MIX + rg * 8 * MIXW;
        for (int k = 0; k < MIXW; ++k) { const float w = W[(size_t)k * DM + c];
#pragma unroll
            for (int j = 0; j < 8; ++j) acc[j] += bf2f(a[j * MIXW + k]) * w; }
#pragma unroll
        for (int j = 0; j < 8; ++j) { const size_t o = (size_t)(rg * 8 + j) * DM + c; P.out[o] = xsrc[o] + acc[j]; }
    }
}
DEVFN void ph_router(PRef P, int l, long gid, long gs) {
    const float* g = P.norm_ffn_g + l * DM; const float* rw = P.router_w + (size_t)l * DM * NEXP; const float* rb = P.router_b + l * NEXP;
    for (long r = gid; r < MROWS; r += gs) {
        const float* xr = P.out + r * DM; float ss = 0.f; float lg[NEXP];
#pragma unroll
        for (int e = 0; e < NEXP; ++e) lg[e] = 0.f;
        for (int c = 0; c < DM; ++c) { const float xv = xr[c]; ss += xv * xv; const float xg = xv * g[c];
#pragma unroll
            for (int e = 0; e < NEXP; ++e) lg[e] += xg * rw[c * NEXP + e]; }
        const float rs = 1.0f / sqrtf(ss * (1.0f / DM) + 1e-6f); P.RS[r] = rs;
        float mx = -1e30f;
#pragma unroll
        for (int e = 0; e < NEXP; ++e) { lg[e] = lg[e] * rs + rb[e]; mx = lg[e] > mx ? lg[e] : mx; }
        float sum = 0.f;
#pragma unroll
        for (int e = 0; e < NEXP; ++e) { lg[e] = expf(lg[e] - mx); sum += lg[e]; }
#pragma unroll
        for (int e = 0; e < NEXP; ++e) P.AFF[r * NEXP + e] = lg[e] / sum;
    }
}
DEVFN void ph_topk(PRef P, long gid, long gs) {
    for (long it = gid; it < (long)NB * NEXP * NS; it += gs) {
        const int s = (int)(it % NS), e = (int)((it / NS) % NEXP), b = (int)(it / ((long)NS * NEXP));
        const float* af = P.AFF + (size_t)b * NS * NEXP + e; const float v = af[(size_t)s * NEXP];
        int rank = 0;
        for (int s2 = 0; s2 < NS; ++s2) { const float o = af[(size_t)s2 * NEXP]; rank += (o > v || (o == v && s2 < s)) ? 1 : 0; }
        const long t = (long)b * NS + s;
        if (rank < CAP) { const long p = ((long)e * NB + b) * CAP + rank; P.IDX[p] = (int)t; P.GATE[p] = v; P.SLOT[t * NEXP + e] = rank; }
        else P.SLOT[t * NEXP + e] = -1;
    }
}
DEVFN void ph_gemm_gu(PRef P, int l, long gid, long gs) {
    for (long it = gid; it < (long)(NPAIR / 8) * DM; it += gs) {
        const long pg = it / DM; const int f = (int)(it % DM); const int e = (int)(pg * 8 / ((long)CAP * NB));
        const float* Wg = P.w_gate + ((size_t)l * NEXP + e) * DM * DM; const float* Wu = P.w_upx + ((size_t)l * NEXP + e) * DM * DM;
        float ag[8], au[8]; const bf16_t* a[8];
#pragma unroll
        for (int j = 0; j < 8; ++j) { ag[j] = 0.f; au[j] = 0.f; a[j] = P.XS + (size_t)(pg * 8 + j) * DM; }
        for (int k = 0; k < DM; ++k) { const float wg = Wg[(size_t)k * DM + f], wu = Wu[(size_t)k * DM + f];
#pragma unroll
            for (int j = 0; j < 8; ++j) { const float xv = bf2f(a[j][k]); ag[j] += xv * wg; au[j] += xv * wu; } }
#pragma unroll
        for (int j = 0; j < 8; ++j) P.HID[(size_t)(pg * 8 + j) * DM + f] = f2bf(siluf_(ag[j]) * au[j]);
    }
}
DEVFN void ph_gemm_down(PRef P, int l, long gid, long gs) {
    for (long it = gid; it < (long)(NPAIR / 8) * DM; it += gs) {
        const long pg = it / DM; const int c = (int)(it % DM); const int e = (int)(pg * 8 / ((long)CAP * NB));
        const float* Wd = P.w_down + ((size_t)l * NEXP + e) * DM * DM;
        float acc[8];
#pragma unroll
        for (int j = 0; j < 8; ++j) acc[j] = 0.f;
        const bf16_t* a = P.HID + (size_t)pg * 8 * DM;
        for (int k = 0; k < DM; ++k) { const float w = Wd[(size_t)k * DM + c];
#pragma unroll
            for (int j = 0; j < 8; ++j) acc[j] += bf2f(a[j * DM + k]) * w; }
#pragma unroll
        for (int j = 0; j < 8; ++j) P.YS[(size_t)(pg * 8 + j) * DM + c] = f2bf(acc[j] * P.GATE[pg * 8 + j]);
    }
}
DEVFN void ph_gather(PRef P, long gid, long gs) {
    for (long i = gid; i < (long)NPAIR * 128; i += gs) { const long p = i / 128; const int ch = (int)(i % 128);
        const uint4v* src = (const uint4v*)(P.XN + (size_t)P.IDX[p] * DM) + ch; ((uint4v*)(P.XS + (size_t)p * DM))[ch] = *src; }
}
DEVFN void ph_combine(PRef P, long gid, long gs) {
    for (long i = gid; i < (long)MROWS * DM; i += gs) {
        const long t = i / DM; const int c = (int)(i % DM); const int b = (int)(t / NS);
        float acc = P.out[i];
        for (int e = 0; e < NEXP; ++e) { const int sl = P.SLOT[t * NEXP + e]; if (sl >= 0) acc += bf2f(P.YS[(((size_t)e * NB + b) * CAP + sl) * DM + c]); }
        P.out[i] = acc;
    }
}
DEVFN void ph_final(PRef P, long gid, long gs) {
    for (long i = gid; i < (long)MROWS * DM; i += gs) { const long r = i / DM; const int c = (int)(i % DM); P.out[i] = P.out[i] * P.RS[r] * P.norm_final_g[c]; }
}


#ifndef CPU_EMU
__device__ __forceinline__ int fresh_tid() { int t = threadIdx.x; asm volatile("" : "+v"(t)); return t; }
__device__ __forceinline__ int fresh_bx() { int b = blockIdx.x; asm volatile("" : "+s"(b)); return b; }
namespace pg8 {
#define PG8_LAS __attribute__((address_space(3)))
typedef unsigned short bf16_t;
typedef short bf16x8 __attribute__((ext_vector_type(8)));
typedef float f32x4 __attribute__((ext_vector_type(4)));
typedef unsigned u32x4 __attribute__((ext_vector_type(4)));
constexpr int BM = 256, BK = 64, HALF = 128, HTB = HALF * BK * 2  , STAGE_BYTES = 8 * HTB, NXCD = 8, WGM = 8;

__host__ __device__ __forceinline__ int lds_byte(int r, int c) { const int st = (r >> 4) * 2 + (c >> 5), rr = r & 15, cc = c & 31, ob = rr * 64 + cc * 2; return st * 1024 + (ob ^ (((ob >> 9) & 1) << 5)); }
__host__ __device__ __forceinline__ void stage_rc(int b, int& R, int& C) { const int st = b / 1024, sb = b % 1024, swz = sb ^ (((sb >> 9) & 1) << 5); R = (st >> 1) * 16 + swz / 64; C = (st & 1) * 32 + (swz % 64) / 2; }
__host__ __device__ __forceinline__ int perm32(int rho) { const int n = rho >> 4, i = rho & 15; return 8 * (i >> 2) + 4 * n + (i & 3); }

struct Unit { int pm, pn; size_t boff; int ui; };
struct Gemm { const bf16_t* A; const bf16_t* Bt; int M, N, K; };

struct StaticOrder {
    int nM, nN, nwg, G, c, rows_per_group; size_t group_stride;
    __host__ __device__ void init(int M, int N, int G_, int c_) { nM = M / BM; nN = N / BM; nwg = nM * nN; G = G_; c = c_; rows_per_group = 1 << 30; group_stride = 0; }
    __host__ __device__ bool next(int i, Unit& u) const {
        const long L = (long)i * G + c; if (L >= nwg) return false;
        int wgid = (int)L; { const int q = nwg / NXCD, r = nwg % NXCD, xcd = wgid % NXCD, off = wgid / NXCD; wgid = (xcd < r ? xcd * (q + 1) : r * (q + 1) + (xcd - r) * q) + off; }
        const int nig = WGM * nN, gid = wgid / nig, fm = gid * WGM, gsz = (nM - fm) < WGM ? (nM - fm) : WGM;
        u.pm = fm + ((wgid % nig) % gsz); u.pn = (wgid % nig) / gsz; u.boff = (size_t)(u.pm / rows_per_group) * group_stride; u.ui = i; return true;
    }
    __device__ __forceinline__ void a_ready(const Unit&) const {}
    __device__ __forceinline__ void done(const Unit&) const {}
};


__device__ __forceinline__ unsigned cvt_pk_bf16(float lo, float hi) { unsigned r; asm volatile("v_cvt_pk_bf16_f32 %0, %1, %2" : "=v"(r) : "v"(lo), "v"(hi)); return r; }
typedef float f32x2 __attribute__((ext_vector_type(2)));

typedef float f32x2 __attribute__((ext_vector_type(2)));
template <class Epi, class Sched, bool ALIGN_EPI = false, bool SP2 = false, bool GATHER = false>
__device__ __forceinline__ void gemm_phase(PG8_LAS unsigned char* lds, const Gemm g, const Sched& S, const Epi& E, const PG8_LAS unsigned* gtab = nullptr) {
    static_assert(!GATHER || SP2, "the gathered A operand is wired into the SP2 schedule only");
    const int tid = fresh_tid(), wid = __builtin_amdgcn_readfirstlane(tid >> 6), lane = tid & 63, wr = wid >> 2, wc = wid & 3, fr = lane & 15, fq = lane >> 4;
    const int K = g.K, nt = K / BK;
    unsigned voffA[2], voffB[2]; int rowA[2]; unsigned colA2[2];
#pragma unroll
    for (int i = 0; i < 2; ++i) { int R, C; stage_rc(tid * 16 + i * 8192, R, C); const int Rb = Epi::PERM ? ((R & ~31) + perm32(R & 31)) : R;
        voffA[i] = (unsigned)(R * K + C) * 2u; voffB[i] = (unsigned)(Rb * K + C) * 2u; rowA[i] = R; colA2[i] = (unsigned)C * 2u; }
    unsigned vC[2][2] = {{0u, 0u}, {0u, 0u}}, vN[2][2] = {{0u, 0u}, {0u, 0u}};
    auto gload = [&](int ui_, unsigned (&v)[2][2]) __attribute__((always_inline)) {
#pragma unroll
        for (int h = 0; h < 2; ++h)
#pragma unroll
            for (int i = 0; i < 2; ++i) v[h][i] = gtab[ui_ * 256 + h * HALF + rowA[i]] + colA2[i]; };
    const size_t kstep = (size_t)(BK * 2);
    const size_t hstep = (size_t)HALF * K * 2;
    const size_t tstep = 2 * hstep;
    const unsigned ldsw = (unsigned)wid * 1024u;
    const int aoff = lds_byte(wr * 64 + fr, fq * 8), boff = lds_byte(wc * 32 + fr, fq * 8);
#define PG8_SA(b, h) (((b) * 2 + (h)) * HTB)
#define PG8_SB(b, h) ((4 + (b) * 2 + (h)) * HTB)
#define PG8_STAGE(bufoff, gbase, voff) do { _Pragma("unroll") for (int _i = 0; _i < 2; ++_i) \
        __builtin_amdgcn_global_load_lds((const unsigned*)((const char*)(gbase) + (voff)[_i]), (PG8_LAS unsigned*)(lds + (bufoff) + ldsw + _i * 8192), 16, 0, 0); } while (0)
#define PG8_LDA(dst, b, h) do { _Pragma("unroll") for (int m = 0; m < 4; ++m) _Pragma("unroll") for (int k = 0; k < 2; ++k) dst[m][k] = *(const PG8_LAS bf16x8*)(lds + PG8_SA(b, h) + aoff + m * 2048 + k * 1024); } while (0)
#define PG8_LDB(dst, b, h) do { _Pragma("unroll") for (int n = 0; n < 2; ++n) _Pragma("unroll") for (int k = 0; k < 2; ++k) dst[n][k] = *(const PG8_LAS bf16x8*)(lds + PG8_SB(b, h) + boff + n * 2048 + k * 1024); } while (0)
#define PG8_MMA(ai, bj, At, Bt) do { __builtin_amdgcn_s_setprio(1); _Pragma("unroll") for (int m = 0; m < 4; ++m) _Pragma("unroll") for (int n = 0; n < 2; ++n) _Pragma("unroll") for (int k = 0; k < 2; ++k) \
        acc[ai][bj][m][n] = __builtin_amdgcn_mfma_f32_16x16x32_bf16(Bt[n][k], At[m][k], acc[ai][bj][m][n], 0, 0, 0); __builtin_amdgcn_s_setprio(0); } while (0)
#define PG8_WAIT_V(n) asm volatile("s_waitcnt vmcnt(" #n ")" ::: "memory")
#define PG8_WAIT_L(n) asm volatile("s_waitcnt lgkmcnt(" #n ")" ::: "memory")
#define PG8_BAR __builtin_amdgcn_s_barrier()
#define PG8_SCHED __builtin_amdgcn_sched_barrier(0)
    auto stageA = [&](int bufoff, const char* gbase, int h, bool nx) __attribute__((always_inline)) {
        if constexpr (GATHER) { unsigned v_[2] = {nx ? vN[h][0] : vC[h][0], nx ? vN[h][1] : vC[h][1]}; PG8_STAGE(bufoff, gbase, v_); }
        else { (void)nx; PG8_STAGE(bufoff, gbase + (h ? hstep : 0), voffA); } };
    Unit cur, nxt; int ui = 0;
    if (!S.next(0, cur)) return;
    f32x4 acc[2][2][4][2];
#pragma unroll
    for (int a = 0; a < 2; ++a)
#pragma unroll
        for (int b = 0; b < 2; ++b)
#pragma unroll
            for (int m = 0; m < 4; ++m)
#pragma unroll
                for (int n = 0; n < 2; ++n) acc[a][b][m][n] = (f32x4){0.f, 0.f, 0.f, 0.f};
    bf16x8 At[4][2], B0[2][2], B1[2][2];
    const char* cA = (const char*)g.A + (GATHER ? (size_t)0 : (size_t)cur.pm * tstep); const char* cB = (const char*)g.Bt + cur.boff + (size_t)cur.pn * tstep;
    S.a_ready(cur);
    if constexpr (GATHER) gload(0, vC);
    if constexpr (SP2) {
        PG8_STAGE(PG8_SB(0, 0), cB, voffB); PG8_STAGE(PG8_SB(0, 1), cB + hstep, voffB); stageA(PG8_SA(0, 0), cA, 0, false); stageA(PG8_SA(0, 1), cA, 1, false);
        if (wr == 1) PG8_BAR;
        PG8_WAIT_V(2); PG8_BAR;
        PG8_STAGE(PG8_SB(1, 0), cB + kstep, voffB); stageA(PG8_SA(1, 0), cA + kstep, 0, false); PG8_STAGE(PG8_SB(1, 1), cB + hstep + kstep, voffB);
        PG8_WAIT_V(6); PG8_BAR;
    } else {
        PG8_STAGE(PG8_SB(0, 0), cB, voffB); PG8_STAGE(PG8_SA(0, 0), cA, voffA); PG8_STAGE(PG8_SB(0, 1), cB + hstep, voffB); PG8_STAGE(PG8_SA(0, 1), cA + hstep, voffA);
        if (wr == 1) PG8_BAR;
        PG8_WAIT_V(4); PG8_BAR;
        PG8_STAGE(PG8_SB(1, 0), cB + kstep, voffB); PG8_STAGE(PG8_SA(1, 0), cA + kstep, voffA); PG8_STAGE(PG8_SB(1, 1), cB + hstep + kstep, voffB);
        PG8_WAIT_V(6); PG8_BAR;
    }
    for (;;) {
        const bool has_next = S.next(ui + 1, nxt);
        const char* nA = has_next ? (const char*)g.A + (GATHER ? (size_t)0 : (size_t)nxt.pm * tstep) : cA;
        if constexpr (GATHER) { if (has_next) gload(ui + 1, vN); else {
#pragma unroll
            for (int h = 0; h < 2; ++h) { vN[h][0] = vC[h][0]; vN[h][1] = vC[h][1]; } } } const char* nB = has_next ? (const char*)g.Bt + nxt.boff + (size_t)nxt.pn * tstep : cB;
        for (int t = 0; t < nt; t += 2) {
            const bool last = (t == nt - 2);
            const char* a1 = cA + (size_t)(t + 1) * kstep;
            const char* a2 = last ? nA : cA + (size_t)(t + 2) * kstep; const char* b2 = last ? nB : cB + (size_t)(t + 2) * kstep;
            const char* a3 = a2 + kstep; const char* b3 = b2 + kstep;
            if (last && has_next) S.a_ready(nxt);
            if constexpr (SP2) {
            PG8_LDB(B0, 0, 0); PG8_LDB(B1, 0, 1); PG8_SCHED; PG8_LDA(At, 0, 0); stageA(PG8_SA(1, 1), a1, 1, false);
            PG8_WAIT_V(8); PG8_WAIT_L(0); PG8_BAR; PG8_MMA(0, 0, At, B0); PG8_MMA(0, 1, At, B1); PG8_BAR; PG8_SCHED;
            PG8_LDA(At, 0, 1); PG8_STAGE(PG8_SB(0, 0), b2, voffB); PG8_STAGE(PG8_SB(0, 1), b2 + hstep, voffB); stageA(PG8_SA(0, 0), a2, 0, last);
            PG8_WAIT_V(8); PG8_WAIT_L(0); PG8_BAR; PG8_MMA(1, 0, At, B0); PG8_MMA(1, 1, At, B1); PG8_BAR; PG8_SCHED;
            PG8_LDB(B0, 1, 0); PG8_LDB(B1, 1, 1); PG8_SCHED; PG8_LDA(At, 1, 0); stageA(PG8_SA(0, 1), a2, 1, last);
            PG8_WAIT_V(8); PG8_WAIT_L(0); PG8_BAR; PG8_MMA(0, 0, At, B0); PG8_MMA(0, 1, At, B1); PG8_BAR; PG8_SCHED;
            PG8_LDA(At, 1, 1); PG8_STAGE(PG8_SB(1, 0), b3, voffB); PG8_STAGE(PG8_SB(1, 1), b3 + hstep, voffB); stageA(PG8_SA(1, 0), a3, 0, last);
            PG8_WAIT_V(8); PG8_WAIT_L(0); PG8_BAR; PG8_MMA(1, 0, At, B0); PG8_MMA(1, 1, At, B1); PG8_BAR; PG8_SCHED;
            } else {
            PG8_LDB(B0, 0, 0); PG8_SCHED; PG8_LDA(At, 0, 0); PG8_STAGE(PG8_SA(1, 1), a1 + hstep, voffA);
            PG8_WAIT_L(8); PG8_BAR; PG8_WAIT_L(0); PG8_MMA(0, 0, At, B0); PG8_BAR; PG8_SCHED;
            PG8_LDB(B1, 0, 1); PG8_STAGE(PG8_SB(0, 0), b2, voffB);
            PG8_BAR; PG8_WAIT_L(0); PG8_MMA(0, 1, At, B1); PG8_BAR;
            PG8_LDA(At, 0, 1); PG8_STAGE(PG8_SA(0, 0), a2, voffA);
            PG8_BAR; PG8_WAIT_L(0); PG8_MMA(1, 0, At, B0); PG8_BAR; PG8_SCHED;
            PG8_STAGE(PG8_SB(0, 1), b2 + hstep, voffB);
            PG8_WAIT_V(6); PG8_BAR; PG8_MMA(1, 1, At, B1); PG8_BAR;
            PG8_LDB(B0, 1, 0); PG8_SCHED; PG8_LDA(At, 1, 0); PG8_STAGE(PG8_SA(0, 1), a2 + hstep, voffA);
            PG8_WAIT_L(8); PG8_BAR; PG8_WAIT_L(0); PG8_MMA(0, 0, At, B0); PG8_BAR; PG8_SCHED;
            PG8_LDB(B1, 1, 1); PG8_STAGE(PG8_SB(1, 0), b3, voffB);
            PG8_BAR; PG8_WAIT_L(0); PG8_MMA(0, 1, At, B1); PG8_BAR;
            PG8_LDA(At, 1, 1); PG8_STAGE(PG8_SA(1, 0), a3, voffA);
            PG8_BAR; PG8_WAIT_L(0); PG8_MMA(1, 0, At, B0); PG8_BAR; PG8_SCHED;
            PG8_STAGE(PG8_SB(1, 1), b3 + hstep, voffB);
            PG8_WAIT_V(6); PG8_BAR; PG8_MMA(1, 1, At, B1); PG8_BAR;
            }
        }
        if constexpr (ALIGN_EPI) { if (wr == 0) PG8_BAR; }
        if constexpr (!Epi::AFTER_DRAIN) { E(acc, cur, wr, wc, fr, fq); S.done(cur); }
        if (!has_next) break;
#pragma unroll
        for (int a = 0; a < 2; ++a)
#pragma unroll
            for (int b = 0; b < 2; ++b)
#pragma unroll
                for (int m = 0; m < 4; ++m)
#pragma unroll
                    for (int n = 0; n < 2; ++n) acc[a][b][m][n] = (f32x4){0.f, 0.f, 0.f, 0.f};
        cur = nxt; cA = nA; cB = nB; ++ui;
        if constexpr (GATHER) {
#pragma unroll
            for (int h = 0; h < 2; ++h) { vC[h][0] = vN[h][0]; vC[h][1] = vN[h][1]; } }
        if constexpr (ALIGN_EPI) { if (wr == 1) PG8_BAR; }
    }
    PG8_WAIT_V(0);
    if constexpr (!ALIGN_EPI) { if (wr == 0) PG8_BAR; }
    PG8_BAR;
    if constexpr (Epi::AFTER_DRAIN) { E.fused(acc, cur, wr, wc, fr, fq, lds, wid, lane); S.done(cur); }
#undef PG8_SA
#undef PG8_SB
#undef PG8_STAGE
#undef PG8_LDA
#undef PG8_LDB
#undef PG8_MMA
#undef PG8_WAIT_V
#undef PG8_WAIT_L
#undef PG8_BAR
#undef PG8_SCHED
}
}

#define GAS __attribute__((address_space(1)))
#define LAS __attribute__((address_space(3)))
typedef unsigned v4u __attribute__((ext_vector_type(4)));
typedef float f32x4 __attribute__((ext_vector_type(4)));
typedef short bf16x8 __attribute__((ext_vector_type(8)));
typedef GAS unsigned gu32;
typedef GAS unsigned long long gu64;
#define RLX_AGENT __ATOMIC_RELAXED, __HIP_MEMORY_SCOPE_AGENT
#define LDS_WAIT() asm volatile("s_waitcnt lgkmcnt(0)" ::: "memory")
#define VM_WAIT() asm volatile("s_waitcnt vmcnt(0)" ::: "memory")
__device__ __forceinline__ unsigned long long rt() { return __builtin_amdgcn_s_memrealtime(); }
typedef float f32x2_pk __attribute__((ext_vector_type(2))); typedef __bf16 bf16x2_pk __attribute__((ext_vector_type(2)));
__device__ __forceinline__ unsigned pk2(float lo, float hi) { const f32x2_pk v = {lo, hi}; return __builtin_bit_cast(unsigned, __builtin_convertvector(v, bf16x2_pk)); }
__device__ __forceinline__ bf16_t f2bf_hw(float f) { return (bf16_t)(pk2(f, 0.f) & 0xffffu); }

#define XB_TMO      128
#define XB_XCNT(j)  (256  + 64 * (j))
#define XB_XSUB(j)  (1280 + 64 * (j))
#define XB_XGEN(j)  (2304 + 64 * (j))
#define XB_TOP      3328
#define XB_TOPGEN   3392
#define XCD_BAR_WORDS 3456
#define XB_SPIN_CAP (1u << 30)

__device__ __forceinline__ unsigned xb_ld(unsigned* p)              { return __hip_atomic_load(p, __ATOMIC_RELAXED, __HIP_MEMORY_SCOPE_AGENT); }
__device__ __forceinline__ unsigned xb_add(unsigned* p, unsigned v) { return __hip_atomic_fetch_add(p, v, __ATOMIC_RELAXED, __HIP_MEMORY_SCOPE_AGENT); }
__device__ __forceinline__ unsigned xb_xcc_id() { return (unsigned)__builtin_amdgcn_s_getreg((3 << 11) | 20) & 0xFu; }
#define XB_SPIN(cond, bar) do { unsigned _sp = 0; while (cond) { __builtin_amdgcn_s_sleep(1); \
    if ((++_sp & 255u) == 0u) { if (xb_ld(&(bar)[XB_TMO])) break; if (_sp > XB_SPIN_CAP) { atomicAdd(&(bar)[XB_TMO], 1u); break; } } } } while (0)

struct XcdBarrier {
    unsigned* bar; unsigned x;
    volatile LAS unsigned* st;
};

__device__ __forceinline__ XcdBarrier xcd_barrier_post(unsigned* bar, volatile LAS unsigned* st) {
    XcdBarrier b; b.bar = bar; b.x = xb_xcc_id(); b.st = st;
    if (threadIdx.x == 0) (void)xb_add(&bar[XB_XCNT(b.x)], 1u);
    return b;
}
__device__ __forceinline__ void xcd_barrier_complete(unsigned* bar, unsigned x, unsigned& nloc, unsigned& nx) {
    const unsigned G = gridDim.x * gridDim.y * gridDim.z;
    unsigned sum, cnt, mine, sp = 0u;
    for (;;) {
        sum = 0u; cnt = 0u; mine = 0u;
#pragma unroll
        for (unsigned j = 0; j < 16; ++j) { const unsigned c = xb_ld(&bar[XB_XCNT(j)]); sum += c; cnt += (c > 0u) ? 1u : 0u; mine = (j == x) ? c : mine; }
        if (sum == G) break;
        __builtin_amdgcn_s_sleep(1);
        if ((++sp & 255u) == 0u) { if (xb_ld(&bar[XB_TMO])) break; if (sp > XB_SPIN_CAP) { atomicAdd(&bar[XB_TMO], 1u); break; } }
    }
    nloc = mine > 0u ? mine : 1u; nx = cnt > 0u ? cnt : 1u;
}

__device__ __forceinline__ void xcd_barrier(const XcdBarrier& b) {
    asm volatile("s_waitcnt vmcnt(0)" ::: "memory");
    __syncthreads();
    if (threadIdx.x == 0) {
        unsigned* bar = b.bar;
        __builtin_amdgcn_s_waitcnt(0);
        unsigned nloc = b.st[0], nx = b.st[1];
        if (nloc == 0u) { xcd_barrier_complete(bar, b.x, nloc, nx); b.st[0] = nloc; b.st[1] = nx; }
        const unsigned old = xb_add(&bar[XB_XSUB(b.x)], 1u);
        const unsigned gen = old / nloc;
        if (old + 1u == (gen + 1u) * nloc) {
            __builtin_amdgcn_fence(__ATOMIC_RELEASE, "agent");
            asm volatile("s_waitcnt vmcnt(0)" ::: "memory");
            const unsigned og = xb_add(&bar[XB_TOP], 1u);
            const unsigned tg = og / nx;
            if (og + 1u == (tg + 1u) * nx) xb_add(&bar[XB_TOPGEN], 1u);
            else XB_SPIN(xb_ld(&bar[XB_TOPGEN]) == tg, bar);
            __builtin_amdgcn_fence(__ATOMIC_ACQUIRE, "agent");
            xb_add(&bar[XB_XGEN(b.x)], 1u);
            asm volatile("s_waitcnt vmcnt(0)" ::: "memory");
        } else {
            XB_SPIN(xb_ld(&bar[XB_XGEN(b.x)]) == gen, bar);
            __builtin_amdgcn_fence(__ATOMIC_ACQUIRE, "agent");
            asm volatile("s_waitcnt vmcnt(0)" ::: "memory");
        }
    }
    __syncthreads();
}

struct Ctx { LAS unsigned char* lds; char* lds_g; XcdBarrier bar; int wave, G; };
constexpr int RING_OFF = 0, RING_BYTES = 131072, LDS_BYTES = 163840, LDSCTL_OFF = LDS_BYTES - 2048, MISC_OFF = LDSCTL_OFF + 320, PARAMS_OFF = LDSCTL_OFF + 1024;
#define CW_BAR 4096

struct EpiIn {
    static constexpr bool PERM = true, AFTER_DRAIN = false;
    bf16_t *PA, *PB, *PC, *PD;
    __device__ __forceinline__ void operator()(const pg8::f32x4 (&acc)[2][2][4][2], const pg8::Unit& u, int wr, int wc, int fr, int fq) const {
        bf16_t* base; int ldc, colt;
        if (u.pn < 4) { base = PA; ldc = 1024; colt = u.pn * 256; } else if (u.pn < 6) { base = PB; ldc = 512; colt = (u.pn - 4) * 256; }
        else if (u.pn < 10) { base = PC; ldc = 1024; colt = (u.pn - 6) * 256; } else { base = PD; ldc = 1280; colt = (u.pn - 10) * 256; }
        const int row0 = u.pm * 256 + wr * 64 + fr, col0 = colt + wc * 32 + 8 * fq;
#pragma unroll
        for (int ai = 0; ai < 2; ++ai)
#pragma unroll
            for (int m = 0; m < 4; ++m) { bf16_t* rowp = base + (size_t)(row0 + ai * 128 + m * 16) * ldc + col0;
#pragma unroll
                for (int bj = 0; bj < 2; ++bj) { const pg8::f32x4 v0 = acc[ai][bj][m][0], v1 = acc[ai][bj][m][1]; pg8::u32x4 w;
                    w.x = pg8::cvt_pk_bf16(v0[0], v0[1]); w.y = pg8::cvt_pk_bf16(v0[2], v0[3]); w.z = pg8::cvt_pk_bf16(v1[0], v1[1]); w.w = pg8::cvt_pk_bf16(v1[2], v1[3]);
                    *(GAS pg8::u32x4*)(rowp + bj * 128) = w; } }
    }
};
template <bool SRC_BF16> struct EpiOut {
    static constexpr bool PERM = true, AFTER_DRAIN = false;
    const void* xsrc; bf16_t* XR;
    __device__ __forceinline__ void operator()(const pg8::f32x4 (&acc)[2][2][4][2], const pg8::Unit& u, int wr, int wc, int fr, int fq) const {
        const int col0 = u.pn * 256 + wc * 32 + 8 * fq;
#pragma unroll
        for (int ai = 0; ai < 2; ++ai)
#pragma unroll
            for (int m = 0; m < 4; ++m) { const size_t off = (size_t)(u.pm * 256 + ai * 128 + wr * 64 + m * 16 + fr) * DM + col0;
#pragma unroll
                for (int bj = 0; bj < 2; ++bj) { pg8::f32x4 b0, b1;
                    if (SRC_BF16) { const pg8::u32x4 w = *(const GAS pg8::u32x4*)((const bf16_t*)xsrc + off + bj * 128);
                        b0 = (pg8::f32x4){__uint_as_float(w.x << 16), __uint_as_float(w.x & 0xffff0000u), __uint_as_float(w.y << 16), __uint_as_float(w.y & 0xffff0000u)};
                        b1 = (pg8::f32x4){__uint_as_float(w.z << 16), __uint_as_float(w.z & 0xffff0000u), __uint_as_float(w.w << 16), __uint_as_float(w.w & 0xffff0000u)}; }
                    else { b0 = *(const GAS pg8::f32x4*)((const float*)xsrc + off + bj * 128); b1 = *(const GAS pg8::f32x4*)((const float*)xsrc + off + bj * 128 + 4); }
                    const pg8::f32x4 v0 = b0 + acc[ai][bj][m][0], v1 = b1 + acc[ai][bj][m][1]; pg8::u32x4 o;
                    o.x = pg8::cvt_pk_bf16(v0[0], v0[1]); o.y = pg8::cvt_pk_bf16(v0[2], v0[3]); o.z = pg8::cvt_pk_bf16(v1[0], v1[1]); o.w = pg8::cvt_pk_bf16(v1[2], v1[3]);
                    *(GAS pg8::u32x4*)(XR + off + bj * 128) = o; } }
    }
};
struct EpiGU {
    static constexpr bool PERM = true, AFTER_DRAIN = false;
    bf16_t* HID; const LAS float* rst;
    __device__ __forceinline__ void operator()(const pg8::f32x4 (&acc)[2][2][4][2], const pg8::Unit& u, int wr, int wc, int fr, int fq) const {
        const int row0 = u.pm * 256 + wr * 64 + fr, col0 = u.pn * 128 + wc * 32 + 8 * fq; const LAS float* rsp = rst + u.ui * 256 + wr * 64 + fr;
#pragma unroll
        for (int ai = 0; ai < 2; ++ai)
#pragma unroll
            for (int m = 0; m < 4; ++m) { float h[8]; const float rs = rsp[ai * 128 + m * 16];
#pragma unroll
                for (int n = 0; n < 2; ++n)
#pragma unroll
                    for (int i = 0; i < 4; ++i) { const float g = acc[ai][0][m][n][i] * rs, up = acc[ai][1][m][n][i] * rs; h[n * 4 + i] = g * __builtin_amdgcn_rcpf(1.0f + __expf(-g)) * up; }
                pg8::u32x4 w; w.x = pg8::cvt_pk_bf16(h[0], h[1]); w.y = pg8::cvt_pk_bf16(h[2], h[3]); w.z = pg8::cvt_pk_bf16(h[4], h[5]); w.w = pg8::cvt_pk_bf16(h[6], h[7]);
                *(GAS pg8::u32x4*)(HID + (size_t)(row0 + ai * 128 + m * 16) * DM + col0) = w; }
    }
};
struct EpiDown {
    static constexpr bool PERM = true, AFTER_DRAIN = false;
    bf16_t* YS; const LAS float* gl;
    __device__ __forceinline__ void operator()(const pg8::f32x4 (&acc)[2][2][4][2], const pg8::Unit& u, int wr, int wc, int fr, int fq) const {
        const int row0 = u.pm * 256 + wr * 64 + fr, col0 = u.pn * 256 + wc * 32 + 8 * fq;
#pragma unroll
        for (int ai = 0; ai < 2; ++ai)
#pragma unroll
            for (int m = 0; m < 4; ++m) { const int row = row0 + ai * 128 + m * 16; const float gt = gl[u.ui * 256 + wr * 64 + fr + ai * 128 + m * 16]; bf16_t* rowp = YS + (size_t)row * DM + col0;
#pragma unroll
                for (int bj = 0; bj < 2; ++bj) { const pg8::f32x4 v0 = acc[ai][bj][m][0] * gt, v1 = acc[ai][bj][m][1] * gt; pg8::u32x4 w;
                    w.x = pg8::cvt_pk_bf16(v0[0], v0[1]); w.y = pg8::cvt_pk_bf16(v0[2], v0[3]); w.z = pg8::cvt_pk_bf16(v1[0], v1[1]); w.w = pg8::cvt_pk_bf16(v1[2], v1[3]);
                    *(GAS pg8::u32x4*)(rowp + bj * 128) = w; } }
    }
};
template <class T> __device__ __forceinline__ T* uni(T* p) { const unsigned long long v = (unsigned long long)p;
    const unsigned lo = __builtin_amdgcn_readfirstlane((unsigned)v), hi = __builtin_amdgcn_readfirstlane((unsigned)(v >> 32)); return (T*)(((unsigned long long)hi << 32) | lo); }
struct EpiLora {
    static constexpr bool PERM = true, AFTER_DRAIN = false;
    bf16_t* AP; bf16_t* GA; const float* w0; const float* a0;
    __device__ __forceinline__ void operator()(const pg8::f32x4 (&acc)[2][2][4][2], const pg8::Unit& u, int wr, int wc, int fr, int fq) const {
        const int row0 = u.pm * 256 + wr * 64 + fr, col0 = wc * 32 + 8 * fq; const int kind = u.pn < 2 ? 0 : (u.pn < 4 ? 1 : 2);
        bf16_t* base = kind == 0 ? AP + 768 + u.pn * 256 : (kind == 1 ? AP + 1280 + (u.pn - 2) * 256 : GA); const int ldd = kind == 2 ? 256 : 1792;
        const float* bias = kind == 0 ? w0 + u.pn * 256 : a0 + (u.pn - 2) * 256; const float sc = kind == 0 ? 0.6065306597f : 1.0f;
        pg8::f32x4 bv[2][2];
#pragma unroll
        for (int bj = 0; bj < 2; ++bj)
#pragma unroll
            for (int n = 0; n < 2; ++n) bv[bj][n] = kind == 2 ? (pg8::f32x4){0.f, 0.f, 0.f, 0.f} : *(const GAS pg8::f32x4*)(bias + col0 + bj * 128 + 4 * n);
#pragma unroll
        for (int ai = 0; ai < 2; ++ai)
#pragma unroll
            for (int m = 0; m < 4; ++m) { bf16_t* rowp = base + (size_t)(row0 + ai * 128 + m * 16) * ldd + col0;
#pragma unroll
                for (int bj = 0; bj < 2; ++bj) { pg8::f32x4 v0 = acc[ai][bj][m][0] + bv[bj][0], v1 = acc[ai][bj][m][1] + bv[bj][1];
                    if (kind != 2) {
#pragma unroll
                        for (int i = 0; i < 4; ++i) { v0[i] = sc * __builtin_amdgcn_rcpf(1.0f + __expf(-v0[i])); v1[i] = sc * __builtin_amdgcn_rcpf(1.0f + __expf(-v1[i])); } }
                    pg8::u32x4 w; w.x = pg8::cvt_pk_bf16(v0[0], v0[1]); w.y = pg8::cvt_pk_bf16(v0[2], v0[3]); w.z = pg8::cvt_pk_bf16(v1[0], v1[1]); w.w = pg8::cvt_pk_bf16(v1[2], v1[3]);
                    *(GAS pg8::u32x4*)(rowp + bj * 128) = w; __builtin_amdgcn_sched_barrier(0); } }
    }
};
__device__ __forceinline__ void gemm_lora_mfma(PRef P, int l, Ctx& C) {
    int G_ = C.G, bx_ = fresh_bx(); asm volatile("" : "+s"(G_), "+s"(bx_));
    int K_ = 256; asm volatile("" : "+s"(K_));
    pg8::Gemm g{uni(P.LT), uni(P.WL_T), MROWS, 1280, K_}; pg8::StaticOrder S; S.init(MROWS, 1280, G_, bx_);
    EpiLora E{uni(P.AP), uni(P.GA), uni(P.w0) + l * 512, uni(P.a0) + l * 512};
    pg8::gemm_phase<EpiLora, pg8::StaticOrder, true, true>(C.lds + RING_OFF, g, S, E);
}
__device__ __forceinline__ void gemm_in_mfma(PRef P, Ctx& C) {
    int G_ = C.G, bx_ = fresh_bx(); asm volatile("" : "+s"(G_), "+s"(bx_));
    pg8::Gemm g{uni(P.XN), uni(P.WIN_T), MROWS, 3840, DM}; pg8::StaticOrder S; S.init(MROWS, 3840, G_, bx_);
    EpiIn E{uni(P.PA), uni(P.PB), uni(P.PC), uni(P.PD)};
    pg8::gemm_phase<EpiIn, pg8::StaticOrder, true, true>(C.lds + RING_OFF, g, S, E);
}
template <bool SRC_BF16> __device__ __forceinline__ void gemm_out_mfma(PRef P, const void* xsrc, Ctx& C) {
    int G_ = C.G, bx_ = fresh_bx(); asm volatile("" : "+s"(G_), "+s"(bx_));
    pg8::Gemm g{uni(P.MIX), uni(P.WOUT_T), MROWS, DM, MIXW}; pg8::StaticOrder S; S.init(MROWS, DM, G_, bx_);
    EpiOut<SRC_BF16> E{uni((const char*)xsrc), uni(P.XR)};
    pg8::gemm_phase<EpiOut<SRC_BF16>, pg8::StaticOrder, true, true>(C.lds + RING_OFF, g, S, E);
}
__device__ __forceinline__ void gemm_gu_mfma(PRef P, Ctx& C) {
    int G_ = C.G, bx_ = fresh_bx(); asm volatile("" : "+s"(G_), "+s"(bx_));
    pg8::Gemm g{uni(P.XR), uni(P.WGU_T), NPAIR, 2048, DM}; pg8::StaticOrder S; S.init(NPAIR, 2048, G_, bx_);
    S.rows_per_group = NB * CAP / 256; S.group_stride = (size_t)2048 * 1024 * 2;
    LAS unsigned* gt = (LAS unsigned*)(C.lds + RING_OFF + RING_BYTES);
    LAS float* rt = (LAS float*)(gt + 8 * 256);
    { const int tid = fresh_tid(); const GAS int* IDX = (const GAS int*)uni(P.IDX); const GAS float* RS = (const GAS float*)uni(P.RS); unsigned val[8]; float rv[8];
#pragma unroll
      for (int ui = 0; ui < 8; ++ui) { pg8::Unit u; const bool ok = S.next(ui, u); val[ui] = (ok && tid < 256) ? (unsigned)IDX[(size_t)u.pm * 256 + tid] : 0u; }
#pragma unroll
      for (int ui = 0; ui < 8; ++ui) rv[ui] = tid < 256 ? RS[val[ui]] : 0.f;
      if (tid < 256) {
#pragma unroll
          for (int ui = 0; ui < 8; ++ui) { gt[ui * 256 + tid] = val[ui] * (unsigned)(DM * 2); rt[ui * 256 + tid] = rv[ui]; } }
      __syncthreads(); }
    EpiGU E{uni(P.HID), rt};
    pg8::gemm_phase<EpiGU, pg8::StaticOrder, true, true, true>(C.lds + RING_OFF, g, S, E, gt);
}
__device__ __forceinline__ void gemm_down_mfma(PRef P, Ctx& C) {
    int G_ = C.G, bx_ = fresh_bx(); asm volatile("" : "+s"(G_), "+s"(bx_));
    pg8::Gemm g{uni(P.HID), uni(P.WD_T), NPAIR, DM, DM}; pg8::StaticOrder S; S.init(NPAIR, DM, G_, bx_);
    S.rows_per_group = NB * CAP / 256; S.group_stride = (size_t)1024 * 1024 * 2;
    LAS float* gl = (LAS float*)(C.lds + RING_OFF + RING_BYTES);
    { const int tid = fresh_tid(); const GAS float* GATE = (const GAS float*)uni(P.GATE); float gv[4];
#pragma unroll
      for (int ui = 0; ui < 4; ++ui) { pg8::Unit u; const bool ok = S.next(ui, u); gv[ui] = (ok && tid < 256) ? GATE[(size_t)u.pm * 256 + tid] : 0.f; }
      if (tid < 256) {
#pragma unroll
          for (int ui = 0; ui < 4; ++ui) gl[ui * 256 + tid] = gv[ui]; }
      __syncthreads(); }
    EpiDown E{uni(P.YS), gl};
    pg8::gemm_phase<EpiDown, pg8::StaticOrder, true, true>(C.lds + RING_OFF, g, S, E);
}
__device__ __forceinline__ void conv_item(const float* W, int ldw, int col0, int nvalid, int k0, bf16_t* WT, int K, int n0, LAS float* scr, int lane, int kd = -1) {
    if (kd < 0) kd = k0;
    const int c = lane & 31;
    { const GAS float* Wg = (const GAS float*)W + (size_t)k0 * ldw + col0 + (c < nvalid ? c : 0); float r[32];
#pragma unroll
      for (int i = 0; i < 32; ++i) r[i] = Wg[(size_t)(2 * i + (lane >> 5)) * ldw];
#pragma unroll
      for (int i = 0; i < 32; ++i) scr[(2 * i + (lane >> 5)) * 33 + c] = c < nvalid ? r[i] : 0.f; }
    LDS_WAIT(); asm volatile("" ::: "memory");
    const int c8 = lane & 7;
#pragma unroll
    for (int j = 0; j < 4; ++j) { const int n = (lane >> 3) + 8 * j; const LAS float* s = scr + (8 * c8) * 33 + n;
        v4u o; o.x = pk2(s[0 * 33], s[1 * 33]); o.y = pk2(s[2 * 33], s[3 * 33]); o.z = pk2(s[4 * 33], s[5 * 33]); o.w = pk2(s[6 * 33], s[7 * 33]);
        *(GAS v4u*)(WT + (size_t)(n0 + n) * K + kd + 8 * c8) = o; }
    LDS_WAIT(); asm volatile("" ::: "memory");
}
__device__ __forceinline__ void conv_item64(const float* __restrict__ W, int ldw, int col0, int k0, bf16_t* __restrict__ WT, int K, int n0, LAS float* scr, int lane) {
#pragma unroll
    for (int i = 0; i < 64; ++i) scr[i * 65 + lane] = ((const GAS float*)W)[(size_t)(k0 + i) * ldw + col0 + lane];
    LDS_WAIT(); asm volatile("" ::: "memory");
    const int c8 = lane & 7;
#pragma unroll
    for (int j = 0; j < 8; ++j) { const int n = (lane >> 3) + 8 * j; const LAS float* sp = scr + (8 * c8) * 65 + n;
        v4u o; o.x = pk2(sp[0 * 65], sp[1 * 65]); o.y = pk2(sp[2 * 65], sp[3 * 65]); o.z = pk2(sp[4 * 65], sp[5 * 65]); o.w = pk2(sp[6 * 65], sp[7 * 65]);
        *(GAS v4u*)(WT + (size_t)(n0 + n) * K + k0 + 8 * c8) = o; }
    LDS_WAIT(); asm volatile("" ::: "memory");
}
__device__ __forceinline__ void convert_small(PRef P, int l, Ctx& C) {
    const int lane = fresh_tid() & 63;
    LAS float* scr = (LAS float*)(C.lds + RING_OFF + C.wave * 16384);
    const int gw = fresh_bx() * 8 + C.wave, NGW = C.G * 8;
    const float* win = P.w_in + (size_t)l * DM * PIN; const float* wout = P.w_out + (size_t)l * MIXW * DM;
    for (int it = gw; it < 16 * 120 + 18 * 32 + 160; it += NGW) {
        if (it < 16 * 120) { const int kb = it / 120, nb = it % 120; const int n0 = nb * 32; int col0, nv;
            if (nb < 80) { col0 = n0; nv = 32; } else if (nb < 116) { col0 = n0 + 16; nv = 32; } else if (nb == 116) { col0 = 2560; nv = 16; } else { col0 = 0; nv = 0; }
            conv_item(win, PIN, col0, nv, kb * 64, P.WIN_T, DM, n0, scr, lane); }
        else if (it < 16 * 120 + 18 * 32) { const int r = it - 16 * 120; const int kb = r / 32, nb = r % 32; conv_item(wout, DM, nb * 32, 32, kb * 64, P.WOUT_T, MIXW, nb * 32, scr, lane); }
        else {
            const int r = it - 16 * 120 - 18 * 32; const int nb = r >> 2, kb = r & 3, n0 = nb * 32; const float* src = P.w_up; int c0 = 0, nv = 0, ks = 0;
            if (n0 < 512) { if (kb == 0) { src = P.w_up + ((size_t)l * 2 + n0 / 256) * 64 * 256; c0 = n0 % 256; nv = 32; } }
            else if (n0 < 1024) { if (kb == 1) { src = P.a_up + ((size_t)l * 2 + (n0 - 512) / 256) * 64 * 256; c0 = (n0 - 512) % 256; nv = 32; } }
            else if (kb >= 2) { src = P.g_up + (size_t)l * 128 * 256; c0 = n0 - 1024; nv = 32; ks = (kb - 2) * 64; }
            conv_item(src, 256, c0, nv, ks, P.WL_T, 256, n0, scr, lane, kb * 64); }
    }
}
__device__ __forceinline__ void convert_moe(PRef P, int l, Ctx& C, int wi = -1, int nw = 0) {
    const int lane = fresh_tid() & 63;
    LAS float* scr = (LAS float*)(C.lds + RING_OFF + C.wave * 16896);
    const int gw = (wi >= 0 ? wi : fresh_bx()) * 8 + C.wave, NGW = (nw ? nw : C.G) * 8;
    constexpr int NIT = NEXP * 16 * 32 + NEXP * 16 * 16;
    const GAS float* wg_ = (const GAS float*)P.w_gate + (size_t)l * NEXP * DM * DM; const GAS float* wu_ = (const GAS float*)P.w_upx + (size_t)l * NEXP * DM * DM; const GAS float* wd_ = (const GAS float*)P.w_down + (size_t)l * NEXP * DM * DM;
    GAS bf16_t* WGU = (GAS bf16_t*)P.WGU_T; GAS bf16_t* WD = (GAS bf16_t*)P.WD_T;
    float r[64]; const GAS float* src = wg_; GAS bf16_t* dst = WGU; int gk = -1;
    const GAS float* gf = (const GAS float*)P.norm_ffn_g + l * DM;
    auto decode = [&](int it, const GAS float*& sp, GAS bf16_t*& dp) {
        if (it < NEXP * 16 * 32) { const int e = it / 512, rr = it % 512, kb = rr % 16, nb = rr / 16; const int n0 = nb * 64, j = n0 / 256, half = (n0 / 128) & 1, c0 = 128 * j + (n0 & 127);
            sp = (half ? wu_ : wg_) + (size_t)e * DM * DM + (size_t)(kb * 64) * DM + c0 + lane; dp = WGU + (size_t)e * 2048 * 1024 + (size_t)n0 * DM + kb * 64; gk = kb * 64; }
        else { const int q = it - NEXP * 16 * 32; const int e = q / 256, rr = q % 256, kb = rr % 16, nb = rr / 16;
            sp = wd_ + (size_t)e * DM * DM + (size_t)(kb * 64) * DM + nb * 64 + lane; dp = WD + (size_t)e * 1024 * 1024 + (size_t)(nb * 64) * DM + kb * 64; gk = -1; } };
    if (gw < NIT) { decode(gw, src, dst);
#pragma unroll
        for (int i = 0; i < 64; ++i) r[i] = __builtin_nontemporal_load(src + (size_t)i * DM); }
    for (int it = gw; it < NIT; it += NGW) {
#pragma unroll
        for (int i = 0; i < 64; ++i) scr[i * 65 + lane] = r[i];
        GAS bf16_t* cdst = dst; const int c8 = lane & 7; f32x4 g0 = {1.f, 1.f, 1.f, 1.f}, g1 = g0;
        if (gk >= 0) { g0 = *(const GAS f32x4*)(gf + gk + 8 * c8); g1 = *(const GAS f32x4*)(gf + gk + 8 * c8 + 4); }
        if (it + NGW < NIT) { decode(it + NGW, src, dst);
#pragma unroll
            for (int i = 0; i < 64; ++i) r[i] = __builtin_nontemporal_load(src + (size_t)i * DM); }
        LDS_WAIT(); asm volatile("" ::: "memory");
#pragma unroll
        for (int j = 0; j < 8; ++j) { const int n = (lane >> 3) + 8 * j; const LAS float* sp = scr + (8 * c8) * 65 + n;
            v4u o; o.x = pk2(sp[0 * 65] * g0.x, sp[1 * 65] * g0.y); o.y = pk2(sp[2 * 65] * g0.z, sp[3 * 65] * g0.w); o.z = pk2(sp[4 * 65] * g1.x, sp[5 * 65] * g1.y); o.w = pk2(sp[6 * 65] * g1.z, sp[7 * 65] * g1.w);
            *(GAS v4u*)(cdst + (size_t)n * DM + 8 * c8) = o; }
        LDS_WAIT(); asm volatile("" ::: "memory");
    }
}
namespace attn_body {
using bf16=unsigned short;
using bf16x8=__attribute__((ext_vector_type(8)))short;
using s16x4=__attribute__((ext_vector_type(4)))short;
using f32x16=__attribute__((ext_vector_type(16)))float;
using u32x4=__attribute__((ext_vector_type(4)))unsigned;
constexpr int BATCH=NB,NHEAD=4,SEQ=NS,D=64,QP=512,KP=512,OP=1152;
constexpr int NW=8,QBLK=32,QB=QBLK*NW,KVBLK=64,NQB=SEQ/QB;
constexpr int ATTN_UNIT_ROWS=QB;
__device__ __forceinline__ int crow(int r,int hi){return (r&3)+8*(r>>2)+4*hi;}
#define SBAR() __builtin_amdgcn_sched_barrier(0)
__device__ __forceinline__ void cmask(f32x16&p0,f32x16&p1,int jb,int qrel,int hi){
  const float NEG=-INFINITY; int kb=64*jb+4*hi;
  #pragma unroll
  for(int r=0;r<16;++r){int kv=kb+(r&3)+8*(r>>2); if(kv>qrel)p0[r]=NEG; if(kv+32>qrel)p1[r]=NEG;}
}

constexpr int NSLOT=3, SLOTB=8192;
constexpr int LDS_K=0, LDS_V=NSLOT*SLOTB, LDS_WS=2*NSLOT*SLOTB, LDS_OST=LDS_WS+NW*64*4, LDS_BYTES=LDS_OST+NW*4096;
constexpr float C2=0.125f*1.4426950408889634f;
__device__ __forceinline__ void glds16(const void*gsrc,unsigned lds_dst){unsigned keep;
  asm volatile("s_mov_b32 %0, m0\n\ts_mov_b32 m0, %2\n\ts_nop 0\n\tglobal_load_lds_dwordx4 %1, off\n\ts_mov_b32 m0, %0":"=&s"(keep):"v"(gsrc),"s"(lds_dst):"memory");}
__device__ __forceinline__ float max3f(float a,float b,float c){float r;asm("v_max3_f32 %0, %1, %2, %3":"=v"(r):"v"(a),"v"(b),"v"(c));return r;}
__device__ __forceinline__ float max2f(float a,float b){float r;asm("v_max_f32_e32 %0, %1, %2":"=v"(r):"v"(a),"v"(b));return r;}
__device__ __forceinline__ float fadd_s(float a,float b){float r;asm("v_add_f32_e32 %0, %1, %2":"=v"(r):"v"(a),"v"(b));return r;}
__device__ __forceinline__ float fsub_s(float a,float b){float r;asm("v_sub_f32_e32 %0, %1, %2":"=v"(r):"v"(a),"v"(b));return r;}
typedef float f32x2_t __attribute__((ext_vector_type(2))); typedef __bf16 bf16x2_t __attribute__((ext_vector_type(2)));
__device__ __forceinline__ unsigned cvtpk_s(float lo,float hi){f32x2_t v={lo,hi};bf16x2_t b=__builtin_convertvector(v,bf16x2_t);return __builtin_bit_cast(unsigned,b);}
#define WAIT_BAR(N) asm volatile("s_waitcnt vmcnt(" #N ") lgkmcnt(0)\n\ts_barrier":::"memory")

__device__ __forceinline__ void qkt(f32x16&p0,f32x16&p1,const char*Kslot,const bf16x8*qr,const f32x16&negm,int r32,int hi){
  const char*kb=Kslot+hi*1024+r32*16;
  #pragma unroll
  for(int d0=0;d0<4;++d0){
    const bf16x8 b0=*reinterpret_cast<const bf16x8*>(kb+d0*2048);
    const bf16x8 b1=*reinterpret_cast<const bf16x8*>(kb+d0*2048+512);
    if(d0==0){p0=__builtin_amdgcn_mfma_f32_32x32x16_bf16(b0,qr[0],negm,0,0,0);p1=__builtin_amdgcn_mfma_f32_32x32x16_bf16(b1,qr[0],negm,0,0,0);}
    else{p0=__builtin_amdgcn_mfma_f32_32x32x16_bf16(b0,qr[d0],p0,0,0,0);p1=__builtin_amdgcn_mfma_f32_32x32x16_bf16(b1,qr[d0],p1,0,0,0);}}
}
typedef __attribute__((address_space(3))) const char* lds_cptr;
typedef short v4i16_t __attribute__((ext_vector_type(4)));
__device__ __forceinline__ void kload8(bf16x8*kf,lds_cptr kp){
  kf[0]=*(const __attribute__((address_space(3))) bf16x8*)(kp);      kf[1]=*(const __attribute__((address_space(3))) bf16x8*)(kp+512);
  kf[2]=*(const __attribute__((address_space(3))) bf16x8*)(kp+2048); kf[3]=*(const __attribute__((address_space(3))) bf16x8*)(kp+2560);
  kf[4]=*(const __attribute__((address_space(3))) bf16x8*)(kp+4096); kf[5]=*(const __attribute__((address_space(3))) bf16x8*)(kp+4608);
  kf[6]=*(const __attribute__((address_space(3))) bf16x8*)(kp+6144); kf[7]=*(const __attribute__((address_space(3))) bf16x8*)(kp+6656);
}
__device__ __forceinline__ void kload2(bf16x8*kf,lds_cptr kp,int j){ kf[2*j]=*(const __attribute__((address_space(3))) bf16x8*)(kp+j*2048); kf[2*j+1]=*(const __attribute__((address_space(3))) bf16x8*)(kp+j*2048+512); }
__device__ __forceinline__ s16x4 vtr(lds_cptr p){ return __builtin_bit_cast(s16x4,__builtin_amdgcn_ds_read_tr16_b64_v4i16((__attribute__((address_space(3))) v4i16_t*)p)); }
__device__ __forceinline__ float rowmax(const f32x16&p0,const f32x16&p1){
  float a=max3f(p0[0],p0[1],p1[0]),b=max3f(p0[2],p0[3],p1[1]);a=max3f(a,p1[2],p1[3]);
  #pragma unroll
  for(int r=4;r<16;r+=4){a=max3f(a,p0[r],p0[r+1]);b=max3f(b,p0[r+2],p0[r+3]);a=max3f(a,p1[r],p1[r+1]);b=max3f(b,p1[r+2],p1[r+3]);}
  const float m=max2f(a,b);
  auto rr=__builtin_amdgcn_permlane32_swap(__float_as_uint(m),__float_as_uint(m),false,false);
  return max2f(__uint_as_float(rr[0]),__uint_as_float(rr[1]));
}
__device__ __forceinline__ void pv(f32x16*o,int vb,bf16x8 pa0,bf16x8 pa1,bf16x8 pa2,bf16x8 pa3){
  #pragma unroll
  for(int d0=0;d0<2;++d0){s16x4 lo[4],hi[4];
    #pragma unroll
    for(int ks=0;ks<4;++ks){
      asm volatile("ds_read_b64_tr_b16 %0,%1 offset:%c2":"=&v"(lo[ks]):"v"(vb),"i"(d0*4096+ks*1024):"memory");
      asm volatile("ds_read_b64_tr_b16 %0,%1 offset:%c2":"=&v"(hi[ks]):"v"(vb),"i"(d0*4096+ks*1024+512):"memory");}
    asm volatile("s_waitcnt lgkmcnt(0)":::"memory");SBAR();
    #define PK(k) (bf16x8){lo[k][0],lo[k][1],lo[k][2],lo[k][3],hi[k][0],hi[k][1],hi[k][2],hi[k][3]}
    o[d0]=__builtin_amdgcn_mfma_f32_32x32x16_bf16(pa0,PK(0),o[d0],0,0,0);
    o[d0]=__builtin_amdgcn_mfma_f32_32x32x16_bf16(pa1,PK(1),o[d0],0,0,0);
    o[d0]=__builtin_amdgcn_mfma_f32_32x32x16_bf16(pa2,PK(2),o[d0],0,0,0);
    o[d0]=__builtin_amdgcn_mfma_f32_32x32x16_bf16(pa3,PK(3),o[d0],0,0,0);
    #undef PK
  }
}

#ifndef ATTN_STORE16
#define ATTN_STORE16(p,v) (*(u32x4*)(p)=(v))
#endif
template<int THRL> __device__ __forceinline__ void attn_unit(int b,int qb,const bf16*Q,const bf16*__restrict__ K,const bf16*__restrict__ V,bf16*O,char*shm){
  const int tid=fresh_tid(),lane=tid&63,r32=lane&31,hi=lane>>5; const int wid=__builtin_amdgcn_readfirstlane(tid>>6);
  const long rowbase=(long)b*SEQ; const int q0=qb*QB;
  const bf16*Qw=Q+(rowbase+q0+wid*QBLK)*QP;
  const bf16*Kh=K+rowbase*KP,*Vh=V+rowbase*KP;
  const unsigned lds0=(unsigned)(uintptr_t)shm;
  float*wsf=(float*)(shm+LDS_WS)+wid*64;
  const bf16*ksrc=Kh+(long)lane*KP+wid*8;
  const bf16*vsrc=Vh+(long)(16*(wid&3)+(lane>>2))*KP+(wid>>2)*32+(lane&3)*8;
  const unsigned kdst=lds0+LDS_K+wid*1024, vdst=lds0+LDS_V+wid*1024;
  #define DMA_K(t,slot) glds16(ksrc+(long)(t)*KVBLK*KP,(unsigned)__builtin_amdgcn_readfirstlane(kdst+(slot)))
  #define DMA_V(t,slot) glds16(vsrc+(long)(t)*KVBLK*KP,(unsigned)__builtin_amdgcn_readfirstlane(vdst+(slot)))
  const int vb0=(int)(lds0+LDS_V)+((lane>>4)&1)*32+(lane&3)*8+(4*hi+((lane&15)>>2))*64;
  const char*Kbase=shm+LDS_K; bf16x8 kf[8];
  const lds_cptr shm3=(lds_cptr)shm; const lds_cptr kp0=shm3+LDS_K+hi*1024+r32*16; const lds_cptr vp0=shm3+LDS_V+((lane>>4)&1)*32+(lane&3)*8+(4*hi+((lane&15)>>2))*64;
  constexpr int NT=SEQ/KVBLK;
  DMA_K(0,0);DMA_V(0,0);DMA_K(1,SLOTB);
  bf16x8 qr[4];
  #pragma unroll
  for(int d0=0;d0<4;++d0)qr[d0]=*reinterpret_cast<const bf16x8*>(&Qw[(long)r32*QP+d0*16+hi*8]);
  float mhat=0.f,l_reg=0.f;f32x16 o[2];o[0]=f32x16{};o[1]=f32x16{};f32x16 negm=f32x16{};asm volatile("":"+v"(negm));
  #define CMASK(P0,P1,t) do{}while(0)
  bool resc=false;
  #define START(P0,P1) do{ const float rm=rowmax(P0,P1); resc=false; \
    { const float dl=rm; mhat=fadd_s(mhat,dl); \
      _Pragma("unroll") for(int r=0;r<16;++r){P0[r]=fsub_s(P0[r],dl);P1[r]=fsub_s(P1[r],dl);} \
      _Pragma("unroll") for(int r=0;r<16;++r)negm[r]=-mhat; asm volatile("":"+v"(negm)); } \
    _Pragma("unroll") for(int r=0;r<16;++r)P0[r]=__builtin_amdgcn_exp2f(P0[r]); }while(0)
  #define RESC() do{ if(resc){ asm volatile("s_waitcnt lgkmcnt(0)":::"memory"); \
      _Pragma("unroll") for(int d_=0;d_<2;++d_) _Pragma("unroll") for(int r=0;r<16;++r)o[d_][r]*=wsf[crow(r,hi)]; } }while(0)
  f32x16 pA0,pA1,pB0,pB1;
  int sl_prev=0,sl_cur=0,sl_next=SLOTB;
  #define ROT() do{sl_prev=sl_cur;sl_cur=sl_next;sl_next=(sl_next==(NSLOT-1)*SLOTB)?0:sl_next+SLOTB;}while(0)
  DMA_K(2,2*SLOTB);
  WAIT_BAR(3);
  qkt(pA0,pA1,Kbase,qr,negm,r32,hi);asm volatile("s_nop 15\n\ts_nop 7":"+v"(pA0),"+v"(pA1));CMASK(pA0,pA1,0);
  START(pA0,pA1);
  _Pragma("unroll") for(int r=0;r<16;++r)pA1[r]=__builtin_amdgcn_exp2f(pA1[r]);
  WAIT_BAR(0);
  DMA_K(3,0);DMA_V(1,SLOTB);
  ROT();
  kload8(kf,kp0+sl_cur);
  WAIT_BAR(2);
  s16x4 vlo[8],vhi[8]; u32x4 pw0,pw1,pw2,pw3;
  #define PKW(P,B) cvtpk_s(P[B],P[B+1])
  #define PAF(k) __builtin_bit_cast(bf16x8,pw##k)
  #define VFR(i) (bf16x8){vlo[i][0],vlo[i][1],vlo[i][2],vlo[i][3],vhi[i][0],vhi[i][1],vhi[i][2],vhi[i][3]}
  #define PIN(x) asm volatile("":"+v"(x))
  #define MX3(a,b,c) __builtin_fmaxf(__builtin_fmaxf((a),(b)),(c))
  #define GAPA(MF,A0,A1,A2,A3,W0,W1,PW) do{ MF; sacc+=A0; sacc+=A1; sacc+=A2; sacc+=A3; PIN(sacc); W0; W1; PIN(PW); SBAR(); }while(0)
  #define EX(v) __builtin_amdgcn_exp2f(v)
  #define GAPB(MF,X,B) do{ MF; X[B]=EX(X[B]); X[B+1]=EX(X[B+1]); X[B+2]=EX(X[B+2]); X[B+3]=EX(X[B+3]); PIN(X); SBAR(); }while(0)
  #define VRD(i) do{ vlo[i]=vtr(vp_+(((i)>>2)*4096+((i)&3)*1024)); vhi[i]=vtr(vp_+(((i)>>2)*4096+((i)&3)*1024+512)); }while(0)
  #define KRD(G,j) do{ if(G){ kload2(kf,kp0+sl_next,j); SBAR(); } }while(0)
  #define STEP(C0,C1,P0,P1,t,GK,GV,GL) do{ SBAR(); \
    const lds_cptr vp_=vp0+sl_prev; \
    VRD(0); SBAR(); float sacc=(P0[0]+P0[1]); \
    GAPA(C0=__builtin_amdgcn_mfma_f32_32x32x16_bf16(kf[0],qr[0],negm,0,0,0), P0[2],P0[3],P0[4],P0[5],     pw0[0]=PKW(P0,0), pw0[1]=PKW(P0,2), pw0); \
    VRD(4); SBAR(); GAPA(C1=__builtin_amdgcn_mfma_f32_32x32x16_bf16(kf[1],qr[0],negm,0,0,0), P0[6],P0[7],P0[8],P0[9],     pw0[2]=PKW(P0,4), pw0[3]=PKW(P0,6), pw0); \
    VRD(1); SBAR(); GAPA(C0=__builtin_amdgcn_mfma_f32_32x32x16_bf16(kf[2],qr[1],C0,0,0,0),   P0[10],P0[11],P0[12],P0[13], pw1[0]=PKW(P0,8), pw1[1]=PKW(P0,10), pw1); \
    VRD(5); SBAR(); GAPA(C1=__builtin_amdgcn_mfma_f32_32x32x16_bf16(kf[3],qr[1],C1,0,0,0),   P0[14],P0[15],P1[0],P1[1],   pw1[2]=PKW(P0,12),pw1[3]=PKW(P0,14), pw1); \
    VRD(2); SBAR(); GAPA(C0=__builtin_amdgcn_mfma_f32_32x32x16_bf16(kf[4],qr[2],C0,0,0,0),   P1[2],P1[3],P1[4],P1[5],     pw2[0]=PKW(P1,0), pw2[1]=PKW(P1,2), pw2); \
    VRD(6); SBAR(); GAPA(C1=__builtin_amdgcn_mfma_f32_32x32x16_bf16(kf[5],qr[2],C1,0,0,0),   P1[6],P1[7],P1[8],P1[9],     pw2[2]=PKW(P1,4), pw2[3]=PKW(P1,6), pw2); \
    VRD(3); SBAR(); GAPA(C0=__builtin_amdgcn_mfma_f32_32x32x16_bf16(kf[6],qr[3],C0,0,0,0),   P1[10],P1[11],P1[12],P1[13], pw3[0]=PKW(P1,8), pw3[1]=PKW(P1,10), pw3); \
    VRD(7); SBAR(); GAPA(C1=__builtin_amdgcn_mfma_f32_32x32x16_bf16(kf[7],qr[3],C1,0,0,0),   P1[14],P1[15],0.f,0.f,       pw3[2]=PKW(P1,12),pw3[3]=PKW(P1,14), pw3); \
    l_reg+=sacc; \
    if(GK){DMA_K((t)+3,sl_cur);} if(GV){DMA_V((t)+1,sl_next);} \
    CMASK(C0,C1,t); \
    { float a=MX3(C0[0],C0[1],C1[0]),b=MX3(C0[2],C0[3],C1[1]); a=MX3(a,C1[2],C1[3]); \
      _Pragma("unroll") for(int r=4;r<16;r+=4){a=MX3(a,C0[r],C0[r+1]);b=MX3(b,C0[r+2],C0[r+3]);a=MX3(a,C1[r],C1[r+1]);b=MX3(b,C1[r+2],C1[r+3]);} \
      float rm=__builtin_fmaxf(a,b); { auto rr=__builtin_amdgcn_permlane32_swap(__float_as_uint(rm),__float_as_uint(rm),false,false); rm=__builtin_fmaxf(__uint_as_float(rr[0]),__uint_as_float(rr[1])); } \
      resc=false; \
      if(__builtin_expect(__any(rm>(float)THRL),0)){ const float dl=__builtin_fmaxf(rm,0.f); mhat+=dl; \
        _Pragma("unroll") for(int r=0;r<16;++r){C0[r]-=dl;C1[r]-=dl;} \
        _Pragma("unroll") for(int r=0;r<16;++r)negm[r]=-mhat; asm volatile("":"+v"(negm)); \
        const float f=__builtin_amdgcn_exp2f(-dl); l_reg*=f; if(hi==0)wsf[r32]=f; resc=true; } } \
    SBAR(); \
    GAPB(o[0]=__builtin_amdgcn_mfma_f32_32x32x16_bf16(PAF(0),VFR(0),o[0],0,0,0), C0,0); \
    GAPB(o[1]=__builtin_amdgcn_mfma_f32_32x32x16_bf16(PAF(0),VFR(4),o[1],0,0,0), C0,4); \
    KRD(GL,0); GAPB(o[0]=__builtin_amdgcn_mfma_f32_32x32x16_bf16(PAF(1),VFR(1),o[0],0,0,0), C0,8); \
    KRD(GL,1); GAPB(o[1]=__builtin_amdgcn_mfma_f32_32x32x16_bf16(PAF(1),VFR(5),o[1],0,0,0), C0,12); \
    KRD(GL,2); GAPB(o[0]=__builtin_amdgcn_mfma_f32_32x32x16_bf16(PAF(2),VFR(2),o[0],0,0,0), C1,0); \
    KRD(GL,3); GAPB(o[1]=__builtin_amdgcn_mfma_f32_32x32x16_bf16(PAF(2),VFR(6),o[1],0,0,0), C1,4); \
    GAPB(o[0]=__builtin_amdgcn_mfma_f32_32x32x16_bf16(PAF(3),VFR(3),o[0],0,0,0), C1,8); \
    GAPB(o[1]=__builtin_amdgcn_mfma_f32_32x32x16_bf16(PAF(3),VFR(7),o[1],0,0,0), C1,12); \
    }while(0)
  int t=1;
  for(;t+5<NT;t+=2){
    STEP(pB0,pB1,pA0,pA1,t,true,true,true);     WAIT_BAR(2); RESC(); ROT();
    STEP(pA0,pA1,pB0,pB1,t+1,true,true,true);   WAIT_BAR(2); RESC(); ROT();
  }
  #define ENDW(tt) do{ if((tt)+3<NT){WAIT_BAR(2);} else if((tt)+2<NT){WAIT_BAR(1);} else {WAIT_BAR(0);} }while(0)
  for(;t+1<NT;t+=2){
    STEP(pB0,pB1,pA0,pA1,t,(t+3<NT),(t+1<NT),(t+1<NT));       ENDW(t);   RESC(); ROT();
    STEP(pA0,pA1,pB0,pB1,t+1,(t+4<NT),(t+2<NT),(t+2<NT));     ENDW(t+1); RESC(); ROT();
  }
  STEP(pB0,pB1,pA0,pA1,NT-1,false,false,false); RESC();
  { float sacc=pB0[0]+pB0[1]; _Pragma("unroll") for(int r=2;r<16;++r)sacc+=pB0[r]; _Pragma("unroll") for(int r=0;r<16;++r)sacc+=pB1[r]; l_reg+=sacc;
    pw0=(u32x4){PKW(pB0,0),PKW(pB0,2),PKW(pB0,4),PKW(pB0,6)};pw1=(u32x4){PKW(pB0,8),PKW(pB0,10),PKW(pB0,12),PKW(pB0,14)};pw2=(u32x4){PKW(pB1,0),PKW(pB1,2),PKW(pB1,4),PKW(pB1,6)};pw3=(u32x4){PKW(pB1,8),PKW(pB1,10),PKW(pB1,12),PKW(pB1,14)};
    SBAR(); pv(o,vb0+sl_cur,PAF(0),PAF(1),PAF(2),PAF(3)); }
  #undef PKW
  #undef PAF
  #undef VFR
  #undef PIN
  #undef MX3
  #undef GAPA
  #undef GAPB
  #undef EX
  #undef VRD
  #undef KRD
  #undef STEP
  #undef ENDW
  {auto rr=__builtin_amdgcn_permlane32_swap(__float_as_uint(l_reg),__float_as_uint(l_reg),false,false);l_reg=__uint_as_float(rr[0])+__uint_as_float(rr[1]);}
  if(hi==0)wsf[32+r32]=l_reg;asm volatile("s_waitcnt lgkmcnt(0)":::"memory");
  float rli[16];
  #pragma unroll
  for(int r=0;r<16;++r)rli[r]=__builtin_amdgcn_rcpf(wsf[32+crow(r,hi)]);
  bf16*Ow=O+(rowbase+q0+wid*QBLK)*OP;
  { bf16*stg=(bf16*)(shm+LDS_OST)+wid*2048;
    #pragma unroll
    for(int r=0;r<16;++r){const int orow=crow(r,hi);
      #pragma unroll
      for(int d0=0;d0<2;++d0)stg[orow*64+d0*32+r32]=f2bf_hw(o[d0][r]*rli[r]);}
    asm volatile("s_waitcnt lgkmcnt(0)":::"memory");
    #pragma unroll
    for(int i=0;i<4;++i){const int row=i*8+(lane>>3),ch=lane&7; const u32x4 v=*(const u32x4*)(stg+row*64+ch*8); ATTN_STORE16(Ow+(long)row*OP+ch*8,v);} }
  asm volatile("s_waitcnt lgkmcnt(0)\n\ts_barrier":::"memory");
  #undef DMA_K
  #undef DMA_V
  #undef CMASK
  #undef START
  #undef RESC
  #undef ROT
}
constexpr int ATTN_LDS_BYTES=LDS_BYTES;
#undef SBAR
#undef WAIT_BAR
}

__device__ __forceinline__ void ph_attnB_mfma(PRef P, Ctx& C, unsigned* ctr, volatile LAS int* tk) {
    const bf16_t* PB = uni(P.PB); bf16_t* MIX = uni(P.MIX); const int tid = fresh_tid();
    for (;;) { if (tid == 0) *tk = (int)__hip_atomic_fetch_add(ctr, 1u, __ATOMIC_RELAXED, __HIP_MEMORY_SCOPE_AGENT);
        __syncthreads(); const int u = *tk; if (u >= NB * 4 * (NS / 256)) break;
        const int qb = u % (NS / 256), h = (u / (NS / 256)) & 3, b = u / (4 * (NS / 256)); const int g = h >> 1;
        attn_body::attn_unit<8>(b, qb, PB + h * 64, PB + 256 + g * 64, PB + 384 + g * 64, MIX + 256 + h * 64, C.lds_g); }
}
typedef unsigned u32x4g __attribute__((ext_vector_type(4)));
__device__ __forceinline__ void unpack8(const u32x4g w, float (&f)[8]) { f[0] = __uint_as_float(w.x << 16); f[1] = __uint_as_float(w.x & 0xffff0000u); f[2] = __uint_as_float(w.y << 16); f[3] = __uint_as_float(w.y & 0xffff0000u);
    f[4] = __uint_as_float(w.z << 16); f[5] = __uint_as_float(w.z & 0xffff0000u); f[6] = __uint_as_float(w.w << 16); f[7] = __uint_as_float(w.w & 0xffff0000u); }
__device__ __forceinline__ u32x4g pack8(const float (&f)[8]) { u32x4g w; w.x = pk2(f[0], f[1]); w.y = pk2(f[2], f[3]); w.z = pk2(f[4], f[5]); w.w = pk2(f[6], f[7]); return w; }
__device__ __forceinline__ float oct_sum(float v) { v += __shfl_xor(v, 1); v += __shfl_xor(v, 2); v += __shfl_xor(v, 4); return v; }
__device__ __forceinline__ void ph_prepA_shift_v(PRef P, int l, long gid, long gs) {
    const float* __restrict__ mp = P.mu_prev + l * 1024; const float* __restrict__ mn = P.mu_next + l * 1024; const bf16_t* __restrict__ PA = P.PA; bf16_t* __restrict__ AP = P.AP; bf16_t* __restrict__ LT = P.LT;
#pragma unroll 4
    for (long i = gid; i < (long)MROWS * 32; i += gs) {
        const long t = i >> 5; const int c0 = 768 + (int)(i & 31) * 8; const int s = (int)(t % NS);
        float f[8], pv[8], nx[8], o[8];
        unpack8(*(const u32x4g*)(PA + t * 1024 + c0), f);
        if (s > 0) unpack8(*(const u32x4g*)(PA + (t - 1) * 1024 + c0), pv); else {
#pragma unroll
            for (int j = 0; j < 8; ++j) pv[j] = 0.f; }
        if (s < NS - 1) unpack8(*(const u32x4g*)(PA + (t + 1) * 1024 + c0), nx); else {
#pragma unroll
            for (int j = 0; j < 8; ++j) nx[j] = 0.f; }
        const bool is_tanh = c0 < 832, is_id = c0 >= 832 && c0 < 896; const float am = is_tanh ? -2.0f : -1.0f;
#pragma unroll
        for (int j = 0; j < 8; ++j) { const float v = f[j] + mp[c0 + j] * (pv[j] - f[j]) + mn[c0 + j] * (nx[j] - f[j]);
            const float sg = __builtin_amdgcn_rcpf(1.0f + __expf(am * v)); o[j] = is_id ? v : (is_tanh ? 2.0f * sg - 1.0f : sg); }
        *(u32x4g*)(LT + t * 256 + (c0 - 768)) = pack8(o);
    }
}
__device__ __forceinline__ void ph_lora_fused(PRef P, int l, Ctx& C) {
    typedef short bf16x8l __attribute__((ext_vector_type(8))); typedef float f32x4l __attribute__((ext_vector_type(4)));
    const int tid = fresh_tid(), lane = tid & 63, wave = C.wave, x = lane & 15, q = lane >> 4;
    constexpr int LDL = 280;
    LAS bf16_t* Ls = (LAS bf16_t*)C.lds;
    const GAS bf16_t* PA = (const GAS bf16_t*)uni(P.PA); GAS bf16_t* AP = (GAS bf16_t*)uni(P.AP); GAS bf16_t* GA = (GAS bf16_t*)uni(P.GA); const GAS bf16_t* WL = (const GAS bf16_t*)uni(P.WL_T);
    const GAS float* mp = (const GAS float*)P.mu_prev + l * 1024 + 768; const GAS float* mn = (const GAS float*)P.mu_next + l * 1024 + 768;
    const GAS float* w0 = (const GAS float*)P.w0 + l * 512; const GAS float* a0 = (const GAS float*)P.a0 + l * 512;
    bf16x8l wf[2][2][4]; f32x4l bs[2][2];
    auto ldpair = [&](const int pi) __attribute__((always_inline)) { const int sl = pi & 1; const int pr = pi < 2 ? wave * 2 + pi : (pi < 4 ? 16 + wave * 2 + (pi - 2) : 32 + wave), n0 = pr * 32, kb = pi < 2 ? 0 : (pi < 4 ? 64 : 128), nks = pi < 4 ? 2 : 4;
        const int nrow = n0 + 8 * (x >> 2) + (x & 3);
#pragma unroll
        for (int ks = 0; ks < nks; ++ks) { wf[sl][0][ks] = *(const GAS bf16x8l*)(WL + (size_t)nrow * 256 + kb + ks * 32 + q * 8); wf[sl][1][ks] = *(const GAS bf16x8l*)(WL + (size_t)(nrow + 4) * 256 + kb + ks * 32 + q * 8); }
        const f32x4l z4 = {0.f, 0.f, 0.f, 0.f};
        bs[sl][0] = pi < 2 ? *(const GAS f32x4l*)(w0 + n0 + 8 * q) : (pi < 4 ? *(const GAS f32x4l*)(a0 + n0 - 512 + 8 * q) : z4);
        bs[sl][1] = pi < 2 ? *(const GAS f32x4l*)(w0 + n0 + 8 * q + 4) : (pi < 4 ? *(const GAS f32x4l*)(a0 + n0 - 512 + 8 * q + 4) : z4); };
    const int c0h = (tid & 31) * 8;
    const f32x4l p0 = *(const GAS f32x4l*)(mp + c0h), p1 = *(const GAS f32x4l*)(mp + c0h + 4), q0 = *(const GAS f32x4l*)(mn + c0h), q1 = *(const GAS f32x4l*)(mn + c0h + 4);
    for (int rb = fresh_bx(); rb < MROWS / 128; rb += C.G) { const long t0 = (long)rb * 128;
        ldpair(0);
#pragma unroll
        for (int hb = 0; hb < 2; ++hb) { u32x4g rf[4], rp[4], rn[4];
#pragma unroll
            for (int u = 0; u < 4; ++u) { const int it = tid + (hb * 4 + u) * 512; const int r = it >> 5, c8 = it & 31; const long t = t0 + r; const int s = (int)(t % NS); const u32x4g z = {0u, 0u, 0u, 0u};
                const GAS u32x4g* p = (const GAS u32x4g*)(PA + t * 1024 + 768 + c8 * 8); rf[u] = p[0]; rp[u] = s > 0 ? p[-128] : z; rn[u] = s < NS - 1 ? p[128] : z; }
#pragma unroll
            for (int u = 0; u < 4; ++u) { const int it = tid + (hb * 4 + u) * 512; const int r = it >> 5, c8 = it & 31, c0 = c8 * 8; float f[8], pv[8], nx[8], o[8]; unpack8(rf[u], f); unpack8(rp[u], pv); unpack8(rn[u], nx);
                const bool is_tanh = c0 < 64, is_id = c0 >= 64 && c0 < 128; const float am = is_tanh ? -2.0f : -1.0f;
#pragma unroll
                for (int j = 0; j < 8; ++j) { const float v = f[j] + (j < 4 ? p0[j & 3] : p1[j & 3]) * (pv[j] - f[j]) + (j < 4 ? q0[j & 3] : q1[j & 3]) * (nx[j] - f[j]);
                    const float sg = __builtin_amdgcn_rcpf(1.0f + __expf(am * v)); o[j] = is_id ? v : (is_tanh ? 2.0f * sg - 1.0f : sg); }
                *(LAS u32x4g*)(Ls + r * LDL + c0) = pack8(o); } }
        __syncthreads();
#pragma unroll
        for (int pi = 0; pi < 5; ++pi) { const int pr = pi < 2 ? wave * 2 + pi : (pi < 4 ? 16 + wave * 2 + (pi - 2) : 32 + wave), n0 = pr * 32, kb = pi < 2 ? 0 : (pi < 4 ? 64 : 128), nks = pi < 4 ? 2 : 4;
            GAS bf16_t* ob = pi < 4 ? AP + 768 + n0 + 8 * q : GA + (n0 - 1024) + 8 * q; const int ldd = pi < 4 ? 1792 : 256; const float sc = pi < 2 ? 0.6065306597f : 1.0f;
            if (pi + 1 < 5) ldpair(pi + 1);
#pragma unroll 2
            for (int rt = 0; rt < 8; ++rt) { f32x4l a0v = {0.f, 0.f, 0.f, 0.f}, a1v = {0.f, 0.f, 0.f, 0.f};
#pragma unroll
                for (int ks = 0; ks < nks; ++ks) { const bf16x8l af = *(const LAS bf16x8l*)(Ls + (rt * 16 + x) * LDL + kb + ks * 32 + q * 8);
                    a0v = __builtin_amdgcn_mfma_f32_16x16x32_bf16(wf[pi & 1][0][ks], af, a0v, 0, 0, 0); a1v = __builtin_amdgcn_mfma_f32_16x16x32_bf16(wf[pi & 1][1][ks], af, a1v, 0, 0, 0); }
                f32x4l v0 = a0v + bs[pi & 1][0], v1 = a1v + bs[pi & 1][1];
                if (pi < 4) {
#pragma unroll
                    for (int i = 0; i < 4; ++i) { v0[i] = sc * __builtin_amdgcn_rcpf(1.0f + __expf(-v0[i])); v1[i] = sc * __builtin_amdgcn_rcpf(1.0f + __expf(-v1[i])); } }
                u32x4g w; w.x = pk2(v0[0], v0[1]); w.y = pk2(v0[2], v0[3]); w.z = pk2(v1[0], v1[1]); w.w = pk2(v1[2], v1[3]);
                *(GAS u32x4g*)(ob + (size_t)(t0 + rt * 16 + x) * ldd) = w; } }
        __syncthreads();
    }
}
__device__ __forceinline__ void ph_prepC_conv_v(PRef P, int l, long gid, long gs) {
    const float* __restrict__ cw = P.conv + (size_t)l * 5 * 768; const bf16_t* __restrict__ PC = P.PC; bf16_t* __restrict__ CP = P.CP;
#pragma unroll 2
    for (long i = gid; i < (long)MROWS * 96; i += gs) {
        const long t = i / 96; const int cg = (int)(i % 96), c0 = cg * 8; const int s = (int)(t % NS);
        float a[8];
#pragma unroll
        for (int j = 0; j < 8; ++j) a[j] = 0.f;
#pragma unroll
        for (int q = 0; q < 5; ++q) { const int sq = s + q - 2;
            if (sq >= 0 && sq < NS) { float x[8]; unpack8(*(const u32x4g*)(PC + (t + q - 2) * 1024 + c0), x);
#pragma unroll
                for (int j = 0; j < 8; ++j) a[j] += x[j] * cw[q * 768 + c0 + j]; } }
        float ss = 0.f;
#pragma unroll
        for (int j = 0; j < 8; ++j) { a[j] = siluf_(a[j]); ss += a[j] * a[j]; }
        ss = oct_sum(ss);
        float sc = 1.0f;
        if (cg < 64) sc = 1.0f / sqrtf(ss + 1e-12f);
        if (cg < 32) sc *= 0.125f;
#pragma unroll
        for (int j = 0; j < 8; ++j) a[j] *= sc;
        *(u32x4g*)(CP + t * 768 + c0) = pack8(a);
    }
}
__device__ __forceinline__ void ph_fixA_v(PRef P, int l, long gid, long gs) {
    const float* lw = P.ln_w + l * 256; const float* lb = P.ln_b + l * 256; const bf16_t* __restrict__ YA = P.YA; const bf16_t* __restrict__ PA = P.PA; const float* __restrict__ mp = P.mu_prev + l * 1024; const float* __restrict__ mn = P.mu_next + l * 1024; const bf16_t* __restrict__ GA = P.GA; const float* __restrict__ BON = P.RN; bf16_t* __restrict__ MIX = P.MIX;
#pragma unroll 4
    for (long i = gid; i < (long)MROWS * 32; i += gs) {
        const long t = i >> 5; const int c0 = (int)(i & 31) * 8, h = c0 >> 6;
        float y0[8], y1[8], v[8], g[8], y[8];
        unpack8(__builtin_nontemporal_load((const u32x4g*)(YA + t * 256 + c0)), y0); unpack8(__builtin_nontemporal_load((const u32x4g*)(YA + ((size_t)MROWS + t) * 256 + c0)), y1);
        { const int s = (int)(t % NS); float f[8], pv[8], nx[8]; unpack8(*(const u32x4g*)(PA + t * 1024 + 512 + c0), f);
          if (s > 0) unpack8(*(const u32x4g*)(PA + (t - 1) * 1024 + 512 + c0), pv); else {
#pragma unroll
              for (int j = 0; j < 8; ++j) pv[j] = 0.f; }
          if (s < NS - 1) unpack8(*(const u32x4g*)(PA + (t + 1) * 1024 + 512 + c0), nx); else {
#pragma unroll
              for (int j = 0; j < 8; ++j) nx[j] = 0.f; }
#pragma unroll
          for (int j = 0; j < 8; ++j) v[j] = f[j] + mp[512 + c0 + j] * (pv[j] - f[j]) + mn[512 + c0 + j] * (nx[j] - f[j]); }
        unpack8(*(const u32x4g*)(GA + t * 256 + c0), g);
        float sm = 0.f;
#pragma unroll
        for (int j = 0; j < 8; ++j) { y[j] = y0[j] + y1[j]; sm += y[j]; }
        const float mean = oct_sum(sm) * (1.0f / 64); float var = 0.f;
#pragma unroll
        for (int j = 0; j < 8; ++j) { const float d = y[j] - mean; var += d * d; }
        const float rstd = 1.0f / sqrtf(oct_sum(var) * (1.0f / 64) + 64e-5f);
        const float bo = BON[t * 4 + h] + BON[((size_t)MROWS + t) * 4 + h];
#pragma unroll
        for (int j = 0; j < 8; ++j) y[j] = ((y[j] - mean) * rstd * lw[c0 + j] + lb[c0 + j] + bo * v[j]) * g[j];
        *(u32x4g*)(MIX + t * MIXW + c0) = pack8(y);
    }
}
__device__ __forceinline__ void ph_fixC_v(PRef P, int l, long gid, long gs) {
    const float* __restrict__ ng = P.gdn_norm_g + l * 64; const bf16_t* __restrict__ OC = P.OC; const bf16_t* __restrict__ PC = P.PC; bf16_t* __restrict__ MIX = P.MIX;
#pragma unroll 4
    for (long i = gid; i < (long)MROWS * 32; i += gs) {
        const long t = i >> 5; const int c0 = (int)(i & 31) * 8;
        float o0[8], o1[8], z[8], o[8];
        unpack8(__builtin_nontemporal_load((const u32x4g*)(OC + t * 256 + c0)), o0); unpack8(__builtin_nontemporal_load((const u32x4g*)(OC + ((size_t)MROWS + t) * 256 + c0)), o1); unpack8(*(const u32x4g*)(PC + t * 1024 + 768 + c0), z);
        float ss = 0.f;
#pragma unroll
        for (int j = 0; j < 8; ++j) { o[j] = o0[j] + o1[j]; ss += o[j] * o[j]; }
        const float rs = 1.0f / sqrtf(oct_sum(ss) * (1.0f / 64) + 1e-6f);
#pragma unroll
        for (int j = 0; j < 8; ++j) o[j] = o[j] * rs * ng[(c0 & 63) + j] * (z[j] * __builtin_amdgcn_rcpf(1.0f + __expf(-z[j])));
        *(u32x4g*)(MIX + t * MIXW + 512 + c0) = pack8(o);
    }
}
__device__ __forceinline__ void ph_fixD_v(PRef P, long gid, long gs) {
    const float* ML = P.ML; bf16_t* MIX = P.MIX;
    for (long i = gid; i < (long)MROWS * 48; i += gs) {
        const long t = i / 48; const int cg = (int)(i % 48), hd = cg >> 3, br = hd >> 1, jh = hd & 1;
        float m[3], lv[3]; float mx = -1e30f;
#pragma unroll
        for (int b2 = 0; b2 < 3; ++b2) { m[b2] = ML[t * 12 + (b2 * 2 + jh) * 2]; lv[b2] = ML[t * 12 + (b2 * 2 + jh) * 2 + 1]; mx = fmaxf(mx, m[b2]); }
        float sum = 0.f, mine = 0.f;
#pragma unroll
        for (int b2 = 0; b2 < 3; ++b2) { const float dn = lv[b2] * __expf(m[b2] - mx); sum += dn; mine = b2 == br ? dn : mine; }
        const float w = mine / sum; float x[8];
        u32x4g* p = (u32x4g*)(MIX + t * MIXW + 768 + cg * 8); unpack8(*p, x);
#pragma unroll
        for (int j = 0; j < 8; ++j) x[j] *= w;
        *p = pack8(x);
    }
}
__device__ __forceinline__ void ph_topk_lds(PRef P, Ctx& C) {
    const int tid = fresh_tid(), lane = tid & 63, wave = C.wave; LAS unsigned long long* keys = (LAS unsigned long long*)C.lds;
    LAS int* sel = (LAS int*)(C.lds + NS * 8);
    LAS int* wc = sel + NS / 2;
    const GAS float* AFF = (const GAS float*)uni(P.AFF); GAS int* IDX = (GAS int*)uni(P.IDX); GAS float* GATE = (GAS float*)uni(P.GATE); GAS int* SLOT = (GAS int*)uni(P.SLOT);
    const GAS bf16_t* HN = (const GAS bf16_t*)uni(P.XN); GAS bf16_t* XS = (GAS bf16_t*)uni(P.XS);
    for (int it = fresh_bx(); it < NB * NEXP * 2; it += C.G) { const int half = it & 1, be = it >> 1, e = be % NEXP, b = be / NEXP;
        const GAS float* af = AFF + (size_t)b * NS * NEXP + e;
        unsigned long long k[NS / 512];
#pragma unroll
        for (int j = 0; j < NS / 512; ++j) { const int s = tid + 512 * j; k[j] = ((unsigned long long)__float_as_uint(af[(size_t)s * NEXP]) << 32) | (unsigned)(0xFFFFFFFFu - (unsigned)s); keys[s] = k[j]; }
        unsigned long long T = 0ull; int round = 0, cntT = NS;
#pragma unroll 1
        for (int bit = 61; bit >= 0 && cntT != CAP; --bit) { if (bit == 31) { T |= 0xFFFFF000ull; bit = 11; }
            const unsigned long long cand = T | (1ull << bit); int c = 0;
#pragma unroll
            for (int j = 0; j < NS / 512; ++j) c += __popcll(__ballot(k[j] >= cand));
            if (lane == 0) wc[(round & 1) * 8 + wave] = c;
            __syncthreads();
            int tot = 0;
#pragma unroll
            for (int w = 0; w < 8; ++w) tot += wc[(round & 1) * 8 + w];
            if (tot >= CAP) { T = cand; cntT = tot; }
            ++round; }
        const int s0 = half * (NS / 2) + 4 * tid; unsigned long long mk[4]; int mysel = 0;
#pragma unroll
        for (int j = 0; j < 4; ++j) { mk[j] = keys[s0 + j]; mysel += mk[j] >= T ? 1 : 0; }
        int pre = mysel;
#pragma unroll
        for (int o = 1; o < 64; o <<= 1) { const int t = __shfl_up(pre, o); if (lane >= o) pre += t; }
        __syncthreads();
        if (lane == 63) wc[wave] = pre;
        __syncthreads();
        int woff = 0, htot = 0;
#pragma unroll
        for (int w = 0; w < 8; ++w) { const int t = wc[w]; htot += t; woff += w < wave ? t : 0; }
        const int hbase = half ? CAP - htot : 0;
        int local = woff + pre - mysel;
#pragma unroll
        for (int j = 0; j < 4; ++j) { const int s = s0 + j; const long t = (long)b * NS + s;
            if (mk[j] >= T) { const int slot = hbase + local; const long p = ((long)e * NB + b) * CAP + slot; IDX[p] = (int)t; GATE[p] = __uint_as_float((unsigned)(mk[j] >> 32)); SLOT[t * NEXP + e] = slot;
                sel[local] = (s << 10) | slot; ++local; }
            else SLOT[t * NEXP + e] = -1; }
        __syncthreads();
    }
}
template <int CTRL> __device__ __forceinline__ float dppf(float x) { return __builtin_bit_cast(float, __builtin_amdgcn_mov_dpp(__builtin_bit_cast(int, x), CTRL, 0xf, 0xf, true)); }
constexpr int DPP_XOR1 = 0xB1, DPP_XOR2 = 0x4E, DPP_ROR4 = 0x124, DPP_ROR8 = 0x128;
__device__ __forceinline__ float xrow_sum(float x) {
    auto s = __builtin_amdgcn_permlane16_swap(__float_as_uint(x), __float_as_uint(x), false, false); x = __uint_as_float(s[0]) + __uint_as_float(s[1]);
    auto t = __builtin_amdgcn_permlane32_swap(__float_as_uint(x), __float_as_uint(x), false, false); return __uint_as_float(t[0]) + __uint_as_float(t[1]); }
__device__ __forceinline__ float xrow_max(float x) {
    auto s = __builtin_amdgcn_permlane16_swap(__float_as_uint(x), __float_as_uint(x), false, false); x = fmaxf(__uint_as_float(s[0]), __uint_as_float(s[1]));
    auto t = __builtin_amdgcn_permlane32_swap(__float_as_uint(x), __float_as_uint(x), false, false); return fmaxf(__uint_as_float(t[0]), __uint_as_float(t[1])); }
__device__ __forceinline__ float wave_sum(float v) {
    v += dppf<DPP_XOR1>(v); v += dppf<DPP_XOR2>(v); v += dppf<DPP_ROR4>(v); v += dppf<DPP_ROR8>(v); return xrow_sum(v); }
__device__ __forceinline__ void ph_norm_rows_w(const float* x, const float* g, bf16_t* XN, Ctx& C) {
    const int lane = fresh_tid() & 63;
    const int gw = fresh_bx() * 8 + C.wave, NGW = C.G * 8;
    for (int row = gw; row < MROWS; row += NGW) {
        const GAS f32x4* xr = (const GAS f32x4*)(x + (size_t)row * DM) + lane; f32x4 v[4]; float ss = 0.f;
#pragma unroll
        for (int j = 0; j < 4; ++j) { v[j] = xr[64 * j]; ss += (v[j].x * v[j].x + v[j].y * v[j].y) + (v[j].z * v[j].z + v[j].w * v[j].w); }
        const float rs = 1.0f / sqrtf(wave_sum(ss) * (1.0f / DM) + 1e-6f);
        GAS unsigned long long* o8 = (GAS unsigned long long*)(XN + (size_t)row * DM) + lane;
#pragma unroll
        for (int j = 0; j < 4; ++j) { const f32x4 gg = ((const GAS f32x4*)g)[lane + 64 * j];
            o8[64 * j] = (unsigned long long)pk2(v[j].x * rs * gg.x, v[j].y * rs * gg.y) | ((unsigned long long)pk2(v[j].z * rs * gg.z, v[j].w * rs * gg.w) << 32); }
    }
}
__device__ __forceinline__ void ph_router_mfma(PRef P, int l, Ctx& C) {
    typedef short bf16x8r __attribute__((ext_vector_type(8))); typedef float f32x4r __attribute__((ext_vector_type(4)));
    const int tid = fresh_tid(), lane = tid & 63, x = lane & 15, q = lane >> 4;
    const int gw = fresh_bx() * 8 + C.wave, NGW = C.G * 8;
    const GAS float* g = (const GAS float*)(P.norm_ffn_g + l * DM); const GAS float* rw = (const GAS float*)(P.router_w + (size_t)l * DM * NEXP); const GAS float* rb = (const GAS float*)(P.router_b + l * NEXP);
    const GAS bf16_t* xin = (const GAS bf16_t*)P.XR; GAS float* RS = (GAS float*)P.RS; GAS float* AFF = (GAS float*)P.AFF;
    LAS bf16_t* Wt = (LAS bf16_t*)C.lds;
#pragma unroll
    for (int it_ = 0; it_ < DM * NEXP / 512; ++it_) { const int idx = tid + it_ * 512; const int c = idx >> 4, e = idx & 15; const float w = rw[idx] * g[c]; const bf16_t hi = f2bf_hw(w); const bf16_t lo = f2bf_hw(w - __uint_as_float((unsigned)hi << 16));
        const int ks = c >> 5, k = c & 31; Wt[((ks * 2 + 0) * 16 + e) * 32 + k] = hi; Wt[((ks * 2 + 1) * 16 + e) * 32 + k] = lo; }
    __syncthreads();
    for (int blk = gw; blk < MROWS / 16; blk += NGW) {
        const size_t row = (size_t)blk * 16 + x; const GAS bf16x8r* xp = (const GAS bf16x8r*)(xin + row * DM + 8 * q);
        bf16x8r xf[32];
#pragma unroll
        for (int ks = 0; ks < 32; ++ks) xf[ks] = xp[ks * 4];
        f32x4r acc = {0.f, 0.f, 0.f, 0.f}, sq = {0.f, 0.f, 0.f, 0.f};
#pragma unroll
        for (int ks = 0; ks < 32; ++ks) { const LAS bf16x8r* wp = (const LAS bf16x8r*)(Wt + ((ks * 2) * 16 + x) * 32 + q * 8);
            const bf16x8r whi = wp[0], wlo = wp[64];
            acc = __builtin_amdgcn_mfma_f32_16x16x32_bf16(whi, xf[ks], acc, 0, 0, 0); acc = __builtin_amdgcn_mfma_f32_16x16x32_bf16(wlo, xf[ks], acc, 0, 0, 0);
            sq = __builtin_amdgcn_mfma_f32_16x16x32_bf16(xf[ks], xf[ks], sq, 0, 0, 0);
            if (ks & 1) __builtin_amdgcn_sched_barrier(0); }
        float dv = (x & 3) == 0 ? sq[0] : ((x & 3) == 1 ? sq[1] : ((x & 3) == 2 ? sq[2] : sq[3])); dv = q == (x >> 2) ? dv : 0.f;
        const float rs = 1.0f / sqrtf(xrow_sum(dv) * (1.0f / DM) + 1e-6f);
        const f32x4r rb4 = *(const GAS f32x4r*)(rb + 4 * q); f32x4r lg; float mx = -1e30f;
#pragma unroll
        for (int i = 0; i < 4; ++i) { lg[i] = acc[i] * rs + rb4[i]; mx = fmaxf(mx, lg[i]); }
        mx = xrow_max(mx); float sum = 0.f;
#pragma unroll
        for (int i = 0; i < 4; ++i) { lg[i] = __expf(lg[i] - mx); sum += lg[i]; }
        sum = xrow_sum(sum); const float inv = 1.0f / sum;
        *(GAS f32x4r*)(AFF + row * NEXP + 4 * q) = lg * inv;
        if (q == 0) RS[row] = rs;
    }
}
__device__ __forceinline__ void ph_router_w(PRef P, int l, Ctx& C) {
    const int tid = fresh_tid(), lane = tid & 63;
    const int gw = fresh_bx() * 8 + C.wave, NGW = C.G * 8;
    const float* g = P.norm_ffn_g + l * DM; const float* rw = P.router_w + (size_t)l * DM * NEXP; const float* rb = P.router_b + l * NEXP;
    const bf16_t* xin = P.XR; bf16_t* HN = P.XN; GAS float* AFF = (GAS float*)P.AFF;
    LAS float* T = (LAS float*)C.lds;
    for (int idx = tid; idx < DM * NEXP / 4; idx += 512) { const int c = idx >> 2, e4 = idx & 3; const int j = c >> 8, ln = (c & 255) >> 2, i = c & 3;
        *(LAS f32x4*)(T + ((j * 4 + i) * 64 + ln) * 20 + e4 * 4) = *(const GAS f32x4*)(rw + (size_t)c * NEXP + e4 * 4); }
    __syncthreads();
    unsigned long long nx[4];
    if (gw < MROWS) { const GAS unsigned long long* xr = (const GAS unsigned long long*)(xin + (size_t)gw * DM) + lane;
#pragma unroll
        for (int j = 0; j < 4; ++j) nx[j] = xr[64 * j]; }
    const float rbl = rb[lane >> 2];
    for (int row = gw; row < MROWS; row += NGW) {
        unsigned long long cw[4];
#pragma unroll
        for (int j = 0; j < 4; ++j) cw[j] = nx[j];
        if (row + NGW < MROWS) { const GAS unsigned long long* xr = (const GAS unsigned long long*)(xin + (size_t)(row + NGW) * DM) + lane;
#pragma unroll
            for (int j = 0; j < 4; ++j) nx[j] = xr[64 * j]; }
        f32x4 v[4]; float ss = 0.f;
#pragma unroll
        for (int j = 0; j < 4; ++j) { const unsigned lo = (unsigned)cw[j], hi = (unsigned)(cw[j] >> 32);
            v[j] = (f32x4){__uint_as_float(lo << 16), __uint_as_float(lo & 0xffff0000u), __uint_as_float(hi << 16), __uint_as_float(hi & 0xffff0000u)};
            ss += (v[j].x * v[j].x + v[j].y * v[j].y) + (v[j].z * v[j].z + v[j].w * v[j].w); }
        const float rs = 1.0f / sqrtf(wave_sum(ss) * (1.0f / DM) + 1e-6f);
        float lg[NEXP];
#pragma unroll
        for (int e = 0; e < NEXP; ++e) lg[e] = 0.f;
        GAS unsigned long long* o8 = (GAS unsigned long long*)(HN + (size_t)row * DM) + lane;
#pragma unroll
        for (int j = 0; j < 4; ++j) { const f32x4 gg = ((const GAS f32x4*)g)[lane + 64 * j]; v[j] = (f32x4){v[j].x * rs * gg.x, v[j].y * rs * gg.y, v[j].z * rs * gg.z, v[j].w * rs * gg.w};
            o8[64 * j] = (unsigned long long)pk2(v[j].x, v[j].y) | ((unsigned long long)pk2(v[j].z, v[j].w) << 32); }
        { const LAS f32x4* wr = (const LAS f32x4*)(T + lane * 20); f32x4 wb[2][4];
#pragma unroll
          for (int e4 = 0; e4 < 4; ++e4) wb[0][e4] = wr[e4];
#pragma unroll
          for (int gi = 0; gi < 16; ++gi) { const float xv = v[gi >> 2][gi & 3];
            if (gi + 1 < 16) {
#pragma unroll
                for (int e4 = 0; e4 < 4; ++e4) wb[(gi + 1) & 1][e4] = wr[(gi + 1) * 64 * 5 + e4]; }
#pragma unroll
            for (int e4 = 0; e4 < 4; ++e4) { const f32x4 w4 = wb[gi & 1][e4]; lg[e4 * 4] += xv * w4.x; lg[e4 * 4 + 1] += xv * w4.y; lg[e4 * 4 + 2] += xv * w4.z; lg[e4 * 4 + 3] += xv * w4.w; }
            __builtin_amdgcn_sched_barrier(0); } }
        float t8[8], t4[4], t2[2], lgt;
#pragma unroll
        for (int k = 0; k < 8; ++k) { auto sw = __builtin_amdgcn_permlane32_swap(__float_as_uint(lg[k]), __float_as_uint(lg[8 + k]), false, false); t8[k] = __uint_as_float(sw[0]) + __uint_as_float(sw[1]); }
#pragma unroll
        for (int k = 0; k < 4; ++k) { auto sw = __builtin_amdgcn_permlane16_swap(__float_as_uint(t8[k]), __float_as_uint(t8[4 + k]), false, false); t4[k] = __uint_as_float(sw[0]) + __uint_as_float(sw[1]); }
        { const bool up = (lane & 8) != 0;
#pragma unroll
          for (int k = 0; k < 2; ++k) { const float snd = up ? t4[k] : t4[2 + k], mine = up ? t4[2 + k] : t4[k]; t2[k] = mine + dppf<DPP_ROR8>(snd); } }
        { const bool up = (lane & 4) != 0; const float snd = up ? t2[0] : t2[1], mine = up ? t2[1] : t2[0]; lgt = mine + __shfl_xor(snd, 4); }
        lgt += dppf<DPP_XOR1>(lgt); lgt += dppf<DPP_XOR2>(lgt); lgt += rbl;
        float mx = fmaxf(lgt, dppf<DPP_ROR4>(lgt)); mx = fmaxf(mx, dppf<DPP_ROR8>(mx)); mx = xrow_max(mx);
        const float pe = __expf(lgt - mx); float sum = pe + dppf<DPP_ROR4>(pe); sum += dppf<DPP_ROR8>(sum); sum = xrow_sum(sum);
        if ((lane & 3) == 0) AFF[(size_t)row * NEXP + (lane >> 2)] = pe / sum;
    }
}
__device__ __forceinline__ void ph_combine_norm_w(PRef P, int l, Ctx& C) {
    const int lane = fresh_tid() & 63;
    const int gw = fresh_bx() * 8 + C.wave, NGW = C.G * 8;
    GAS float* out = (GAS float*)P.out; GAS bf16_t* XR = (GAS bf16_t*)P.XR; const GAS bf16_t* YS = (const GAS bf16_t*)P.YS; const GAS int* SLOT = (const GAS int*)P.SLOT; GAS bf16_t* XN = (GAS bf16_t*)P.XN;
    const float* __restrict__ g = l == 0 ? P.norm_mix_g + DM : P.norm_final_g;
    unsigned long long nx[2][4]; int nsl[2];
    if (gw * 2 < MROWS) {
#pragma unroll
        for (int r = 0; r < 2; ++r) { const GAS unsigned long long* xr = (const GAS unsigned long long*)(XR + (size_t)(gw * 2 + r) * DM) + lane;
#pragma unroll
            for (int j = 0; j < 4; ++j) nx[r][j] = xr[64 * j];
            nsl[r] = lane < NEXP ? SLOT[(size_t)(gw * 2 + r) * NEXP + lane] : -1; } }
    f32x4 ggc[4];
#pragma unroll
    for (int j = 0; j < 4; ++j) ggc[j] = ((const GAS f32x4*)g)[lane + 64 * j];
    for (int row0 = gw * 2; row0 < MROWS; row0 += NGW * 2) {
        f32x4 v[2][4]; int csl[2];
#pragma unroll
        for (int r = 0; r < 2; ++r) { csl[r] = nsl[r];
#pragma unroll
            for (int j = 0; j < 4; ++j) { const unsigned lo = (unsigned)nx[r][j], hi = (unsigned)(nx[r][j] >> 32);
                v[r][j] = (f32x4){__uint_as_float(lo << 16), __uint_as_float(lo & 0xffff0000u), __uint_as_float(hi << 16), __uint_as_float(hi & 0xffff0000u)}; } }
        if (row0 + NGW * 2 < MROWS) {
#pragma unroll
            for (int r = 0; r < 2; ++r) { const GAS unsigned long long* xr = (const GAS unsigned long long*)(XR + (size_t)(row0 + NGW * 2 + r) * DM) + lane;
#pragma unroll
                for (int j = 0; j < 4; ++j) nx[r][j] = xr[64 * j];
                nsl[r] = lane < NEXP ? SLOT[(size_t)(row0 + NGW * 2 + r) * NEXP + lane] : -1; } }
        const int b = row0 / NS;
        unsigned m[2];
#pragma unroll
        for (int r = 0; r < 2; ++r) m[r] = (unsigned)__ballot(csl[r] >= 0);
        while (m[0] | m[1]) {
            unsigned long long buf[2][2][4]; bool has[2][2];
#pragma unroll
            for (int r = 0; r < 2; ++r)
#pragma unroll
                for (int k = 0; k < 2; ++k) { has[r][k] = m[r] != 0u;
                    if (has[r][k]) { const int e = __builtin_ctz(m[r]); m[r] &= m[r] - 1u; const int sl = __builtin_amdgcn_readlane(csl[r], e);
                        const GAS unsigned long long* yr = (const GAS unsigned long long*)(YS + (((size_t)e * NB + b) * CAP + sl) * DM) + lane;
#pragma unroll
                        for (int j = 0; j < 4; ++j) buf[r][k][j] = __builtin_nontemporal_load(yr + 64 * j); } }
#pragma unroll
            for (int r = 0; r < 2; ++r)
#pragma unroll
                for (int k = 0; k < 2; ++k) if (has[r][k]) {
#pragma unroll
                    for (int j = 0; j < 4; ++j) { const unsigned lo = (unsigned)buf[r][k][j], hi = (unsigned)(buf[r][k][j] >> 32);
                        v[r][j].x += __uint_as_float(lo << 16); v[r][j].y += __uint_as_float(lo & 0xffff0000u); v[r][j].z += __uint_as_float(hi << 16); v[r][j].w += __uint_as_float(hi & 0xffff0000u); } }
        }
#pragma unroll
        for (int r = 0; r < 2; ++r) { float ss = 0.f;
#pragma unroll
            for (int j = 0; j < 4; ++j) ss += (v[r][j].x * v[r][j].x + v[r][j].y * v[r][j].y) + (v[r][j].z * v[r][j].z + v[r][j].w * v[r][j].w);
            const float rs = 1.0f / sqrtf(wave_sum(ss) * (1.0f / DM) + 1e-6f);
            if (l == 0) { GAS unsigned long long* x8 = (GAS unsigned long long*)(XR + (size_t)(row0 + r) * DM) + lane; GAS unsigned long long* o8 = (GAS unsigned long long*)(XN + (size_t)(row0 + r) * DM) + lane;
#pragma unroll
                for (int j = 0; j < 4; ++j) { x8[64 * j] = (unsigned long long)pk2(v[r][j].x, v[r][j].y) | ((unsigned long long)pk2(v[r][j].z, v[r][j].w) << 32); const f32x4 gg = ggc[j];
                    o8[64 * j] = (unsigned long long)pk2(v[r][j].x * rs * gg.x, v[r][j].y * rs * gg.y) | ((unsigned long long)pk2(v[r][j].z * rs * gg.z, v[r][j].w * rs * gg.w) << 32); } }
            else { GAS f32x4* xo = (GAS f32x4*)(out + (size_t)(row0 + r) * DM) + lane;
#pragma unroll
                for (int j = 0; j < 4; ++j) { const f32x4 gg = ggc[j]; const f32x4 o = {v[r][j].x * rs * gg.x, v[r][j].y * rs * gg.y, v[r][j].z * rs * gg.z, v[r][j].w * rs * gg.w}; xo[64 * j] = o; } } }
    }
}
namespace dwin {
typedef short bf16x8 __attribute__((ext_vector_type(8)));
typedef float f32x4 __attribute__((ext_vector_type(4)));
typedef unsigned u32x4 __attribute__((ext_vector_type(4)));
constexpr int LDK = 72, LDV = 264;
__device__ __forceinline__ int t5b(int rel) { const int n = rel < 0 ? -rel : rel; int v; if (n < 8) v = n; else { int lg = 8 + (int)(logf((float)n / 8.0f) / 4.852030263919617f * 8.0f); v = lg < 15 ? lg : 15; } return (rel > 0 ? 16 : 0) + v; }
__device__ __forceinline__ void attnD_mfma(PRef P, Ctx& C, unsigned* ctr, volatile LAS int* tk) {
    const int tid = fresh_tid(), lane = tid & 63, wave = C.wave, x = lane & 15, q = lane >> 4;
    LAS bf16_t* Qs = (LAS bf16_t*)C.lds; LAS bf16_t* Ks = Qs + 128 * LDK; LAS bf16_t* VT = Ks + 256 * LDK; LAS float* tab = (LAS float*)(VT + 64 * LDV);
    typedef GAS bf16_t gbf; typedef GAS u32x4 gu32x4;
    const gbf* PD = (const gbf*)uni(P.PD); gbf* MIX = (gbf*)uni(P.MIX); GAS float* ML = (GAS float*)uni(P.ML); const float* rb = uni(P.rel_bias);
    constexpr int NSU = NB * 6 * (NS / 128);
    struct SU { int b, hd, dil, L, rho, i0; };
    auto decode = [&](int su, SU& u) { const int ib_all = su % (NS / 128); u.hd = (su / (NS / 128)) % 6; u.b = su / (6 * (NS / 128)); const int br = u.hd >> 1; u.dil = br == 0 ? 1 : (br == 1 ? 4 : 16); u.L = NS / u.dil;
        u.rho = ib_all / (u.L / 128); u.i0 = (ib_all % (u.L / 128)) * 128; };
    u32x4 kv0[2], vv0[2], kv1[2], vv1[2], qv[2]; float tabv = 0.f;
    auto issue = [&](const SU& u) { const gbf* base = PD + ((size_t)u.b * NS + u.rho) * 1280 + u.hd * 64; const long rstep = (long)u.dil * 1280;
#pragma unroll
        for (int it_ = 0; it_ < 2; ++it_) { const int idx = tid + it_ * 512; const int w = (idx >> 3) * 2, part = idx & 7, ik = u.i0 - 64 + w;
            const u32x4 z = {0u, 0u, 0u, 0u}; kv0[it_] = z; vv0[it_] = z; kv1[it_] = z; vv1[it_] = z; const gbf* rp = base + (long)ik * rstep + part * 8;
            if (ik >= 0 && ik < u.L) { kv0[it_] = *(const gu32x4*)(rp + 384); vv0[it_] = *(const gu32x4*)(rp + 768); }
            if (ik + 1 >= 0 && ik + 1 < u.L) { kv1[it_] = *(const gu32x4*)(rp + rstep + 384); vv1[it_] = *(const gu32x4*)(rp + rstep + 768); }
            const int r = idx >> 3; qv[it_] = *(const gu32x4*)(base + (long)(u.i0 + r) * rstep + part * 8); }
        if (tid < 224) tabv = (tid >= 32 && tid <= 160) ? rb[t5b((tid - 96) * u.dil) * 6 + u.hd] * 1.4426950408889634f : -1e30f; };
    if (tid == 0) tk[0] = (int)__hip_atomic_fetch_add(ctr, 1u, __ATOMIC_RELAXED, __HIP_MEMORY_SCOPE_AGENT);
    __syncthreads();
    int su = tk[0], par = 0; SU cu; cu.b = cu.hd = cu.rho = cu.i0 = 0; cu.dil = 1; cu.L = NS;
    if (su < NSU) { decode(su, cu); issue(cu); }
    while (su < NSU) {
        const int hd = cu.hd, b = cu.b, dil = cu.dil, L = cu.L, rho = cu.rho, i0 = cu.i0;
#pragma unroll
        for (int it_ = 0; it_ < 2; ++it_) { const int idx = tid + it_ * 512; const int w = (idx >> 3) * 2, part = idx & 7;
            *(LAS u32x4*)(Ks + w * LDK + part * 8) = kv0[it_]; *(LAS u32x4*)(Ks + (w + 1) * LDK + part * 8) = kv1[it_];
            const int pos = (w & ~31) + 8 * ((w >> 2) & 3) + 4 * ((w >> 4) & 1) + (w & 3); const unsigned a[4] = {vv0[it_].x, vv0[it_].y, vv0[it_].z, vv0[it_].w}, c[4] = {vv1[it_].x, vv1[it_].y, vv1[it_].z, vv1[it_].w};
#pragma unroll
            for (int j = 0; j < 4; ++j) { *(LAS unsigned*)(VT + (part * 8 + 2 * j) * LDV + pos) = (a[j] & 0xffffu) | (c[j] << 16); *(LAS unsigned*)(VT + (part * 8 + 2 * j + 1) * LDV + pos) = (a[j] >> 16) | (c[j] & 0xffff0000u); }
            const int r = idx >> 3; *(LAS u32x4*)(Qs + r * LDK + part * 8) = qv[it_]; }
        if (tid < 224) tab[tid] = tabv;
        if (tid == 0) tk[par ^ 1] = (int)__hip_atomic_fetch_add(ctr, 1u, __ATOMIC_RELAXED, __HIP_MEMORY_SCOPE_AGENT);
        __syncthreads();
        const int sun = tk[par ^ 1];
        if (sun < NSU) { decode(sun, cu); issue(cu); }
        const int r0 = wave * 16, tstart = (r0 >> 4) & ~1, qw = 64 + r0 + x;
        f32x4 st[10];
        bf16x8 qa[2];
#pragma unroll
        for (int ks = 0; ks < 2; ++ks) qa[ks] = *(const LAS bf16x8*)(Qs + (r0 + x) * LDK + ks * 32 + q * 8);
#pragma unroll
        for (int t = 0; t < 10; ++t) { f32x4 acc = {0.f, 0.f, 0.f, 0.f};
#pragma unroll
            for (int ks = 0; ks < 2; ++ks) { const bf16x8 ka = *(const LAS bf16x8*)(Ks + ((tstart + t) * 16 + x) * LDK + ks * 32 + q * 8); acc = __builtin_amdgcn_mfma_f32_16x16x32_bf16(ka, qa[ks], acc, 0, 0, 0); }
            st[t] = acc; }
        float mx = -1e30f;
        { const int tb = 32 + 4 * q - x - 16 * (wave & 1);
          const LAS float* tp = tab + tb;
#pragma unroll
          for (int t = 0; t < 10; ++t)
#pragma unroll
            for (int i = 0; i < 4; ++i) st[t][i] = fmaf(st[t][i], 0.125f * 1.4426950408889634f, tp[16 * t + i]);
          if (i0 == 0 || i0 + 128 == L) {
#pragma unroll
            for (int t = 0; t < 10; ++t)
#pragma unroll
              for (int i = 0; i < 4; ++i) { const int ik = i0 - 64 + 16 * (tstart + t) + 4 * q + i; st[t][i] = (ik >= 0 && ik < L) ? st[t][i] : -1e30f; } }
#pragma unroll
          for (int t = 0; t < 10; ++t)
#pragma unroll
            for (int i = 0; i < 4; ++i) mx = fmaxf(mx, st[t][i]); }
        mx = fmaxf(mx, __shfl_xor(mx, 16)); mx = fmaxf(mx, __shfl_xor(mx, 32));
        float ls = 0.f;
#pragma unroll
        for (int t = 0; t < 10; ++t)
#pragma unroll
            for (int i = 0; i < 4; ++i) { const float p = exp2f(st[t][i] - mx); st[t][i] = p; ls += p; }
        ls += __shfl_xor(ls, 16); ls += __shfl_xor(ls, 32);
        f32x4 o[4];
#pragma unroll
        for (int n = 0; n < 4; ++n) o[n] = (f32x4){0.f, 0.f, 0.f, 0.f};
#pragma unroll
        for (int s5 = 0; s5 < 5; ++s5) { bf16x8 pa;
            { const unsigned w0 = pk2(st[2 * s5][0], st[2 * s5][1]), w1 = pk2(st[2 * s5][2], st[2 * s5][3]);
              const unsigned w2 = pk2(st[2 * s5 + 1][0], st[2 * s5 + 1][1]), w3 = pk2(st[2 * s5 + 1][2], st[2 * s5 + 1][3]);
              const u32x4 pw = {w0, w1, w2, w3}; pa = __builtin_bit_cast(bf16x8, pw); }
#pragma unroll
            for (int n = 0; n < 4; ++n) { const bf16x8 vb = *(const LAS bf16x8*)(VT + (16 * n + x) * LDV + 32 * ((tstart >> 1) + s5) + 8 * q); o[n] = __builtin_amdgcn_mfma_f32_16x16x32_bf16(vb, pa, o[n], 0, 0, 0); } }
        { const float inv = 1.0f / ls; const size_t tq = (size_t)b * NS + rho + (size_t)dil * (i0 + r0 + x);
#pragma unroll
          for (int n = 0; n < 4; ++n) *(GAS unsigned long long*)(MIX + tq * MIXW + 768 + hd * 64 + 16 * n + 4 * q) = (unsigned long long)pk2(o[n][0] * inv, o[n][1] * inv) | ((unsigned long long)pk2(o[n][2] * inv, o[n][3] * inv) << 32); }
        if (q == 0) { const size_t tq = (size_t)b * NS + rho + (size_t)dil * (i0 + r0 + x); ML[tq * 12 + hd * 2] = mx * 0.6931471805599453f; ML[tq * 12 + hd * 2 + 1] = ls; }
        __syncthreads();
        su = sun; par ^= 1;
    }
}
}

namespace scan {
typedef short bf16x8 __attribute__((ext_vector_type(8)));
typedef float f32x4 __attribute__((ext_vector_type(4)));
typedef unsigned u32x4 __attribute__((ext_vector_type(4)));
typedef GAS bf16_t gbf;
typedef GAS float gfl; typedef GAS u32x4 gu32x4; typedef GAS unsigned long long gu64; typedef GAS bf16x8 gbf16x8;
constexpr int NCHT = NS / 64, SPLIT_A = NCHT / 2, SPLIT_C = NCHT / 2, PSLOT = NCHT / 2;
constexpr int LDH = 72, LDF = 68, MAT = 64 * LDH;

__device__ __forceinline__ f32x4 mm_tile(const LAS bf16_t* A, const LAS bf16_t* Bt, int tm, int tn, int lane, f32x4 acc) {
    const int r = lane & 15, q = lane >> 4;
#pragma unroll
    for (int ks = 0; ks < 2; ++ks) {
        const bf16x8 a = *(const LAS bf16x8*)(A + (tm * 16 + r) * LDH + ks * 32 + q * 8);
        const bf16x8 b = *(const LAS bf16x8*)(Bt + (tn * 16 + r) * LDH + ks * 32 + q * 8);
        acc = __builtin_amdgcn_mfma_f32_16x16x32_bf16(a, b, acc, 0, 0, 0);
    }
    __builtin_amdgcn_sched_barrier(0);
    return acc;
}
__device__ __forceinline__ float bfl(unsigned w) { return __uint_as_float(w << 16); }
__device__ __forceinline__ float bfh(unsigned w) { return __uint_as_float(w & 0xffff0000u); }
__device__ __forceinline__ unsigned pk(float lo, float hi) { return pk2(lo, hi); }
__device__ __forceinline__ float ldsbf(const LAS bf16_t* p) { return __uint_as_float(((unsigned)*p) << 16); }
__device__ __forceinline__ void st4bf(LAS bf16_t* p, f32x4 v) { *(LAS unsigned long long*)p = (unsigned long long)pk(v[0], v[1]) | ((unsigned long long)pk(v[2], v[3]) << 32); }
__device__ __forceinline__ f32x4 ld4bf(const LAS bf16_t* p) { const unsigned long long w = *(const LAS unsigned long long*)p; const unsigned lo = (unsigned)w, hi = (unsigned)(w >> 32); return (f32x4){bfl(lo), bfh(lo), bfl(hi), bfh(hi)}; }
struct Frag { bf16x8 f[2]; };
__device__ __forceinline__ Frag ldfrag(const LAS bf16_t* M, int tile, int lane) { Frag r; const LAS bf16_t* p = M + (tile * 16 + (lane & 15)) * LDH + (lane >> 4) * 8;
    r.f[0] = *(const LAS bf16x8*)p; r.f[1] = *(const LAS bf16x8*)(p + 32); return r; }
__device__ __forceinline__ f32x4 fmm(const Frag& x, const Frag& y, f32x4 acc) { acc = __builtin_amdgcn_mfma_f32_16x16x32_bf16(x.f[0], y.f[0], acc, 0, 0, 0); return __builtin_amdgcn_mfma_f32_16x16x32_bf16(x.f[1], y.f[1], acc, 0, 0, 0); }
__device__ __forceinline__ f32x4 mm_flip(const LAS bf16_t* Y, const LAS bf16_t* X, int tr, int tc, int lane, f32x4 acc) { return mm_tile(X, Y, tc, tr, lane, acc); }

constexpr int LDD = 20, LDT = 32;
__device__ __forceinline__ void diag_inverse(const LAS float* Ld, LAS bf16_t* Tb, int lane) {
    const int c = lane & 31; float x[16]; unsigned dep = 0u;
#pragma unroll
    for (int i = 0; i < 16; ++i) {
        const LAS float* Lr = (const LAS float*)((const LAS char*)Ld + dep) + i * LDD;
        float a = c == i ? 1.0f : 0.f;
#pragma unroll
        for (int j4 = 0; j4 * 4 < i; ++j4) { const f32x4 l4 = *(const LAS f32x4*)(Lr + 4 * j4);
#pragma unroll
            for (int e = 0; e < 4; ++e) if (4 * j4 + e < i) a -= l4[e] * x[4 * j4 + e]; }
        x[i] = a;
        asm volatile("" : "+v"(dep) : "v"(a));
    }
    if (lane < 32) {
#pragma unroll
        for (int i = 0; i < 16; ++i) Tb[i * LDT + c] = c < 16 ? f2bf_hw(x[i]) : (bf16_t)0;
    }
}
template <class RhsF> __device__ __forceinline__ void solve_blocked(const LAS bf16_t* Lb, const LAS bf16_t* Tb, LAS bf16_t* XT, LAS bf16_t* RTw, RhsF rhs, int wave, int lane) {
    const int x = lane & 15, q = lane >> 4; LAS bf16_t* xrow = XT + (wave * 16 + x) * LDH;
#pragma unroll
    for (int a = 0; a < 4; ++a) *(LAS unsigned long long*)(xrow + 16 * a + 4 * q) = 0ull;
    *(LAS unsigned long long*)(RTw + x * LDT + 16 + 4 * q) = 0ull;
#pragma unroll
    for (int b = 0; b < 4; ++b) {
        f32x4 acc = {0.f, 0.f, 0.f, 0.f};
        if (b > 0) acc = mm_flip(XT, Lb, wave, b, lane, acc);
        f32x4 r;
#pragma unroll
        for (int i = 0; i < 4; ++i) r[i] = rhs(16 * b + 4 * q + i, wave * 16 + x) - acc[i];
        st4bf(RTw + x * LDT + 4 * q, r);
        const bf16x8 ta = *(const LAS bf16x8*)(Tb + b * 16 * LDT + x * LDT + q * 8), rb = *(const LAS bf16x8*)(RTw + x * LDT + q * 8);
        const f32x4 z4 = {0.f, 0.f, 0.f, 0.f};
        const f32x4 xo = __builtin_amdgcn_mfma_f32_16x16x32_bf16(ta, rb, z4, 0, 0, 0);
        st4bf(xrow + 16 * b + 4 * q, xo);
    }
}

template <class StoreF> __device__ __forceinline__ void seq_step(const LAS bf16_t* Qh, const LAS bf16_t* Gms, const LAS bf16_t* ZT, LAS bf16_t* ZTn, f32x4 (&loc)[2], f32x4 (&hmt)[2], int wave, int lane, StoreF st) {
    const int tc = wave & 3; const Frag xz = ldfrag(ZT, tc, lane), xg = ldfrag(Gms, tc, lane);
#pragma unroll
    for (int u = 0; u < 2; ++u) { const int tr = (wave >> 2) + 2 * u; const int rr = tr * 16 + (lane & 15), c0 = tc * 16 + 4 * (lane >> 4);
        const f32x4 o = fmm(xz, ldfrag(Qh, tr, lane), loc[u]);
        const f32x4 zn = fmm(xg, ldfrag(ZT, tr, lane), hmt[u]);
        st4bf(ZTn + rr * LDH + c0, zn); st(rr, c0, o); }
}

__device__ __forceinline__ void phi_step(const LAS bf16_t* Qh, const LAS bf16_t* Gms, LAS bf16_t* PhiT, gbf* psi, long rstride, int wave, int lane) {
    const int tc = wave & 3; const Frag xp = ldfrag(PhiT, tc, lane), xg = ldfrag(Gms, tc, lane); const f32x4 z4 = {0.f, 0.f, 0.f, 0.f};
    f32x4 pn[2];
#pragma unroll
    for (int u = 0; u < 2; ++u) { const int tr = (wave >> 2) + 2 * u; const int rr = tr * 16 + (lane & 15), c0 = tc * 16 + 4 * (lane >> 4);
        const f32x4 ps = fmm(xp, ldfrag(Qh, tr, lane), z4);
        pn[u] = fmm(xg, ldfrag(PhiT, tr, lane), z4);
        *(gu64*)(psi + (long)rr * rstride + c0) = (unsigned long long)pk(ps[0], ps[1]) | ((unsigned long long)pk(ps[2], ps[3]) << 32); }
    __syncthreads();
#pragma unroll
    for (int u = 0; u < 2; ++u) { const int tr = (wave >> 2) + 2 * u; st4bf(PhiT + (tr * 16 + (lane & 15)) * LDH + tc * 16 + 4 * (lane >> 4), pn[u]); }
}
__device__ __forceinline__ void scan_correct(PRef P, Ctx& C) {
    const int tid = fresh_tid(), lane = tid & 63, wave = C.wave; constexpr int NA = NCHT - SPLIT_A, NC = NCHT - SPLIT_C;
    const gbf* PSI = (const gbf*)uni(P.LT); const gbf* ZM = (const gbf*)uni(P.ZMID); const gbf* AP = (const gbf*)uni(P.AP); gbf* YAb = (gbf*)uni(P.YA); gbf* OCb = (gbf*)uni(P.OC);
    for (int it = fresh_bx(); it < 64 * (NA + NC); it += C.G) { const int mix = it >= 64 * NA, r = mix ? it - 64 * NA : it, nch = mix ? NC : NA, sq = r / nch, cc = r % nch, c0 = mix ? SPLIT_C : SPLIT_A; const int d = sq >> 5, b = sq >> 2 & 7, h = sq & 3;
        const gbf* zm = ZM + ((size_t)mix * 64 + sq) * 4096; gbf* OUT = (mix ? OCb : YAb) + (size_t)d * MROWS * 256 + h * 64;
        const int tc = wave & 3; Frag xz; { const gbf* p = zm + (tc * 16 + (lane & 15)) * 64 + (lane >> 4) * 8; xz.f[0] = *(const gbf16x8*)p; xz.f[1] = *(const gbf16x8*)(p + 32); }
#pragma unroll
        for (int u = 0; u < 2; ++u) { const int tr = (wave >> 2) + 2 * u, t = tr * 16 + (lane & 15); const int s_ = (c0 + cc) * 64 + t; const long t_ = (long)b * NS + (d == 0 ? s_ : NS - 1 - s_);
            const gbf* p = (mix ? AP + t_ * 1792 + (d * 4 + h) * 64 : PSI + ((size_t)sq * PSLOT + cc) * 4096 + t * 64) + (lane >> 4) * 8;
            Frag yp; yp.f[0] = *(const gbf16x8*)p; yp.f[1] = *(const gbf16x8*)(p + 32);
            const f32x4 z4 = {0.f, 0.f, 0.f, 0.f}; const f32x4 a = fmm(xz, yp, z4);
            gu64* o8 = (gu64*)(OUT + t_ * 256 + tc * 16 + 4 * (lane >> 4)); const unsigned long long w = *o8; const unsigned lo = (unsigned)w, hi = (unsigned)(w >> 32);
            *o8 = (unsigned long long)pk(bfl(lo) + a[0], bfh(lo) + a[1]) | ((unsigned long long)pk(bfl(hi) + a[2], bfh(hi) + a[3]) << 32); }
    }
}

__device__ __forceinline__ void scanC(PRef P, int l, int sq, int half, Ctx& C) {
    const int tid = fresh_tid(), lane0 = tid & 63, wave = C.wave;
    const int d = sq >> 5, b = (sq >> 2) & 7, h = sq & 3;
    LAS bf16_t* Qs = (LAS bf16_t*)C.lds; LAS bf16_t* Ks = Qs + MAT; LAS bf16_t* Vs = Ks + MAT; LAS bf16_t* KgT = Vs + MAT; LAS bf16_t* Aqs = KgT + MAT;
    LAS bf16_t* XT = Aqs + MAT; LAS bf16_t* Qh = XT + 2 * MAT; LAS bf16_t* Gms = Qh + MAT; LAS bf16_t* ZT = Gms + MAT;
    LAS bf16_t* Lb = ZT + 2 * MAT; LAS bf16_t* Tb = Lb + MAT; LAS bf16_t* RT = Tb + 4 * 16 * LDT; LAS float* Ld = (LAS float*)(RT + 8 * 16 * LDT); LAS float* sg = Ld + 4 * 16 * LDD; LAS float* sgc = sg + 64; LAS float* sbet = sgc + 64; LAS float* sbeg = sbet + 64; LAS float* segc = sbeg + 64; LAS float* segl = segc + 64; LAS float* cwt = segl + 64; LAS bf16_t* PhiT = (LAS bf16_t*)(cwt + 960);
    for (int i = tid; i < MAT / 2; i += 512) ((LAS unsigned*)(ZT + ((half ? SPLIT_C : 0) & 1) * MAT))[i] = 0u;
    const gbf* PC = (const gbf*)uni(P.PC); const gfl* CBG = (const gfl*)uni(P.CBG);
    { const float* cw = uni(P.conv) + (size_t)l * 5 * 768; for (int i = tid; i < 960; i += 512) { const int ar = i / 320, tp = (i / 64) % 5, ch = i & 63; cwt[i] = cw[tp * 768 + ar * 256 + h * 64 + ch]; } } gbf* OC = (gbf*)uni(P.OC) + (size_t)d * MROWS * 256 + h * 64;
    const int lt = tid >> 3, lp = tid & 7;
    u32x4 raw[3][5]; float rbeta = 0.f, rg = 0.f; int rs = 0;
#define SCANC_LOAD(c) do { const int s_ = (c) * 64 + lt; const int sp_ = d == 0 ? s_ : NS - 1 - s_; const long t_ = (long)b * NS + sp_; rs = sp_; const gbf* p_ = PC + t_ * 1024 + h * 64 + lp * 8; \
        if ((c) != 0 && (c) != NS / 64 - 1) { _Pragma("unroll") for (int tp_ = 0; tp_ < 5; ++tp_) _Pragma("unroll") for (int ar_ = 0; ar_ < 3; ++ar_) raw[ar_][tp_] = *(const gu32x4*)(p_ + (long)(tp_ - 2) * 1024 + ar_ * 256); } \
        else { _Pragma("unroll") for (int tp_ = 0; tp_ < 5; ++tp_) { const int so_ = sp_ + tp_ - 2; const bool ok_ = so_ >= 0 && so_ < NS; _Pragma("unroll") for (int ar_ = 0; ar_ < 3; ++ar_) \
            raw[ar_][tp_] = ok_ ? *(const gu32x4*)(p_ + (long)(tp_ - 2) * 1024 + ar_ * 256) : (u32x4){0u, 0u, 0u, 0u}; } }     \
        if (lp == 0) { rbeta = CBG[t_ * 16 + d * 4 + h]; rg = CBG[t_ * 16 + 8 + d * 4 + h]; } } while (0)
    const int cbeg = half ? SPLIT_C : 0, cend = half ? NCHT : SPLIT_C;
    if (half) for (int i = tid; i < 64 * 64; i += 512) PhiT[(i >> 6) * LDH + (i & 63)] = (i >> 6) == (i & 63) ? (bf16_t)0x3F80 : (bf16_t)0;
    gbf* APp = (gbf*)uni(P.AP) + (d * 4 + h) * 64; gbf* ZMID = (gbf*)uni(P.ZMID) + ((size_t)64 + sq) * 4096;
    SCANC_LOAD(cbeg);
    __syncthreads();
    for (int c = cbeg; c < cend; ++c) {
        int lane = lane0; asm volatile("" : "+v"(lane));
        u32x4 rq, rk, rv;
        { float a[3][8];
#pragma unroll
          for (int ar = 0; ar < 3; ++ar) {
#pragma unroll
            for (int j = 0; j < 8; ++j) a[ar][j] = 0.f;
#pragma unroll
            for (int tp = 0; tp < 5; ++tp) { const unsigned w[4] = {raw[ar][tp].x, raw[ar][tp].y, raw[ar][tp].z, raw[ar][tp].w}; const LAS float* cwp = cwt + (ar * 5 + tp) * 64 + lp * 8;
              const f32x4 c0 = *(const LAS f32x4*)cwp, c1 = *(const LAS f32x4*)(cwp + 4);
#pragma unroll
              for (int j = 0; j < 4; ++j) { a[ar][2 * j] += bfl(w[j]) * (j < 2 ? c0[2 * j] : c1[2 * j - 4]); a[ar][2 * j + 1] += bfh(w[j]) * (j < 2 ? c0[2 * j + 1] : c1[2 * j - 3]); } }
            float ss = 0.f;
#pragma unroll
            for (int j = 0; j < 8; ++j) { const float x = a[ar][j]; const float sv = x * __builtin_amdgcn_rcpf(1.0f + __expf(-x)); a[ar][j] = sv; ss += sv * sv; }
            ss += __shfl_xor(ss, 1); ss += __shfl_xor(ss, 2); ss += __shfl_xor(ss, 4);
            const float scl = ar == 2 ? 1.0f : (ar == 0 ? 0.125f : 1.0f) / sqrtf(ss + 1e-12f);
#pragma unroll
            for (int j = 0; j < 8; ++j) a[ar][j] *= scl; }
          rq = (u32x4){pk(a[0][0], a[0][1]), pk(a[0][2], a[0][3]), pk(a[0][4], a[0][5]), pk(a[0][6], a[0][7])};
          rk = (u32x4){pk(a[1][0], a[1][1]), pk(a[1][2], a[1][3]), pk(a[1][4], a[1][5]), pk(a[1][6], a[1][7])};
          rv = (u32x4){pk(a[2][0], a[2][1]), pk(a[2][2], a[2][3]), pk(a[2][4], a[2][5]), pk(a[2][6], a[2][7])}; }
        *(LAS u32x4*)(Qs + lt * LDH + lp * 8) = rq; *(LAS u32x4*)(Ks + lt * LDH + lp * 8) = rk; *(LAS u32x4*)(Vs + lt * LDH + lp * 8) = rv;
        if (lp == 0) { sg[lt] = rg; sbet[lt] = rbeta; }
        const u32x4 kraw = rk;
        __syncthreads();
        if (c + 1 < cend) SCANC_LOAD(c + 1);
        if (wave == 0) {
            float g = sg[lane];
#pragma unroll
            for (int o = 1; o < 64; o <<= 1) { const float t = __shfl_up(g, o); if (lane >= o) g += t; }
            const float gl = __shfl(g, 63);
            sgc[lane] = g; const float eg = __expf(g); segc[lane] = eg; sbeg[lane] = sbet[lane] * eg; segl[lane] = __expf(gl - g);
        }
        __syncthreads();
        { const float sc = segl[lt]; const unsigned kw[4] = {kraw.x, kraw.y, kraw.z, kraw.w};
#pragma unroll
          for (int j = 0; j < 4; ++j) { KgT[(lp * 8 + 2 * j) * LDH + lt] = f2bf_hw(bfl(kw[j]) * sc); KgT[(lp * 8 + 2 * j + 1) * LDH + lt] = f2bf_hw(bfh(kw[j]) * sc); } }
        const int x = lane & 15, q4 = 4 * (lane >> 4); f32x4 ms, mi;
#pragma unroll
        for (int i = 0; i < 4; ++i) { ms[i] = q4 + i < x ? 1.0f : 0.f; mi[i] = q4 + i <= x ? 1.0f : 0.f; }
        auto gram = [&](const LAS bf16_t* rowsM, const Frag& xk, int tc, int tr, bool isq) __attribute__((always_inline)) {
            const int ri = tr * 16 + x; const f32x4 gj = *(const LAS f32x4*)(sgc + tc * 16 + q4); f32x4 v = {0.f, 0.f, 0.f, 0.f};
            if (tc <= tr) { v = fmm(xk, ldfrag(rowsM, tr, lane), v); const float gi = sgc[ri], sc = isq ? 1.0f : sbet[ri];
#pragma unroll
              for (int i = 0; i < 4; ++i) v[i] *= __expf(fminf(gi - gj[i], 0.f)) * sc;
              if (tc == tr) { v *= isq ? mi : ms; if (!isq) *(LAS f32x4*)(Ld + ri * LDD + q4) = v; } }
            st4bf((isq ? Aqs : Lb) + ri * LDH + tc * 16 + q4, v); };
        { const int tc = wave & 3; const Frag xk = ldfrag(Ks, tc, lane);
#pragma unroll
          for (int u = 0; u < 2; ++u) gram(Ks, xk, tc, 2 * u + (wave >> 2), false); }
        __syncthreads();
        if (wave < 4) diag_inverse(Ld + wave * 16 * LDD, Tb + wave * 16 * LDT, lane);
        else { const int tc = wave & 3; const Frag xk = ldfrag(Ks, tc, lane);
#pragma unroll
          for (int tr = 0; tr < 4; ++tr) gram(Qs, xk, tc, tr, true); }
        __syncthreads();
        { const LAS bf16_t* src = wave < 4 ? Vs : Ks; const LAS float* scl = wave < 4 ? sbet : sbeg;
          solve_blocked(Lb, Tb, XT, RT + wave * 16 * LDT, [&](int j, int col) { return ldsbf(src + j * LDH + (col & 63)) * scl[j]; }, wave, lane); }
        __syncthreads();
        f32x4 loc[2], hmt[2];
        { const float egl_all = segc[63]; const int tc = wave & 3; const f32x4 z4 = {0.f, 0.f, 0.f, 0.f};
          const Frag xw = ldfrag(XT + 64 * LDH, tc, lane), xu = ldfrag(XT, tc, lane), xkg = ldfrag(KgT, tc, lane);
#pragma unroll
          for (int u = 0; u < 2; ++u) { const int tr = (wave >> 2) + 2 * u; const int rr = tr * 16 + (lane & 15), c0 = tc * 16 + 4 * (lane >> 4);
            const Frag ya = ldfrag(Aqs, tr, lane), ykg = ldfrag(KgT, tr, lane), yu = ldfrag(XT, tr, lane);
            const f32x4 aw = fmm(xw, ya, z4);
            loc[u] = fmm(xu, ya, z4);
            const f32x4 gw = fmm(xw, ykg, z4);
            hmt[u] = fmm(xkg, yu, z4);
            const f32x4 q4 = ld4bf(Qs + rr * LDH + c0); const float eg = segc[rr]; f32x4 qh, gm;
#pragma unroll
            for (int i = 0; i < 4; ++i) { qh[i] = q4[i] * eg - aw[i]; gm[i] = (rr == c0 + i ? egl_all : 0.f) - gw[i]; }
            st4bf(Qh + rr * LDH + c0, qh); st4bf(Gms + rr * LDH + c0, gm); } }
        __syncthreads();
        { const int cbase = c * 64;
          seq_step(Qh, Gms, ZT + (c & 1) * MAT, ZT + ((c & 1) ^ 1) * MAT, loc, hmt, wave, lane, [&](int t, int v0, f32x4 o) { const int s_ = cbase + t; const long t_ = (long)b * NS + (d == 0 ? s_ : NS - 1 - s_);
              *(gu64*)(OC + t_ * 256 + v0) = (unsigned long long)pk(o[0], o[1]) | ((unsigned long long)pk(o[2], o[3]) << 32); });
          if (half) { const long t0_ = (long)b * NS + (d == 0 ? cbase : NS - 1 - cbase); phi_step(Qh, Gms, PhiT, APp + t0_ * 1792, d == 0 ? 1792 : -1792, wave, lane); } }
    }
    __syncthreads();
    if (!half) { const LAS bf16_t* zf = ZT + (cend & 1) * MAT; const int row = tid >> 3, part = tid & 7; *(gu32x4*)(ZMID + row * 64 + part * 8) = *(const LAS u32x4*)(zf + row * LDH + part * 8); }
#undef SCANC_LOAD
}

__device__ __forceinline__ void scanA(PRef P, int l, int sq, int half, Ctx& C) {
    const int tid = fresh_tid(), lane0 = tid & 63, wave = C.wave;
    const int d = sq >> 5, b = (sq >> 2) & 7, h = sq & 3;
    LAS bf16_t* ARs = (LAS bf16_t*)C.lds;
    LAS bf16_t* BKs = ARs + 2 * MAT;
    LAS bf16_t* BhT = BKs + 2 * MAT; LAS bf16_t* KhT = BhT + MAT; LAS bf16_t* VT = KhT + MAT;
    LAS bf16_t* Mak = VT + MAT;
    LAS bf16_t* Mrb = Mak + MAT;
    LAS bf16_t* Mrk = Mrb + MAT; LAS bf16_t* ZT = Mrk + MAT;
    LAS float* cs = (LAS float*)(ZT + 2 * MAT);
    LAS bf16_t* Lb = (LAS bf16_t*)cs; LAS float* Ld = (LAS float*)(Lb + MAT);
    LAS bf16_t* RH = (LAS bf16_t*)(cs + 64 * LDF);
    LAS float* sct = (LAS float*)(RH + MAT);
    LAS float* segs = sct + 128;
    LAS float* mut = segs + 512;
    LAS bf16_t* Tb = (LAS bf16_t*)(mut + 384);
    LAS bf16_t* XT = BKs; LAS bf16_t* Qh = Mak; LAS bf16_t* RT = Mak; LAS bf16_t* Gms = RH;
    LAS bf16_t* PhiT = Tb + 4 * 16 * LDT;
    for (int i = tid; i < MAT / 2; i += 512) ((LAS unsigned*)(ZT + ((half ? SPLIT_A : 0) & 1) * MAT))[i] = 0u;
    if (half) for (int i = tid; i < 64 * 64; i += 512) PhiT[(i >> 6) * LDH + (i & 63)] = (i >> 6) == (i & 63) ? (bf16_t)0x3F80 : (bf16_t)0;
    const int cbeg = half ? SPLIT_A : 0, cend = half ? NCHT : SPLIT_A;
    gbf* PSI = (gbf*)uni(P.LT) + (size_t)sq * PSLOT * 4096; gbf* ZMID = (gbf*)uni(P.ZMID) + (size_t)sq * 4096;
    const gbf* PA = (const gbf*)uni(P.PA);
    { const float* mp = uni(P.mu_prev) + l * 1024; const float* mn = uni(P.mu_next) + l * 1024; for (int i = tid; i < 384; i += 512) { const int pn = i / 192, ar = (i / 64) % 3, ch = i & 63; mut[i] = (pn ? mn : mp)[ar * 256 + h * 64 + ch]; } }
    const gbf* AP = (const gbf*)uni(P.AP); gfl* BON = (gfl*)uni(P.RN) + (size_t)d * MROWS * 4 + h; gbf* YA = (gbf*)uni(P.YA) + (size_t)d * MROWS * 256 + h * 64;
    const float* kkp = uni(P.k_k) + l * 256 + h * 64; const float* kap = uni(P.k_a) + l * 256 + h * 64; const float* rkp = uni(P.r_k) + l * 256 + h * 64;
    const int lt = tid >> 3, lp = tid & 7;
    float kkc[8], kac[8], rkc[8];
#pragma unroll
    for (int j = 0; j < 8; ++j) { kkc[j] = kkp[lp * 8 + j]; kac[j] = kap[lp * 8 + j]; rkc[j] = rkp[lp * 8 + j]; }
    u32x4 raw[3][3], re, ra; long rtok = 0; bf16_t re8[8];
#define SCANA_LOAD(c) do { const int s_ = (c) * 64 + lt; const long t_ = (long)b * NS + (d == 0 ? s_ : NS - 1 - s_); const gbf* p_ = AP + t_ * 1792 + h * 64 + lp * 8; \
        { const int sp_ = d == 0 ? s_ : NS - 1 - s_; const gbf* q_ = PA + t_ * 1024 + h * 64 + lp * 8; const bool in_ = (c) != 0 && (c) != NS / 64 - 1; _Pragma("unroll") for (int ar_ = 0; ar_ < 3; ++ar_) { raw[ar_][1] = *(const gu32x4*)(q_ + ar_ * 256); \
            if (in_) { raw[ar_][0] = *(const gu32x4*)(q_ + ar_ * 256 - 1024); raw[ar_][2] = *(const gu32x4*)(q_ + ar_ * 256 + 1024); } \
            else { raw[ar_][0] = sp_ > 0 ? *(const gu32x4*)(q_ + ar_ * 256 - 1024) : (u32x4){0u, 0u, 0u, 0u}; raw[ar_][2] = sp_ < NS - 1 ? *(const gu32x4*)(q_ + ar_ * 256 + 1024) : (u32x4){0u, 0u, 0u, 0u}; } } } \
        re = *(const gu32x4*)(p_ + 768 + d * 256); ra = *(const gu32x4*)(p_ + 1280 + d * 256); rtok = t_; \
        _Pragma("unroll") for (int j_ = 0; j_ < 8; ++j_) { const int s2_ = (c) * 64 + (tid >> 6) * 8 + j_; const long t2_ = (long)b * NS + (d == 0 ? s2_ : NS - 1 - s2_); re8[j_] = AP[t2_ * 1792 + 768 + d * 256 + h * 64 + (tid & 63)]; } } while (0)
    SCANA_LOAD(cbeg);
    __syncthreads();
    for (int c = cbeg; c < cend; ++c) {
        int lane = lane0; asm volatile("" : "+v"(lane));
        u32x4 wr, wk, wv; const u32x4 we = re, wa = ra; const long wtok = rtok;
        { u32x4 o3[3];
#pragma unroll
          for (int ar = 0; ar < 3; ++ar) { const unsigned f[4] = {raw[ar][1].x, raw[ar][1].y, raw[ar][1].z, raw[ar][1].w}, pv[4] = {raw[ar][0].x, raw[ar][0].y, raw[ar][0].z, raw[ar][0].w}, nx[4] = {raw[ar][2].x, raw[ar][2].y, raw[ar][2].z, raw[ar][2].w};
            const LAS float* mpp = mut + ar * 64 + lp * 8; const LAS float* mnp = mut + 192 + ar * 64 + lp * 8; float o[8];
#pragma unroll
            for (int j = 0; j < 4; ++j) { const float f0 = bfl(f[j]), f1 = bfh(f[j]);
              o[2 * j] = f0 + mpp[2 * j] * (bfl(pv[j]) - f0) + mnp[2 * j] * (bfl(nx[j]) - f0); o[2 * j + 1] = f1 + mpp[2 * j + 1] * (bfh(pv[j]) - f1) + mnp[2 * j + 1] * (bfh(nx[j]) - f1); }
            o3[ar] = (u32x4){pk(o[0], o[1]), pk(o[2], o[3]), pk(o[4], o[5]), pk(o[6], o[7])}; }
          wr = o3[0]; wk = o3[1]; wv = o3[2]; }
        { const int kch = tid & 63, seg = tid >> 6; float run[8]; float acc = 0.f;
#pragma unroll
          for (int j = 0; j < 8; ++j) { acc -= __uint_as_float(((unsigned)re8[j]) << 16); run[j] = acc; }
          segs[seg * 64 + kch] = acc;
          __syncthreads();
          if (c + 1 < cend) SCANA_LOAD(c + 1);
          float off = 0.f, tot = 0.f;
#pragma unroll
          for (int s2 = 0; s2 < 8; ++s2) { const float sv = segs[s2 * 64 + kch]; tot += sv; off += s2 < seg ? sv : 0.f; }
#pragma unroll
          for (int j = 0; j < 8; ++j) cs[(seg * 8 + j) * LDF + kch] = run[j] + off;
          if (seg == 0) { sct[kch] = __expf(tot); sct[64 + kch] = tot; } }
        __syncthreads();
        for (int rep_ = 0; rep_ < ((KNOB_SDUP & 1) ? 2 : 1); ++rep_) { const unsigned wrr[4] = {wr.x, wr.y, wr.z, wr.w}, wkk[4] = {wk.x, wk.y, wk.z, wk.w}, wvv[4] = {wv.x, wv.y, wv.z, wv.w}, wee[4] = {we.x, we.y, we.z, we.w}, waa[4] = {wa.x, wa.y, wa.z, wa.w};
          float at[8], rt[8], bt[8], kt[8];
          float ssq = 0.f, bon = 0.f;
#pragma unroll
          for (int j = 0; j < 8; ++j) { const float k_ = (j & 1) ? bfh(wkk[j >> 1]) : bfl(wkk[j >> 1]), r_ = (j & 1) ? bfh(wrr[j >> 1]) : bfl(wrr[j >> 1]), al = (j & 1) ? bfh(waa[j >> 1]) : bfl(waa[j >> 1]);
            const float kx_ = k_ * kkc[j]; ssq += kx_ * kx_; bon += r_ * (k_ * (1.0f + (al - 1.0f) * kac[j])) * rkc[j]; }
          ssq += __shfl_xor(ssq, 1); ssq += __shfl_xor(ssq, 2); ssq += __shfl_xor(ssq, 4); bon += __shfl_xor(bon, 1); bon += __shfl_xor(bon, 2); bon += __shfl_xor(bon, 4);
          const float rn = 1.0f / sqrtf(ssq + 1e-12f);
          if (lp == 0) BON[wtok * 4] = 0.5f * bon;
#pragma unroll
          for (int j = 0; j < 8; ++j) { const int ch = lp * 8 + j; const unsigned sh = (j & 1) ? 0u : 16u;
            const float r_ = (j & 1) ? bfh(wrr[j >> 1]) : bfl(wrr[j >> 1]), k_ = (j & 1) ? bfh(wkk[j >> 1]) : bfl(wkk[j >> 1]), v_ = (j & 1) ? bfh(wvv[j >> 1]) : bfl(wvv[j >> 1]);
            const float e_ = (j & 1) ? bfh(wee[j >> 1]) : bfl(wee[j >> 1]), al = (j & 1) ? bfh(waa[j >> 1]) : bfl(waa[j >> 1]); (void)sh;
            const float tot = sct[64 + ch], csv = cs[lt * LDF + ch];
            const float ecs = __expf(csv), eics = __builtin_amdgcn_rcpf(ecs), ecx = __expf(csv + e_), ect = sct[ch] * eics; (void)tot;
            const float kk = k_ * kkc[j] * rn, kx = k_ * (1.0f + (al - 1.0f) * kac[j]), bb = kk * al;
            at[j] = -kk * ecx; rt[j] = r_ * ecs; bt[j] = bb * eics; kt[j] = kx * eics;
            BhT[ch * LDH + lt] = f2bf_hw(bb * ect); KhT[ch * LDH + lt] = f2bf_hw(kx * ect); VT[ch * LDH + lt] = f2bf_hw(v_);
            }
          u32x4 w; w.x = pk(at[0], at[1]); w.y = pk(at[2], at[3]); w.z = pk(at[4], at[5]); w.w = pk(at[6], at[7]); *(LAS u32x4*)(ARs + lt * LDH + lp * 8) = w;
          w.x = pk(rt[0], rt[1]); w.y = pk(rt[2], rt[3]); w.z = pk(rt[4], rt[5]); w.w = pk(rt[6], rt[7]); *(LAS u32x4*)(ARs + (64 + lt) * LDH + lp * 8) = w;
          w.x = pk(bt[0], bt[1]); w.y = pk(bt[2], bt[3]); w.z = pk(bt[4], bt[5]); w.w = pk(bt[6], bt[7]); *(LAS u32x4*)(BKs + lt * LDH + lp * 8) = w;
          w.x = pk(kt[0], kt[1]); w.y = pk(kt[2], kt[3]); w.z = pk(kt[4], kt[5]); w.w = pk(kt[6], kt[7]); *(LAS u32x4*)(BKs + (64 + lt) * LDH + lp * 8) = w; }
        __syncthreads();
        { const int tc8 = wave, tc = tc8 & 3; const bool hi = tc8 >= 4; const Frag xb = ldfrag(BKs, tc8, lane);
          const int x = lane & 15, q4 = 4 * (lane >> 4); const float sg = hi ? 1.0f : -1.0f;
          f32x4 ms, mi;
#pragma unroll
          for (int i = 0; i < 4; ++i) { ms[i] = q4 + i < x ? sg : 0.f; mi[i] = q4 + i <= x ? 1.0f : 0.f; }
          LAS bf16_t* d0 = (hi ? Mak : Lb) + x * LDH + tc * 16 + q4;
          LAS bf16_t* d1 = (hi ? Mrk : Mrb) + x * LDH + tc * 16 + q4;
#pragma unroll
          for (int u = 0; u < 8; ++u) { const int tr = u & 3; const bool rows = u >= 4;
            f32x4 v = {0.f, 0.f, 0.f, 0.f};
            if (tc <= tr) { v = fmm(xb, ldfrag(ARs, u, lane), v);
              if (tc == tr) { v *= rows ? mi : ms; if (!rows && !hi) *(LAS f32x4*)(Ld + (tr * 16 + x) * LDD + q4) = v; }
              else if (!rows) v *= sg; }
            st4bf((rows ? d1 : d0) + tr * 16 * LDH, v);
          } }
        __syncthreads();
        if (wave >= 4) { const int tc = wave & 3; const Frag xv = ldfrag(VT, tc, lane); const f32x4 z4 = {0.f, 0.f, 0.f, 0.f};
#pragma unroll
          for (int tr = 0; tr < 4; ++tr) { const f32x4 acc = fmm(xv, ldfrag(Mak, tr, lane), z4); st4bf(RH + (tr * 16 + (lane & 15)) * LDH + tc * 16 + 4 * (lane >> 4), acc); } }
        else diag_inverse(Ld + wave * 16 * LDD, Tb + wave * 16 * LDT, lane);
        __syncthreads();
        for (int rep_ = 0; rep_ < ((KNOB_SDUP & 4) ? 2 : 1); ++rep_) {
          if (wave < 4) solve_blocked(Lb, Tb, XT, RT + wave * 16 * LDT, [&](int j, int col) { return ldsbf(RH + j * LDH + (col & 63)); }, wave, lane);
          else solve_blocked(Lb, Tb, XT, RT + wave * 16 * LDT, [&](int j, int col) { return ldsbf(ARs + j * LDH + (col & 63)); }, wave, lane); }
        __syncthreads();
        f32x4 loc[2], hmt[2];
        { const int tc = wave & 3; const f32x4 z4 = {0.f, 0.f, 0.f, 0.f};
          const Frag xw = ldfrag(XT + 64 * LDH, tc, lane), xu = ldfrag(XT, tc, lane), xv = ldfrag(VT, tc, lane), xbh = ldfrag(BhT, tc, lane), xkh = ldfrag(KhT, tc, lane);
#pragma unroll
          for (int u = 0; u < 2; ++u) { const int tr = (wave >> 2) + 2 * u; const int rr = tr * 16 + (lane & 15), c0 = tc * 16 + 4 * (lane >> 4);
            const Frag yrb = ldfrag(Mrb, tr, lane), yrk = ldfrag(Mrk, tr, lane), ybh = ldfrag(BhT, tr, lane), yu = ldfrag(XT, tr, lane), yv = ldfrag(VT, tr, lane);
            const f32x4 qw = fmm(xw, yrb, z4);
            loc[u] = fmm(xv, yrk, fmm(xu, yrb, z4));
            const f32x4 gw = fmm(xw, ybh, z4);
            hmt[u] = fmm(xkh, yv, fmm(xbh, yu, z4));
            const f32x4 r4 = ld4bf(ARs + (64 + rr) * LDH + c0); f32x4 qh, gm;
#pragma unroll
            for (int i = 0; i < 4; ++i) { qh[i] = r4[i] + qw[i]; gm[i] = (rr == c0 + i ? sct[rr] : 0.f) + gw[i]; }
            st4bf(Qh + rr * LDH + c0, qh); st4bf(Gms + rr * LDH + c0, gm); } }
        __syncthreads();
        { const int cbase = c * 64;
          seq_step(Qh, Gms, ZT + (c & 1) * MAT, ZT + ((c & 1) ^ 1) * MAT, loc, hmt, wave, lane, [&](int t, int v0, f32x4 o) { const int s_ = cbase + t; const long t_ = (long)b * NS + (d == 0 ? s_ : NS - 1 - s_);
              *(gu64*)(YA + t_ * 256 + v0) = (unsigned long long)pk(o[0], o[1]) | ((unsigned long long)pk(o[2], o[3]) << 32); });
          if (half) phi_step(Qh, Gms, PhiT, PSI + (size_t)(c - cbeg) * 4096, 64, wave, lane); }
    }
    __syncthreads();
    if (!half) { const LAS bf16_t* zf = ZT + (cend & 1) * MAT; const int row = tid >> 3, part = tid & 7;
        *(gu32x4*)(ZMID + row * 64 + part * 8) = *(const LAS u32x4*)(zf + row * LDH + part * 8); }
#undef SCANA_LOAD
}
}

__device__ __forceinline__ void ph_fix_fused(PRef P, int l, Ctx& C) {
    typedef short bf16x8f __attribute__((ext_vector_type(8))); typedef float f32x4f __attribute__((ext_vector_type(4)));
    static_assert(scan::SPLIT_A == scan::SPLIT_C, "one split point for both mixers is assumed here");
    const int tid = fresh_tid(), lane = tid & 63, wave = C.wave, x = lane & 15, q = lane >> 4;
    LAS float* corrL = (LAS float*)C.lds; constexpr int LDC = 68;
    const GAS bf16_t* YA = (const GAS bf16_t*)uni(P.YA); const GAS bf16_t* OC = (const GAS bf16_t*)uni(P.OC); const GAS bf16_t* PA = (const GAS bf16_t*)uni(P.PA); const GAS bf16_t* PC = (const GAS bf16_t*)uni(P.PC);
    const GAS bf16_t* GA = (const GAS bf16_t*)uni(P.GA); const GAS float* BON = (const GAS float*)uni(P.RN); GAS bf16_t* MIX = (GAS bf16_t*)uni(P.MIX);
    const GAS bf16_t* PSI = (const GAS bf16_t*)uni(P.LT); const GAS bf16_t* ZM = (const GAS bf16_t*)uni(P.ZMID); const GAS bf16_t* AP = (const GAS bf16_t*)uni(P.AP);
    const GAS float* lw = (const GAS float*)P.ln_w + l * 256; const GAS float* lb = (const GAS float*)P.ln_b + l * 256; const GAS float* mp = (const GAS float*)P.mu_prev + l * 1024 + 512; const GAS float* mn = (const GAS float*)P.mu_next + l * 1024 + 512;
    const GAS float* ng = (const GAS float*)P.gdn_norm_g + l * 64;
    const int tt = tid >> 5, c0 = (tid & 31) * 8, hh = c0 >> 6;
    const int m = wave >> 2, h = wave & 3;
    const f32x4f p0 = *(const GAS f32x4f*)(mp + c0), p1 = *(const GAS f32x4f*)(mp + c0 + 4), q0 = *(const GAS f32x4f*)(mn + c0), q1 = *(const GAS f32x4f*)(mn + c0 + 4);
    const f32x4f w0 = *(const GAS f32x4f*)(lw + c0), w1 = *(const GAS f32x4f*)(lw + c0 + 4), b0 = *(const GAS f32x4f*)(lb + c0), b1 = *(const GAS f32x4f*)(lb + c0 + 4);
    const f32x4f n0 = *(const GAS f32x4f*)(ng + (c0 & 63)), n1 = *(const GAS f32x4f*)(ng + (c0 & 63) + 4);
    for (int pb = fresh_bx(); pb < NS / 16; pb += C.G) { const int j = pb >> 2, trk = pb & 3;
        const int dc = j >= scan::SPLIT_A ? 0 : 1, cscan = dc == 0 ? j : scan::NCHT - 1 - j, cc = cscan - scan::SPLIT_A;
        const int tl = dc == 0 ? 16 * trk + x : 63 - (16 * trk + x);
        bf16x8f yp0, yp1, xz[4][2];
        auto ldcorr = [&](int b) __attribute__((always_inline)) { const int sq = dc * 32 + b * 4 + h; const long tx = (long)b * NS + 16 * pb + x;
            const GAS bf16_t* pp = (m ? AP + tx * 1792 + (dc * 4 + h) * 64 : PSI + ((size_t)sq * scan::PSLOT + cc) * 4096 + tl * 64) + q * 8;
            yp0 = __builtin_nontemporal_load((const GAS bf16x8f*)pp); yp1 = __builtin_nontemporal_load((const GAS bf16x8f*)(pp + 32));
            const GAS bf16_t* zm = ZM + ((size_t)m * 64 + sq) * 4096 + x * 64 + q * 8;
#pragma unroll
            for (int tc = 0; tc < 4; ++tc) { xz[tc][0] = *(const GAS bf16x8f*)(zm + tc * 16 * 64); xz[tc][1] = *(const GAS bf16x8f*)(zm + tc * 16 * 64 + 32); } };
        ldcorr(0);
#pragma unroll 1
        for (int b = 0; b < NB; ++b) {
            const long t = (long)b * NS + 16 * pb + tt; const int s = 16 * pb + tt; const u32x4g z4u = {0u, 0u, 0u, 0u};
            const u32x4g ry0 = __builtin_nontemporal_load((const GAS u32x4g*)(YA + t * 256 + c0)), ry1 = __builtin_nontemporal_load((const GAS u32x4g*)(YA + ((size_t)MROWS + t) * 256 + c0));
            const u32x4g rf = *(const GAS u32x4g*)(PA + t * 1024 + 512 + c0), rp = s > 0 ? *(const GAS u32x4g*)(PA + (t - 1) * 1024 + 512 + c0) : z4u, rn = s < NS - 1 ? *(const GAS u32x4g*)(PA + (t + 1) * 1024 + 512 + c0) : z4u;
            const u32x4g rg = *(const GAS u32x4g*)(GA + t * 256 + c0); const float bo = BON[t * 4 + hh] + BON[((size_t)MROWS + t) * 4 + hh];
            const u32x4g ro0 = __builtin_nontemporal_load((const GAS u32x4g*)(OC + t * 256 + c0)), ro1 = __builtin_nontemporal_load((const GAS u32x4g*)(OC + ((size_t)MROWS + t) * 256 + c0)), rz = *(const GAS u32x4g*)(PC + t * 1024 + 768 + c0);
#pragma unroll
            for (int tc = 0; tc < 4; ++tc) { f32x4f a = {0.f, 0.f, 0.f, 0.f};
                a = __builtin_amdgcn_mfma_f32_16x16x32_bf16(xz[tc][0], yp0, a, 0, 0, 0); a = __builtin_amdgcn_mfma_f32_16x16x32_bf16(xz[tc][1], yp1, a, 0, 0, 0);
                *(LAS f32x4f*)(corrL + (wave * 16 + x) * LDC + 16 * tc + 4 * q) = a; }
            __syncthreads();
            if (b + 1 < NB) ldcorr(b + 1);
            { float y0[8], y1[8], f[8], pv[8], nx[8], g[8], y[8], v[8]; unpack8(ry0, y0); unpack8(ry1, y1); unpack8(rf, f); unpack8(rp, pv); unpack8(rn, nx); unpack8(rg, g);
              const LAS float* cp = corrL + ((0 * 4 + hh) * 16 + tt) * LDC + (c0 & 63); const f32x4f ca = *(const LAS f32x4f*)cp, cb = *(const LAS f32x4f*)(cp + 4);
              float sm = 0.f;
#pragma unroll
              for (int jj = 0; jj < 8; ++jj) { v[jj] = f[jj] + (jj < 4 ? p0[jj & 3] : p1[jj & 3]) * (pv[jj] - f[jj]) + (jj < 4 ? q0[jj & 3] : q1[jj & 3]) * (nx[jj] - f[jj]);
                  y[jj] = y0[jj] + y1[jj] + (jj < 4 ? ca[jj & 3] : cb[jj & 3]); sm += y[jj]; }
              const float mean = oct_sum(sm) * (1.0f / 64); float var = 0.f;
#pragma unroll
              for (int jj = 0; jj < 8; ++jj) { const float d = y[jj] - mean; var += d * d; }
              const float rstd = 1.0f / sqrtf(oct_sum(var) * (1.0f / 64) + 64e-5f);
#pragma unroll
              for (int jj = 0; jj < 8; ++jj) y[jj] = ((y[jj] - mean) * rstd * (jj < 4 ? w0[jj & 3] : w1[jj & 3]) + (jj < 4 ? b0[jj & 3] : b1[jj & 3]) + bo * v[jj]) * g[jj];
              *(GAS u32x4g*)(MIX + t * MIXW + c0) = pack8(y); }
            { float o0[8], o1[8], z[8], o[8]; unpack8(ro0, o0); unpack8(ro1, o1); unpack8(rz, z);
              const LAS float* cp = corrL + ((1 * 4 + hh) * 16 + tt) * LDC + (c0 & 63); const f32x4f ca = *(const LAS f32x4f*)cp, cb = *(const LAS f32x4f*)(cp + 4);
              float ss = 0.f;
#pragma unroll
              for (int jj = 0; jj < 8; ++jj) { o[jj] = o0[jj] + o1[jj] + (jj < 4 ? ca[jj & 3] : cb[jj & 3]); ss += o[jj] * o[jj]; }
              const float rs = 1.0f / sqrtf(oct_sum(ss) * (1.0f / 64) + 1e-6f);
#pragma unroll
              for (int jj = 0; jj < 8; ++jj) o[jj] = o[jj] * rs * (jj < 4 ? n0[jj & 3] : n1[jj & 3]) * (z[jj] * __builtin_amdgcn_rcpf(1.0f + __expf(-z[jj])));
              *(GAS u32x4g*)(MIX + t * MIXW + 512 + c0) = pack8(o); }
            __syncthreads();
        }
    }
}
#define CW_TICKET 8192
__device__ __forceinline__ void ph_mixers(PRef P, int l, Ctx& C) {
    const int bx = fresh_bx();
    if (bx < 128) { scan::scanA(P, l, bx >> 1, bx & 1, C); if (KNOB_DUP & 65536) { __syncthreads(); scan::scanA(P, l, bx >> 1, bx & 1, C); } }
    else { scan::scanC(P, l, (bx - 128) >> 1, bx & 1, C); if (KNOB_DUP & 32768) { __syncthreads(); scan::scanC(P, l, (bx - 128) >> 1, bx & 1, C); } }
    __syncthreads();
    unsigned* ctr = uni(P.CTL) + CW_TICKET + l * 128; volatile LAS int* tk = (volatile LAS int*)(C.lds + MISC_OFF) + 16;
    ph_attnB_mfma(P, C, ctr, tk);
    __syncthreads();
    dwin::attnD_mfma(P, C, ctr + 64, tk);
}
#endif
#ifdef CPU_EMU
#define FRESH_GID() const long gid = C.gid, gs = C.gs
#else
#define FRESH_GID() int tid_ = threadIdx.x; OPAQUE(tid_); const long gid = (long)fresh_bx() * 512 + tid_, gs = (long)gridDim.x * 512
#endif
#if defined(CPU_EMU) || KNOB_SCAN == 0
#define SCANS(l) do { ph_scanA(P, l, gid, gs); ph_scanC(P, l, (gid + gs / 2) % gs, gs); } while (0)
#elif KNOB_SCAN == 1
#define SCANS(l) do { ph_scan_chunked(P, l, C); ph_scanA(P, l, (gid + gs / 2) % gs, gs); } while (0)
#elif KNOB_SCAN == 2
#define SCANS(l) do { ph_scan_chunked(P, l, C); ph_scanC(P, l, (gid + gs / 2) % gs, gs); } while (0)
#else
#define SCANS(l) ph_scan_chunked(P, l, C)
#endif
#ifdef CPU_EMU
#define CONVERT_SMALL(l) do {} while (0)
#define CONVERT_MOE(l) do {} while (0)
#define GEMM_IN(l) ph_gemm_in(P, l, gid, gs)
#define GEMM_OUT(l, xs) ph_gemm_out(P, l, xs, gid, gs)
#define GEMM_GU(l) ph_gemm_gu(P, l, gid, gs)
#define GEMM_DOWN(l) ph_gemm_down(P, l, gid, gs)
#else
#if KNOB_CONVERT
#define CONVERT_SMALL(l) convert_small(P, l, C)
#define CONVERT_MOE(l) convert_moe(P, l, C)
#else
#define CONVERT_SMALL(l) do {} while (0)
#define CONVERT_MOE(l) do {} while (0)
#endif
#if KNOB_MFMA & 1
#define GEMM_IN(l) gemm_in_mfma(P, C)
#else
#define GEMM_IN(l) ph_gemm_in(P, l, gid, gs)
#endif
#if KNOB_MFMA & 2
#define GEMM_OUT(l, xs) ph_gemm_out(P, l, xs, gid, gs)
#else
#define GEMM_OUT(l, xs) ph_gemm_out(P, l, xs, gid, gs)
#endif
#if KNOB_MFMA & 4
#define GEMM_GU(l) gemm_gu_mfma(P, C)
#else
#define GEMM_GU(l) ph_gemm_gu(P, l, gid, gs)
#endif
#if KNOB_MFMA & 8
#define GEMM_DOWN(l) gemm_down_mfma(P, C)
#else
#define GEMM_DOWN(l) ph_gemm_down(P, l, gid, gs)
#endif
#endif
DEVFN void layer_fwd(PRef P, Ctx& C, const int l) {
    {
        #define XSRC (l == 0 ? P.x : P.out)
#ifdef CPU_EMU
        { FRESH_GID(); ph_rowrs(XSRC, P.RS, gid, gs); GRID_SYNC(); }
        { FRESH_GID(); ph_norm_bf16(XSRC, P.RS, P.norm_mix_g + l * DM, P.XN, gid, gs); GRID_SYNC(); }
#else
        if (l == 0) { ph_norm_rows_w(P.x, P.norm_mix_g, P.XN, C); CONVERT_SMALL(0); GRID_SYNC(); }
#endif
        { FRESH_GID(); GEMM_IN(l); if (KNOB_DUP & 256) { GRID_SYNC(); GEMM_IN(l); } GRID_SYNC(); }
#ifdef CPU_EMU
        { FRESH_GID(); ph_prepA_shift(P, l, gid, gs); ph_prepB(P, l, gid, gs); ph_prepC_conv(P, l, gid, gs); ph_prepC_bg(P, l, gid, gs); GRID_SYNC(); }
#else
        { FRESH_GID(); ph_lora_fused(P, l, C); ph_prepB(P, l, gid, gs); ph_prepC_bg(P, l, gid, gs); if (KNOB_DUP & 16) { GRID_SYNC(); ph_lora_fused(P, l, C); ph_prepC_bg(P, l, gid, gs); } GRID_SYNC(); }
#endif
#ifdef CPU_EMU
        { FRESH_GID(); ph_prepA_lora(P, l, gid, gs); GRID_SYNC(); }
#else
#endif
#ifdef CPU_EMU
        { FRESH_GID(); ph_prepA_rn(P, l, gid, gs); GRID_SYNC(); }
#endif
#ifdef CPU_EMU
        { FRESH_GID(); SCANS(l); GRID_SYNC(); }
        { FRESH_GID(); ph_attnB(P, gid, gs); ph_attnD(P, gid, gs); GRID_SYNC(); }
#else
        { ph_mixers(P, l, C); GRID_SYNC(); }
        if (KNOB_DUP & 4096) { unsigned* ctr = uni(P.CTL) + CW_TICKET + l * 128; volatile LAS int* tk = (volatile LAS int*)(C.lds + MISC_OFF) + 16; ph_attnB_mfma(P, C, ctr + 32, tk); GRID_SYNC(); }
        if (KNOB_DUP & 8192) { unsigned* ctr = uni(P.CTL) + CW_TICKET + l * 128; volatile LAS int* tk = (volatile LAS int*)(C.lds + MISC_OFF) + 16; dwin::attnD_mfma(P, C, ctr + 96, tk); GRID_SYNC(); }
#endif
#ifdef CPU_EMU
        { FRESH_GID(); ph_fixA(P, l, gid, gs); ph_fixC(P, l, gid, gs); ph_fixD(P, gid, gs); GRID_SYNC(); }
#else
        { FRESH_GID(); ph_fix_fused(P, l, C); ph_fixD_v(P, gid, gs); if (KNOB_DUP & 32) { GRID_SYNC(); ph_fix_fused(P, l, C); } GRID_SYNC(); }
#endif
#ifdef CPU_EMU
        { FRESH_GID(); GEMM_OUT(l, XSRC); GRID_SYNC(); }
#else
        { if (l == 0) gemm_out_mfma<false>(P, P.x, C); else gemm_out_mfma<true>(P, P.XR, C); GRID_SYNC(); }
#endif
#ifdef CPU_EMU
        { FRESH_GID(); ph_router(P, l, gid, gs); GRID_SYNC(); }
        { FRESH_GID(); ph_norm_bf16(P.out, P.RS, P.norm_ffn_g + l * DM, P.XN, gid, gs); ph_topk(P, gid, gs); GRID_SYNC(); }
#else
        { ph_router_mfma(P, l, C); if (KNOB_DUP & 128) { GRID_SYNC(); ph_router_mfma(P, l, C); } GRID_SYNC(); }
        { const bool cfirst = ((fresh_bx() >> 3) & 1) != 0;
          if (cfirst) { CONVERT_MOE(l); __syncthreads(); }
          ph_topk_lds(P, C); if (KNOB_DUP & 2) { GRID_SYNC(); ph_topk_lds(P, C); }
          if (!cfirst) { __syncthreads(); CONVERT_MOE(l); }
          if (KNOB_DUP & 1024) { __syncthreads(); CONVERT_MOE(l); } GRID_SYNC(); }
#endif
#ifdef CPU_EMU
        { FRESH_GID(); ph_gather(P, gid, gs); GRID_SYNC(); }
#endif
        { FRESH_GID(); GEMM_GU(l); if (KNOB_DUP & 512) { GRID_SYNC(); GEMM_GU(l); } GRID_SYNC(); }
        { FRESH_GID(); GEMM_DOWN(l); if (KNOB_DUP & 512) { GRID_SYNC(); GEMM_DOWN(l); } GRID_SYNC(); }
#ifdef CPU_EMU
        { FRESH_GID(); ph_combine(P, gid, gs); GRID_SYNC(); }
#else
        { ph_combine_norm_w(P, l, C); if (l == 0) { CONVERT_SMALL(1); GRID_SYNC(); } }
#endif
    }
}
DEVFN void forward(PRef P, Ctx& C) {
    layer_fwd(P, C, 0); layer_fwd(P, C, 1);
#ifdef CPU_EMU
    { FRESH_GID(); ph_rowrs(P.out, P.RS, gid, gs); GRID_SYNC(); }
    { FRESH_GID(); ph_final(P, gid, gs); }
#endif
}
#define WS_CTL_BYTES 65536
#define WS_SMALLW_BYTES ((size_t)(3840 * 1024 + 1024 * 1152 + 1280 * 256 + 128 * 4096) * 2)
#define WS_TOTAL_BYTES (WS_CTL_BYTES + (size_t)WS_ROW_BYTES * MROWS + WS_SMALLW_BYTES)
static void carve(Params& p, unsigned char* ws0) {
    p.CTL = (unsigned*)ws0; unsigned char* ws = ws0 + WS_CTL_BYTES;
    const size_t M = MROWS; size_t o = 0;
    auto take = [&](size_t bytes_per_row) { unsigned char* r = ws + o; o += bytes_per_row * M; return r; };
    p.XN = (bf16_t*)take(2048); p.CP = p.XN;
    unsigned char* big = ws + o;
    p.PA = (bf16_t*)take(2048);
#ifdef CPU_EMU
    p.YA = p.PA; p.OC = p.PA + (size_t)2 * M * 256;
#else
    p.YA = p.XN; p.OC = p.XN + (size_t)2 * M * 256;
#endif
    p.PB = (bf16_t*)take(1024); p.PC = (bf16_t*)take(2048); p.PD = (bf16_t*)take(2560); p.AP = (bf16_t*)take(3584);
    p.XS = (bf16_t*)big; p.YS = p.XS; p.HID = (bf16_t*)(big + (size_t)4096 * M);
    p.WGU_T = (bf16_t*)(big + (size_t)8192 * M); p.WD_T = p.WGU_T + (size_t)NEXP * 2048 * 1024;
    p.LT = (bf16_t*)take(512); p.GA = (bf16_t*)take(512); p.RN = (float*)take(16); p.BON = (float*)take(16); p.CBG = (float*)take(64);
    p.ML = (float*)take(48);
#ifdef CPU_EMU
    p.MIX = (bf16_t*)take(2304);
#else
    p.XR = (bf16_t*)take(2304);
#endif
    p.RS = (float*)take(4); p.AFF = (float*)take(64); p.SLOT = (int*)take(64);
    p.IDX = (int*)take(8); p.GATE = (float*)take(8);
    p.WIN_T = (bf16_t*)(ws + o); p.WOUT_T = p.WIN_T + (size_t)3840 * 1024; p.WL_T = p.WOUT_T + (size_t)1024 * 1152; p.ZMID = p.WL_T + (size_t)1280 * 256;
}
static void fill_inputs(Params& p, void* const* d_in) {
    const float** f = (const float**)&p.x;
    for (int i = 0; i < 30; ++i) f[i] = (const float*)d_in[i];
}

#ifndef CPU_EMU
__global__ void __launch_bounds__(512, 2) mega_fwd(Params P) {
    extern __shared__ __attribute__((aligned(16))) unsigned char lds_raw[];
    Ctx C; C.lds = (LAS unsigned char*)lds_raw; C.lds_g = (char*)lds_raw; C.wave = __builtin_amdgcn_readfirstlane(threadIdx.x >> 6); C.G = gridDim.x;
    for (int u = threadIdx.x; u < 1024 / 4; u += 512) ((LAS unsigned*)(C.lds + LDSCTL_OFF))[u] = 0u;
    __syncthreads();
    { const unsigned* src = (const unsigned*)&P; LAS unsigned* dst = (LAS unsigned*)(C.lds + PARAMS_OFF);
      for (int u = threadIdx.x; u < (int)(sizeof(Params) / 4); u += 512) dst[u] = src[u]; }
    __syncthreads();
    PRef PL = *(const LAS Params*)(C.lds + PARAMS_OFF);
    C.bar = xcd_barrier_post(uni(PL.CTL) + CW_BAR, (volatile LAS unsigned*)(C.lds + MISC_OFF) + 8);
    forward(PL, C);
}

extern "C" void kernel_launch(void* const* d_in, const int* in_sizes, int n_in, void* d_out, int out_size, void* d_ws, size_t ws_size,
                              hipStream_t stream) {
    static int grid = 0;
    if (grid == 0) {
        int dev = 0, cus = 0, per_cu = 0;
        (void)hipGetDevice(&dev);
        (void)hipDeviceGetAttribute(&cus, hipDeviceAttributeMultiprocessorCount, dev);
        (void)hipFuncSetAttribute((const void*)mega_fwd, hipFuncAttributeMaxDynamicSharedMemorySize, LDS_BYTES);
        (void)hipOccupancyMaxActiveBlocksPerMultiprocessor(&per_cu, (const void*)mega_fwd, 512, LDS_BYTES);
        (void)hipGetLastError();
        grid = cus;
        if (per_cu < 1) fprintf(stderr, "kernel_launch: occupancy query reports %d blocks per CU\n", per_cu);
        if (WS_TOTAL_BYTES > ws_size) fprintf(stderr, "workspace too small: need %zu have %zu\n", (size_t)WS_TOTAL_BYTES, ws_size);
    }
    Params p; memset(&p, 0, sizeof(p));
    fill_inputs(p, d_in);
    p.out = (float*)d_out;
    p.MIX = (bf16_t*)d_out;
    carve(p, (unsigned char*)d_ws);
    (void)hipMemsetAsync(d_ws, 0, WS_CTL_BYTES, stream);
    void* args[] = {&p};
    static int mode = 0;
    if (mode != 2) {
        hipError_t e = hipLaunchCooperativeKernel((const void*)mega_fwd, dim3(grid), dim3(512), args, LDS_BYTES, stream);
        if (e == hipSuccess) { mode = 1; return; }
        fprintf(stderr, "cooperative launch failed: %s (grid %d); using a plain launch\n", hipGetErrorString(e), grid);
        (void)hipGetLastError(); mode = 2;
    }
    hipLaunchKernelGGL(mega_fwd, dim3(grid), dim3(512), LDS_BYTES, stream, p);
}
#endif
```
